# Optimizing an MI355X kernel written in HIP

```python
import jax, jax.numpy as jnp
from jax import lax
import numpy as np

D_MODEL = 1024
BATCH = 4
SEQ = 8192
DEPTH = 1

D_CONV = D_MODEL
CONV_WIDTH = 31
N_HEADS = 4
D_MLSTM = D_MODEL
HEAD_DIM = D_MLSTM // N_HEADS
QKV_BLOCK = 4
MLSTM_CONV_WIDTH = 4
CHUNK = 128
F_BIAS_LO = 3.0
F_BIAS_HI = 6.0
D_IN = 2 * D_CONV + 2 * D_MLSTM + 2 * D_MODEL
N_EXPERTS = 32
TOP_K = 4
D_EXPERT = D_MODEL
MOE_BLOCK = 128
SWIGLU_LIMIT = 7.0
SWIGLU_ALPHA = 1.702
EPS = 1e-6

kernel_name = 'hybrid_conformer_mlstm_moe_block'


def rms_norm(x, g):
    xf = x.astype(jnp.float32)
    y = xf * lax.rsqrt(jnp.mean(xf * xf, axis=-1, keepdims=True) + EPS)
    return (y * g.astype(jnp.float32)).astype(x.dtype)


def ada_norm(x, g, shift, scale):
    return rms_norm(x, g) * (1 + scale[:, None, :]) + shift[:, None, :]


def causal_dwconv(x, w, b):
    width = w.shape[0]
    y = lax.conv_general_dilated(
        x, w[:, None, :].astype(x.dtype), window_strides=(1,),
        padding=[(width - 1, 0)], dimension_numbers=('NWC', 'WIO', 'NWC'),
        feature_group_count=x.shape[-1])
    return y + b


def conformer_conv(u_glu, w_dw, b_dw, ln_g, ln_b, w_pw, b_pw):
    a, g = jnp.split(u_glu, 2, axis=-1)
    u = causal_dwconv(a * jax.nn.sigmoid(g), w_dw, b_dw)
    uf = u.astype(jnp.float32)
    mu = jnp.mean(uf, axis=-1, keepdims=True)
    var = jnp.mean(jnp.square(uf - mu), axis=-1, keepdims=True)
    u = ((uf - mu) * lax.rsqrt(var + EPS) * ln_g.astype(jnp.float32) + ln_b.astype(jnp.float32)).astype(u_glu.dtype)
    return jax.nn.silu(u) @ w_pw + b_pw


def blockdiag(x, w):
    xb = x.reshape(x.shape[:-1] + (w.shape[0], QKV_BLOCK))
    return jnp.einsum('bsni,nio->bsno', xb, w).reshape(x.shape)


def mlstm_chunkwise(q, k, v, ig, logf):
    B, S, H, dk = q.shape
    dv = v.shape[-1]
    nc = S // CHUNK

    def to_chunks(t):
        t = t.reshape((B, nc, CHUNK, H) + t.shape[3:])
        return jnp.moveaxis(jnp.moveaxis(t, 1, 0), 3, 2)

    tri = jnp.tril(jnp.ones((CHUNK, CHUNK), dtype=bool))

    def step(carry, inp):
        C, n, m = carry
        qc, kc, vc, ic, fc = inp
        b = jnp.cumsum(fc, axis=-1)
        d_log = jnp.where(tri, b[..., :, None] - b[..., None, :] + ic[..., None, :], -jnp.inf)
        inter = b + m[..., None]
        m_t = jnp.maximum(inter, jnp.max(d_log, axis=-1))
        w_intra = jnp.exp(d_log - m_t[..., None])
        w_inter = jnp.exp(inter - m_t)
        s = jnp.einsum('bhtd,bhsd->bhts', qc, kc) * w_intra
        num = jnp.einsum('bhts,bhsv->bhtv', s, vc) + w_inter[..., None] * jnp.einsum('bhtd,bhdv->bhtv', qc, C)
        den = jnp.sum(s, axis=-1) + w_inter * jnp.einsum('bhtd,bhd->bht', qc, n)
        h = num / jnp.maximum(jnp.abs(den), jnp.exp(-m_t))[..., None]
        b_last = b[..., -1]
        lw = b_last[..., None] - b + ic
        m_new = jnp.maximum(b_last + m, jnp.max(lw, axis=-1))
        decay = jnp.exp(b_last + m - m_new)
        wk = jnp.exp(lw - m_new[..., None])[..., None] * kc
        C_new = decay[..., None, None] * C + jnp.einsum('bhsd,bhsv->bhdv', wk, vc)
        n_new = decay[..., None] * n + jnp.sum(wk, axis=-2)
        return (C_new, n_new, m_new), h

    init = (jnp.zeros((B, H, dk, dv), jnp.float32), jnp.zeros((B, H, dk), jnp.float32),
            jnp.zeros((B, H), jnp.float32))
    _, hs = lax.scan(step, init, (to_chunks(q), to_chunks(k), to_chunks(v), to_chunks(ig), to_chunks(logf)))
    hs = jnp.moveaxis(jnp.moveaxis(hs, 2, 3), 0, 1)
    return hs.reshape(B, S, H * dv)


def mlstm_branch(x_m, o_pre, w_sc, b_sc, w_qbd, w_kbd, w_vbd, w_if, b_if, hn_g, skip, w_mo):
    B, S, _ = x_m.shape
    x_c = jax.nn.silu(causal_dwconv(x_m, w_sc, b_sc))
    q = blockdiag(x_c, w_qbd)
    k = blockdiag(x_c, w_kbd)
    v = blockdiag(x_m, w_vbd)
    gates = (q @ w_if[:D_MLSTM] + k @ w_if[D_MLSTM:2 * D_MLSTM] + v @ w_if[2 * D_MLSTM:] + b_if).astype(jnp.float32)
    ig = gates[..., :N_HEADS]
    logf = jax.nn.log_sigmoid(gates[..., N_HEADS:])
    heads = lambda t: t.reshape(B, S, N_HEADS, HEAD_DIM).astype(jnp.float32)
    h = mlstm_chunkwise(heads(q), heads(k) * (HEAD_DIM ** -0.5), heads(v), ig, logf)
    h = jax.nn.sigmoid(o_pre.astype(jnp.float32)) * h
    hh = h.reshape(B, S, N_HEADS, HEAD_DIM)
    mu = jnp.mean(hh, axis=-1, keepdims=True)
    var = jnp.mean(jnp.square(hh - mu), axis=-1, keepdims=True)
    hn = ((hh - mu) * lax.rsqrt(var + EPS)).reshape(B, S, D_MLSTM) * hn_g.astype(jnp.float32)
    out = hn.astype(x_m.dtype) + skip * x_c
    return out @ w_mo


def moe(h, w_r, b_r, w_gu, b_gu, w_dn, b_dn):
    B, S, D = h.shape
    T = B * S
    hf = h.reshape(T, D)
    logits = (hf @ w_r + b_r).astype(jnp.float32)
    top_v, top_i = lax.top_k(logits, TOP_K)
    top_w = jax.nn.softmax(top_v, axis=-1)
    A = T * TOP_K
    e_flat = top_i.reshape(A)
    tok_flat = jnp.arange(A, dtype=jnp.int32) // TOP_K
    w_flat = top_w.reshape(A)
    order = jnp.argsort(e_flat)
    e_sorted = e_flat[order]
    counts = jnp.bincount(e_flat, length=N_EXPERTS)
    padded = (counts + MOE_BLOCK - 1) // MOE_BLOCK * MOE_BLOCK
    start_u = jnp.cumsum(counts) - counts
    pad_end = jnp.cumsum(padded)
    start_p = pad_end - padded
    dest = start_p[e_sorted] + jnp.arange(A, dtype=jnp.int32) - start_u[e_sorted]
    P = A + N_EXPERTS * MOE_BLOCK
    NB = P // MOE_BLOCK
    row_tok = jnp.zeros((P,), jnp.int32).at[dest].set(tok_flat[order])
    row_w = jnp.zeros((P,), jnp.float32).at[dest].set(w_flat[order])
    blk_e = jnp.minimum(jnp.searchsorted(pad_end, jnp.arange(NB, dtype=jnp.int32) * MOE_BLOCK, side='right'),
                        N_EXPERTS - 1)

    def expert_block(args):
        e, toks, wts = args
        xb = hf[toks]
        gu = xb @ w_gu[e] + b_gu[e]
        gate, up = jnp.split(gu, 2, axis=-1)
        gate = jnp.minimum(gate, SWIGLU_LIMIT)
        up = jnp.clip(up, -SWIGLU_LIMIT, SWIGLU_LIMIT)
        glu = gate * jax.nn.sigmoid(gate * SWIGLU_ALPHA)
        y = ((up + 1) * glu) @ w_dn[e] + b_dn[e]
        return y * wts[:, None].astype(y.dtype)

    ys = lax.map(expert_block, (blk_e, row_tok.reshape(NB, MOE_BLOCK), row_w.reshape(NB, MOE_BLOCK)))
    out = jnp.zeros((T, D), h.dtype).at[row_tok].add(ys.reshape(P, D).astype(h.dtype))
    return out.reshape(B, S, D)


def setup_inputs(seed: int = 0) -> dict:
    key = jax.random.key(seed)
    ks = iter(jax.random.split(key, 40))
    nrm = lambda shape, scale: jax.random.normal(next(ks), shape, jnp.float32) * scale
    L = DEPTH
    f_bias = jnp.broadcast_to(jnp.linspace(F_BIAS_LO, F_BIAS_HI, N_HEADS, dtype=jnp.float32), (L, N_HEADS))
    nb = D_MLSTM // QKV_BLOCK
    return {
        'x': nrm((BATCH, SEQ, D_MODEL), 1.0),
        'c': nrm((BATCH, D_MODEL), 1.0),
        'w_ada': nrm((L, D_MODEL, 6 * D_MODEL), D_MODEL ** -0.5),
        'b_ada': nrm((L, 6 * D_MODEL), 0.01),
        'g_mix': 1.0 + nrm((L, D_MODEL), 0.02),
        'w_in': nrm((L, D_MODEL, D_IN), D_MODEL ** -0.5),
        'w_dw': nrm((L, CONV_WIDTH, D_CONV), CONV_WIDTH ** -0.5),
        'b_dw': nrm((L, D_CONV), 0.01),
        'ln_g': 1.0 + nrm((L, D_CONV), 0.02),
        'ln_b': nrm((L, D_CONV), 0.01),
        'w_conv_out': nrm((L, D_CONV, D_MODEL), D_CONV ** -0.5),
        'b_conv_out': nrm((L, D_MODEL), 0.01),
        'w_sc': nrm((L, MLSTM_CONV_WIDTH, D_MLSTM), MLSTM_CONV_WIDTH ** -0.5),
        'b_sc': nrm((L, D_MLSTM), 0.01),
        'w_qbd': nrm((L, nb, QKV_BLOCK, QKV_BLOCK), QKV_BLOCK ** -0.5),
        'w_kbd': nrm((L, nb, QKV_BLOCK, QKV_BLOCK), QKV_BLOCK ** -0.5),
        'w_vbd': nrm((L, nb, QKV_BLOCK, QKV_BLOCK), QKV_BLOCK ** -0.5),
        'w_if': nrm((L, 3 * D_MLSTM, 2 * N_HEADS), (3 * D_MLSTM) ** -0.5),
        'b_if': jnp.concatenate([nrm((L, N_HEADS), 0.1), f_bias + nrm((L, N_HEADS), 0.1)], axis=-1),
        'hn_g': 1.0 + nrm((L, D_MLSTM), 0.02),
        'skip': 1.0 + nrm((L, D_MLSTM), 0.02),
        'w_m_out': nrm((L, D_MLSTM, D_MODEL), D_MLSTM ** -0.5),
        'w_out': nrm((L, D_MODEL, D_MODEL), D_MODEL ** -0.5),
        'g_moe': 1.0 + nrm((L, D_MODEL), 0.02),
        'w_router': nrm((L, D_MODEL, N_EXPERTS), D_MODEL ** -0.5),
        'b_router': nrm((L, N_EXPERTS), 0.01),
        'w_gu': nrm((L, N_EXPERTS, D_MODEL, 2 * D_EXPERT), D_MODEL ** -0.5),
        'b_gu': nrm((L, N_EXPERTS, 2 * D_EXPERT), 0.01),
        'w_down': nrm((L, N_EXPERTS, D_EXPERT, D_MODEL), D_EXPERT ** -0.5),
        'b_down': nrm((L, N_EXPERTS, D_MODEL), 0.01),
        'g_final': 1.0 + nrm((D_MODEL,), 0.02),
    }


def reference(x, c, w_ada, b_ada, g_mix, w_in, w_dw, b_dw, ln_g, ln_b, w_conv_out, b_conv_out,
              w_sc, b_sc, w_qbd, w_kbd, w_vbd, w_if, b_if, hn_g, skip, w_m_out, w_out,
              g_moe, w_router, b_router, w_gu, b_gu, w_down, b_down, g_final):
    splits = [2 * D_CONV, 2 * D_CONV + D_MLSTM, 2 * D_CONV + 2 * D_MLSTM, 2 * D_CONV + 2 * D_MLSTM + D_MODEL]
    for l in range(DEPTH):
        mod = jax.nn.silu(c) @ w_ada[l] + b_ada[l]
        sh1, sc1, gt1, sh2, sc2, gt2 = jnp.split(mod, 6, axis=-1)
        h = ada_norm(x, g_mix[l], sh1, sc1)
        proj = h @ w_in[l]
        u_glu, x_m, o_pre, z_a, z_b = jnp.split(proj, splits, axis=-1)
        y_a = conformer_conv(u_glu, w_dw[l], b_dw[l], ln_g[l], ln_b[l], w_conv_out[l], b_conv_out[l])
        y_b = mlstm_branch(x_m, o_pre, w_sc[l], b_sc[l], w_qbd[l], w_kbd[l], w_vbd[l],
                           w_if[l], b_if[l], hn_g[l], skip[l], w_m_out[l])
        mixed = (jax.nn.sigmoid(z_a) * y_a + jax.nn.sigmoid(z_b) * y_b) @ w_out[l]
        x = x + gt1[:, None, :] * mixed
        hm = ada_norm(x, g_moe[l], sh2, sc2)
        x = x + gt2[:, None, :] * moe(hm, w_router[l], b_router[l], w_gu[l], b_gu[l], w_down[l], b_down[l])
    return rms_norm(x, g_final)
```

```cpp
#include <hip/hip_runtime.h>
#include <cstdio>
#include <cstdint>

constexpr int DM = 1024, NB_ = 4, SEQ = 8192, T = NB_ * SEQ, NE = 32, TOPK = 4, DIN = 6144;
constexpr int CH = 256;
constexpr int NCH = SEQ / CH;
constexpr int NUNIT = NB_ * 4 * NCH;
constexpr int MAXTILES = 544;
constexpr float EPS = 1e-6f;

typedef unsigned short bf16;
typedef float f32x4 __attribute__((ext_vector_type(4)));
typedef unsigned u32x4 __attribute__((ext_vector_type(4)));
typedef unsigned u32x2 __attribute__((ext_vector_type(2)));

constexpr size_t MB = 1u << 20;
constexpr size_t WS_WGU = 0, WS_WDN = 128 * MB;
constexpr size_t SLAB0 = 192 * MB, SLABSZ = 64 * MB;
#define SLAB(i) (SLAB0 + (size_t)(i) * SLABSZ)
constexpr size_t WS_WIN = 960 * MB, WS_WPW = 972 * MB, WS_WMO = 974 * MB, WS_WOUT = 976 * MB;
constexpr size_t WS_CTL = 978 * MB, WS_MOD = 979 * MB, WS_IG = 980 * MB, WS_LOGF = 980 * MB + 512 * 1024;
constexpr size_t WS_CW = 981 * MB, WS_FLOOR = 981 * MB + 512 * 1024, WS_UNITS = 982 * MB, WS_NLOC = 983 * MB, WS_NS = 984 * MB;
constexpr size_t WS_DENP = 985 * MB, WS_DEN = 987 * MB, WS_TOPI = 988 * MB, WS_TOPW = 989 * MB, WS_CNT = 990 * MB, WS_ROWSLOT = 991 * MB, WS_TILEE = 992 * MB;
constexpr size_t WS_ROWTOK = 997 * MB;
constexpr size_t WS_GP = 993 * MB;
constexpr size_t WS_NEED = 1024 * MB;
constexpr size_t O_HA = SLAB(0), O_YAPRE = SLAB(0), O_UT = SLAB(0), O_MOIN = SLAB(0);
constexpr size_t O_U1 = SLAB(1), O_KWT = SLAB(1), O_CT = SLAB(1);
constexpr size_t O_XM = SLAB(2), O_VT = SLAB(2);
constexpr size_t O_SO = SLAB(3);
constexpr size_t O_SZA = SLAB(4), O_SP = SLAB(4);
constexpr size_t O_SZB = SLAB(5);
constexpr size_t O_Q = SLAB(6), O_K = SLAB(7), O_V = SLAB(8), O_XC = SLAB(9), O_YAG = SLAB(10), O_MERGED = SLAB(11);
constexpr size_t O_HG = SLAB(7);
constexpr size_t O_X1 = SLAB(0);
constexpr size_t O_HM = SLAB(2);
constexpr size_t O_XS = SLAB(3), O_Y = SLAB(3);
constexpr size_t O_ACT = SLAB(8);

struct P { const float* in[31]; float* out; unsigned char* ws; };
enum { I_X = 0, I_C, I_WADA, I_BADA, I_GMIX, I_WIN, I_WDW, I_BDW, I_LNG, I_LNB, I_WPW, I_BPW, I_WSC, I_BSC, I_WQ, I_WK, I_WV, I_WIF, I_BIF, I_HNG, I_SKIP,
       I_WMO, I_WOUT, I_GMOE, I_WR, I_BR, I_WGU, I_BGU, I_WDN, I_BDN, I_GFIN };

#define LAS __attribute__((address_space(3)))
__device__ __forceinline__ unsigned f2bf(float f) { unsigned u = __float_as_uint(f); return (u + 0x7fffu + ((u >> 16) & 1u)) >> 16; }
__device__ __forceinline__ float bf2f(unsigned h) { return __uint_as_float(h << 16); }
__device__ __forceinline__ unsigned pk2(float lo, float hi) { unsigned r; asm volatile("v_cvt_pk_bf16_f32 %0, %1, %2" : "=v"(r) : "v"(lo), "v"(hi)); return r; }
__device__ __forceinline__ float bflo(unsigned w) { return __uint_as_float(w << 16); }
__device__ __forceinline__ float bfhi(unsigned w) { return __uint_as_float(w & 0xffff0000u); }
__device__ __forceinline__ unsigned pk4_fp8(float a, float b, float c, float d) {
    a = fminf(fmaxf(a, -448.f), 448.f); b = fminf(fmaxf(b, -448.f), 448.f); c = fminf(fmaxf(c, -448.f), 448.f); d = fminf(fmaxf(d, -448.f), 448.f);
    int w = 0; w = __builtin_amdgcn_cvt_pk_fp8_f32(a, b, w, false); w = __builtin_amdgcn_cvt_pk_fp8_f32(c, d, w, true); return (unsigned)w; }
__device__ __forceinline__ unsigned pk4_fp8_nc(float a, float b, float c, float d) { int w = 0; w = __builtin_amdgcn_cvt_pk_fp8_f32(a, b, w, false); w = __builtin_amdgcn_cvt_pk_fp8_f32(c, d, w, true); return (unsigned)w; }
typedef float f32x2_ __attribute__((ext_vector_type(2)));
constexpr float S_HM = 32.f, S_W = 1024.f, S_ACT = 4.f, S_Y = 32.f;
__device__ __forceinline__ float sigm(float x) { return __builtin_amdgcn_rcpf(1.f + __expf(-x)); }
__device__ __forceinline__ float silu(float x) { return x * __builtin_amdgcn_rcpf(1.f + __expf(-x)); }
__device__ __forceinline__ float wave_sum(float v) {
#pragma unroll
    for (int o = 1; o < 64; o <<= 1) v += __shfl_xor(v, o);
    return v;
}
__device__ __forceinline__ float wave_max(float v) {
#pragma unroll
    for (int o = 1; o < 64; o <<= 1) v = fmaxf(v, __shfl_xor(v, o));
    return v;
}
__device__ __forceinline__ int otid() { int t = threadIdx.x; asm volatile("" : "+v"(t)); return t; }
template <class Tp> __device__ __forceinline__ Tp* wsp(const P& p, size_t off) { return (Tp*)(p.ws + off); }

__device__ void ph_mod(const P& p, float* lds) {
    const int tid = otid();
    const float* c = p.in[I_C]; const float* w = p.in[I_WADA]; const float* ba = p.in[I_BADA];
    float* mod = wsp<float>(p, WS_MOD);
    for (int cb = blockIdx.x; cb < DIN / 24; cb += gridDim.x) {
        if (tid < 384) {
            const int col = cb * 24 + (tid % 24), ks = tid / 24;
            float a0 = 0.f, a1 = 0.f, a2 = 0.f, a3 = 0.f;
            for (int k = ks * 64; k < ks * 64 + 64; ++k) {
                const float wv = w[(size_t)k * DIN + col];
                a0 += silu(c[k]) * wv; a1 += silu(c[DM + k]) * wv; a2 += silu(c[2 * DM + k]) * wv; a3 += silu(c[3 * DM + k]) * wv;
            }
            float* r = lds + (ks * 24 + (tid % 24)) * 4; r[0] = a0; r[1] = a1; r[2] = a2; r[3] = a3;
        }
        __syncthreads();
        if (tid < 96) {
            const int cl = tid % 24, b = tid / 24; float s = 0.f;
            for (int ks = 0; ks < 16; ++ks) s += lds[(ks * 24 + cl) * 4 + b];
            mod[b * DIN + cb * 24 + cl] = s + ba[cb * 24 + cl];
        }
        __syncthreads();
    }
}
__device__ __forceinline__ int glu_row(int n, int half) { const int ch = n % half, isg = n / half; return (ch >> 7) * 256 + isg * 128 + (ch & 127); }
__device__ __forceinline__ void transpose_item(const float* W, int K, int N, bf16* WT, int drow0, float* scr, int kb, int nb, int lane) {
    const int k0 = 64 * kb, n0 = 32 * nb;
#pragma unroll 8
    for (int i = 0; i < 32; ++i) { const int kk = 2 * i + (lane >> 5); scr[kk * 33 + (lane & 31)] = W[(size_t)(k0 + kk) * N + n0 + (lane & 31)]; }
    __builtin_amdgcn_s_waitcnt(0xc07f); asm volatile("" ::: "memory");
    const int c = lane & 7;
#pragma unroll
    for (int j = 0; j < 4; ++j) { const int n = (lane >> 3) + 8 * j; const float* s = scr + (8 * c) * 33 + n;
        u32x4 o; o.x = pk2(s[0 * 33], s[1 * 33]); o.y = pk2(s[2 * 33], s[3 * 33]); o.z = pk2(s[4 * 33], s[5 * 33]); o.w = pk2(s[6 * 33], s[7 * 33]);
        *(u32x4*)(WT + (size_t)(drow0 + n) * K + k0 + 8 * c) = o; }
    __builtin_amdgcn_s_waitcnt(0xc07f); asm volatile("" ::: "memory");
}
__device__ __forceinline__ void transpose_item8(const float* W, int K, int N, unsigned char* WT, int drow0, float* scr, int kb, int nb, int lane) {
    const int k0 = 128 * kb, n0 = 32 * nb;
#pragma unroll 8
    for (int i = 0; i < 64; ++i) { const int kk = 2 * i + (lane >> 5); scr[kk * 33 + (lane & 31)] = W[(size_t)(k0 + kk) * N + n0 + (lane & 31)]; }
    __builtin_amdgcn_s_waitcnt(0xc07f); asm volatile("" ::: "memory");
    const int c = lane & 7;
#pragma unroll
    for (int j = 0; j < 4; ++j) { const int n = (lane >> 3) + 8 * j; const float* q = scr + (16 * c) * 33 + n;
        u32x4 o; o.x = pk4_fp8(q[0] * S_W, q[33] * S_W, q[66] * S_W, q[99] * S_W); o.y = pk4_fp8(q[132] * S_W, q[165] * S_W, q[198] * S_W, q[231] * S_W);
        o.z = pk4_fp8(q[264] * S_W, q[297] * S_W, q[330] * S_W, q[363] * S_W); o.w = pk4_fp8(q[396] * S_W, q[429] * S_W, q[462] * S_W, q[495] * S_W);
        *(u32x4*)(WT + (size_t)(drow0 + n) * K + k0 + 16 * c) = o; }
    __builtin_amdgcn_s_waitcnt(0xc07f); asm volatile("" ::: "memory");
}
__device__ void ph_wconv(const P& p, float* lds) {
    const int tid = otid(), lane = tid & 63, wave = tid >> 6;
    float* scr = lds + wave * (128 * 33);
    const int gw = blockIdx.x * 8 + wave, NGW = gridDim.x * 8;
    constexpr int I_IN = 16 * 192, I_SQ = 16 * 32, I_GU = 8 * 64, I_DN = 8 * 32;
    constexpr int NITEMS = I_IN + 3 * I_SQ + NE * I_GU + NE * I_DN;
    for (int it = gw; it < NITEMS; it += NGW) {
        int r = it;
        if (r < I_IN) { const int kb = r / 192, nb = r % 192, n0 = nb * 32; const int d = n0 < 2048 ? glu_row(n0, 1024) : n0;
            transpose_item(p.in[I_WIN], DM, DIN, wsp<bf16>(p, WS_WIN), d, scr, kb, nb, lane); continue; } r -= I_IN;
        if (r < I_SQ) { transpose_item(p.in[I_WPW], DM, DM, wsp<bf16>(p, WS_WPW), (r % 32) * 32, scr, r / 32, r % 32, lane); continue; } r -= I_SQ;
        if (r < I_SQ) { transpose_item(p.in[I_WMO], DM, DM, wsp<bf16>(p, WS_WMO), (r % 32) * 32, scr, r / 32, r % 32, lane); continue; } r -= I_SQ;
        if (r < I_SQ) { transpose_item(p.in[I_WOUT], DM, DM, wsp<bf16>(p, WS_WOUT), (r % 32) * 32, scr, r / 32, r % 32, lane); continue; } r -= I_SQ;
        if (r < NE * I_GU) { const int e = r / I_GU, q = r % I_GU, kb = q / 64, nb = q % 64;
            transpose_item8(p.in[I_WGU] + (size_t)e * DM * 2048, DM, 2048, wsp<unsigned char>(p, WS_WGU) + (size_t)e * 2048 * DM, glu_row(nb * 32, 1024), scr, kb, nb, lane); continue; } r -= NE * I_GU;
        { const int e = r / I_DN, q = r % I_DN, kb = q / 32, nb = q % 32;
            transpose_item8(p.in[I_WDN] + (size_t)e * DM * DM, DM, DM, wsp<unsigned char>(p, WS_WDN) + (size_t)e * DM * DM, nb * 32, scr, kb, nb, lane); }
    }
}
__device__ __forceinline__ void adanorm_row(const float* xrow, const float* g, const float* sc, const float* sh, bf16* orow, int lane) {
    f32x4 v[4]; float s = 0.f;
#pragma unroll
    for (int j = 0; j < 4; ++j) { v[j] = ((const f32x4*)xrow)[lane + 64 * j]; s += (v[j].x * v[j].x + v[j].y * v[j].y) + (v[j].z * v[j].z + v[j].w * v[j].w); }
    const float r = rsqrtf(wave_sum(s) * (1.f / DM) + EPS);
#pragma unroll
    for (int j = 0; j < 4; ++j) { const f32x4 gg = ((const f32x4*)g)[lane + 64 * j], ss = ((const f32x4*)sc)[lane + 64 * j], hh = ((const f32x4*)sh)[lane + 64 * j];
        const f32x4 o = v[j] * r * gg * (1.f + ss) + hh;
        u32x2 w; w.x = pk2(o.x, o.y); w.y = pk2(o.z, o.w); ((u32x2*)orow)[lane + 64 * j] = w; }
}
__device__ void ph_norm1(const P& p) {
    const int tid = otid(), lane = tid & 63, gw = blockIdx.x * 8 + (tid >> 6), NGW = gridDim.x * 8;
    const float* mod = wsp<float>(p, WS_MOD); bf16* HA = wsp<bf16>(p, O_HA);
    for (int m = gw; m < T; m += NGW) { const int b = m / SEQ;
        adanorm_row(p.in[I_X] + (size_t)m * DM, p.in[I_GMIX], mod + b * DIN + 1024, mod + b * DIN, HA + (size_t)m * DM, lane); }
}
__device__ void ph_conv(const P& p, float* lds) {
    const int tid = otid(), lane = tid & 63, wave = tid >> 6, c2 = tid * 2;
    const bf16* U1 = wsp<bf16>(p, O_U1); bf16* YA = wsp<bf16>(p, O_YAPRE);
    bf16* tin = (bf16*)(lds + 256);
    bf16* tout = tin + 2 * 8192;
    const float* wd = p.in[I_WDW];
    float w0[31], w1[31];
#pragma unroll
    for (int j = 0; j < 31; ++j) { w0[j] = wd[j * DM + c2]; w1[j] = wd[j * DM + c2 + 1]; }
    const float b0 = p.in[I_BDW][c2], b1 = p.in[I_BDW][c2 + 1];
    const float g0 = p.in[I_LNG][c2], g1 = p.in[I_LNG][c2 + 1], lb0 = p.in[I_LNB][c2], lb1 = p.in[I_LNB][c2 + 1];
    const int crow = tid >> 7, ccol = (tid & 127) * 8;
    for (int blk = blockIdx.x; blk < T / 128; blk += gridDim.x) {
        const int tb = blk * 128, sb = tb % SEQ;
        unsigned win[38];
#pragma unroll
        for (int j = 0; j < 30; ++j) win[j] = (sb - 30 + j >= 0) ? *(const unsigned*)(U1 + (size_t)(tb - 30 + j) * DM + c2) : 0u;
        u32x4 r0 = *(const u32x4*)(U1 + (size_t)(tb + crow) * DM + ccol), r1 = *(const u32x4*)(U1 + (size_t)(tb + crow + 4) * DM + ccol);
        for (int grp = 0; grp < 16; ++grp) {
            const int t0 = tb + grp * 8;
            bf16* ti = tin + (grp & 1) * 8192;
            *(u32x4*)(ti + crow * 1024 + ccol) = r0; *(u32x4*)(ti + (crow + 4) * 1024 + ccol) = r1;
            if (grp < 15) { r0 = *(const u32x4*)(U1 + (size_t)(t0 + 8 + crow) * DM + ccol); r1 = *(const u32x4*)(U1 + (size_t)(t0 + 12 + crow) * DM + ccol); }
            __syncthreads();
            if (grp > 0) { const bf16* to = tout + ((grp - 1) & 1) * 8192;
                *(u32x4*)(YA + (size_t)(t0 - 8 + crow) * DM + ccol) = *(const u32x4*)(to + crow * 1024 + ccol);
                *(u32x4*)(YA + (size_t)(t0 - 4 + crow) * DM + ccol) = *(const u32x4*)(to + (crow + 4) * 1024 + ccol); }
#pragma unroll
            for (int j = 0; j < 8; ++j) win[30 + j] = *(const unsigned*)(ti + j * 1024 + c2);
            float a0[8], a1[8];
#pragma unroll
            for (int i = 0; i < 8; ++i) { a0[i] = b0; a1[i] = b1; }
#pragma unroll
            for (int j = 0; j < 38; ++j) { const float u0 = bflo(win[j]), u1 = bfhi(win[j]);
#pragma unroll
                for (int i = 0; i < 8; ++i) { const int tap = j - i; if (tap >= 0 && tap <= 30) { a0[i] += u0 * w0[tap]; a1[i] += u1 * w1[tap]; } } }
#pragma unroll
            for (int j = 0; j < 30; ++j) win[j] = win[j + 8];
            float st[16];
#pragma unroll
            for (int i = 0; i < 8; ++i) { st[2 * i] = wave_sum(a0[i] + a1[i]); st[2 * i + 1] = wave_sum(a0[i] * a0[i] + a1[i] * a1[i]); }
            float* red = lds + (grp & 1) * 128;
            if (lane == 0) {
#pragma unroll
                for (int i = 0; i < 16; ++i) red[i * 8 + wave] = st[i]; }
            __syncthreads();
            bf16* to = tout + (grp & 1) * 8192;
#pragma unroll
            for (int i = 0; i < 8; ++i) {
                const f32x4 s0 = *(const f32x4*)(red + i * 16), s1 = *(const f32x4*)(red + i * 16 + 4), q0 = *(const f32x4*)(red + i * 16 + 8), q1 = *(const f32x4*)(red + i * 16 + 12);
                const float s = ((s0.x + s0.y) + (s0.z + s0.w)) + ((s1.x + s1.y) + (s1.z + s1.w)), q = ((q0.x + q0.y) + (q0.z + q0.w)) + ((q1.x + q1.y) + (q1.z + q1.w));
                const float mu = s * (1.f / DM), var = fmaxf(q * (1.f / DM) - mu * mu, 0.f), rs = rsqrtf(var + EPS);
                const float y0 = (a0[i] - mu) * rs * g0 + lb0, y1 = (a1[i] - mu) * rs * g1 + lb1;
                *(unsigned*)(to + i * 1024 + c2) = pk2(silu(y0), silu(y1));
            }
        }
        __syncthreads();
        { const bf16* to = tout + 8192;
            *(u32x4*)(YA + (size_t)(tb + 120 + crow) * DM + ccol) = *(const u32x4*)(to + crow * 1024 + ccol);
            *(u32x4*)(YA + (size_t)(tb + 124 + crow) * DM + ccol) = *(const u32x4*)(to + (crow + 4) * 1024 + ccol); }
        __syncthreads();
    }
}
typedef short bf16x8v __attribute__((ext_vector_type(8)));
__device__ __forceinline__ unsigned cvtpk(float lo, float hi) { unsigned r; asm volatile("v_cvt_pk_bf16_f32 %0, %1, %2" : "=v"(r) : "v"(lo), "v"(hi)); return r; }
__device__ __forceinline__ bf16x8v pack_frag(const float* v) { u32x4 w; w.x = cvtpk(v[0], v[1]); w.y = cvtpk(v[2], v[3]); w.z = cvtpk(v[4], v[5]); w.w = cvtpk(v[6], v[7]); return __builtin_bit_cast(bf16x8v, w); }
__device__ void ph_m1(const P& p, float* lds) {
    const int tid = otid(), lane = tid & 63, wave = tid >> 6, tok = lane & 15, kg = lane >> 4;
    const bf16* XM = wsp<bf16>(p, O_XM);
    bf16* Q = wsp<bf16>(p, O_Q); bf16* K = wsp<bf16>(p, O_K); bf16* V = wsp<bf16>(p, O_V); bf16* XC = wsp<bf16>(p, O_XC);
    float* GP = wsp<float>(p, WS_GP);
    for (int item = blockIdx.x; item < 256; item += gridDim.x) {
        const int cb = item & 3, range = item >> 2, c8 = cb * 256 + wave * 32 + kg * 8;
        float wsc[4][8], bsc[8];
        float* bd = lds + 4096 + (wave * 4 + kg) * 96;
#pragma unroll
        for (int j = 0; j < 4; ++j) { const f32x4 a = *(const f32x4*)(p.in[I_WSC] + j * DM + c8), b = *(const f32x4*)(p.in[I_WSC] + j * DM + c8 + 4);
            wsc[j][0] = a.x; wsc[j][1] = a.y; wsc[j][2] = a.z; wsc[j][3] = a.w; wsc[j][4] = b.x; wsc[j][5] = b.y; wsc[j][6] = b.z; wsc[j][7] = b.w; }
        { const f32x4 a = *(const f32x4*)(p.in[I_BSC] + c8), b = *(const f32x4*)(p.in[I_BSC] + c8 + 4); bsc[0] = a.x; bsc[1] = a.y; bsc[2] = a.z; bsc[3] = a.w; bsc[4] = b.x; bsc[5] = b.y; bsc[6] = b.z; bsc[7] = b.w; }
#pragma unroll
        for (int g = 0; g < 2; ++g)
#pragma unroll
            for (int i = 0; i < 16; ++i) { const int o = (c8 / 4 + g) * 16 + i; if (tok == 0) { bd[(g * 3 + 0) * 16 + i] = p.in[I_WQ][o]; bd[(g * 3 + 1) * 16 + i] = p.in[I_WK][o]; bd[(g * 3 + 2) * 16 + i] = p.in[I_WV][o]; } }
        __syncthreads();
        bf16x8v bq, bk, bv;
        { float t0[8], t1[8], t2[8];
#pragma unroll
            for (int j = 0; j < 8; ++j) { const bool on = tok < 8; const int gi = tok & 7;
                t0[j] = on ? p.in[I_WIF][(size_t)(c8 + j) * 8 + gi] : 0.f; t1[j] = on ? p.in[I_WIF][(size_t)(DM + c8 + j) * 8 + gi] : 0.f; t2[j] = on ? p.in[I_WIF][(size_t)(2 * DM + c8 + j) * 8 + gi] : 0.f; }
            bq = pack_frag(t0); bk = pack_frag(t1); bv = pack_frag(t2); }
        u32x4 nx[4];
#pragma unroll
        for (int j = 0; j < 4; ++j) { const int t_ = range * 512 + tok, s_ = t_ % SEQ; nx[j] = (u32x4){0u, 0u, 0u, 0u}; if (s_ - 3 + j >= 0) nx[j] = *(const u32x4*)(XM + (size_t)(t_ - 3 + j) * DM + c8); }
        for (int tt = 0; tt < 32; ++tt) {
            const int t = range * 512 + tt * 16 + tok;
            float xm[4][8];
#pragma unroll
            for (int j = 0; j < 4; ++j) { const u32x4 u = nx[j];
                xm[j][0] = bflo(u.x); xm[j][1] = bfhi(u.x); xm[j][2] = bflo(u.y); xm[j][3] = bfhi(u.y); xm[j][4] = bflo(u.z); xm[j][5] = bfhi(u.z); xm[j][6] = bflo(u.w); xm[j][7] = bfhi(u.w); }
            if (tt < 31) {
#pragma unroll
                for (int j = 0; j < 4; ++j) nx[j] = *(const u32x4*)(XM + (size_t)(t + 16 - 3 + j) * DM + c8); }
            float xc[8], q[8], k[8], v[8];
#pragma unroll
            for (int c = 0; c < 8; ++c) { float a = bsc[c];
#pragma unroll
                for (int j = 0; j < 4; ++j) a += xm[j][c] * wsc[j][c];
                xc[c] = silu(a); }
#pragma unroll
            for (int g = 0; g < 2; ++g)
                {   f32x4 aq = {0.f, 0.f, 0.f, 0.f}, ak = aq, av = aq;
#pragma unroll
                    for (int ii = 0; ii < 4; ++ii) { const f32x4 w_q = *(const f32x4*)(bd + (g * 3 + 0) * 16 + ii * 4), w_k = *(const f32x4*)(bd + (g * 3 + 1) * 16 + ii * 4), w_v = *(const f32x4*)(bd + (g * 3 + 2) * 16 + ii * 4);
                        aq += w_q * xc[g * 4 + ii]; ak += w_k * xc[g * 4 + ii]; av += w_v * xm[3][g * 4 + ii]; }
#pragma unroll
                    for (int o = 0; o < 4; ++o) { q[g * 4 + o] = aq[o]; k[g * 4 + o] = ak[o]; v[g * 4 + o] = av[o]; } }
            const bf16x8v fq_ = pack_frag(q), fk_ = pack_frag(k), fv_ = pack_frag(v), fx_ = pack_frag(xc);
            f32x4 acc = {0.f, 0.f, 0.f, 0.f};
            acc = __builtin_amdgcn_mfma_f32_16x16x32_bf16(fq_, bq, acc, 0, 0, 0);
            acc = __builtin_amdgcn_mfma_f32_16x16x32_bf16(fk_, bk, acc, 0, 0, 0);
            acc = __builtin_amdgcn_mfma_f32_16x16x32_bf16(fv_, bv, acc, 0, 0, 0);
            float* red = lds + (tt & 3) * 1024 + wave * 128;
            if (tok < 8) {
#pragma unroll
                for (int r = 0; r < 4; ++r) red[(kg * 4 + r) * 8 + tok] = acc[r]; }
            *(bf16x8v*)(Q + (size_t)t * DM + c8) = fq_; *(bf16x8v*)(K + (size_t)t * DM + c8) = fk_; *(bf16x8v*)(V + (size_t)t * DM + c8) = fv_; *(bf16x8v*)(XC + (size_t)t * DM + c8) = fx_;
            if (tt & 1) {
                __syncthreads();
                if (tid < 256) { const int tl = tt - 1 + (tid >> 7), e = tid & 127; const float* rr = lds + (tl & 3) * 1024 + e; float sum = 0.f;
#pragma unroll
                    for (int w = 0; w < 8; ++w) sum += rr[w * 128];
                    GP[(size_t)cb * T * 8 + (size_t)(range * 512 + tl * 16) * 8 + e] = sum; }
            }
        }
        __syncthreads();
    }
}
constexpr int TP = 258;
__device__ void ph_m2(const P& p, float* ldsf) {
    const int tid = otid(), lane = tid & 63, wave = tid >> 6;
    bf16* tile = (bf16*)ldsf;
    float* wts = ldsf + 33024;
    float* red = ldsf + 33024 + 256;
    const bf16* Kb = wsp<bf16>(p, O_K); const bf16* Vb = wsp<bf16>(p, O_V);
    bf16* KWT = wsp<bf16>(p, O_KWT); bf16* VT = wsp<bf16>(p, O_VT);
    const float* GP = wsp<float>(p, WS_GP); const float* bif = p.in[I_BIF];
    float* CW = wsp<float>(p, WS_CW); float* FL = wsp<float>(p, WS_FLOOR); float* UN = wsp<float>(p, WS_UNITS); float* NLOC = wsp<float>(p, WS_NLOC);
    for (int unit = blockIdx.x; unit < NUNIT; unit += gridDim.x) {
        const int b = unit >> 7, h = (unit >> 5) & 3, c = unit & 31, tok0 = b * SEQ + c * CH;
        float bc = 0.f, a = 0.f, igv = 0.f;
        if (tid < 256) {
            float gi_ = bif[h], gf_ = bif[4 + h];
#pragma unroll
            for (int cb = 0; cb < 4; ++cb) { const float* g8 = GP + (size_t)cb * T * 8 + (size_t)(tok0 + tid) * 8; gi_ += g8[h]; gf_ += g8[4 + h]; }
            igv = gi_;
            float lf = fminf(gf_, 0.f) - log1pf(__expf(-fabsf(gf_)));
#pragma unroll
            for (int o = 1; o < 64; o <<= 1) { const float n = __shfl_up(lf, o); if (lane >= o) lf += n; }
            if (lane == 63) red[wave] = lf;
            bc = lf;
        }
        __syncthreads();
        if (tid < 256) {
            for (int w = 0; w < wave; ++w) bc += red[w];
            a = igv - bc;
            const float m = wave_max(a);
            if (lane == 0) red[8 + wave] = m;
        }
        __syncthreads();
        if (tid < 256) {
            const float amax = fmaxf(fmaxf(red[8], red[9]), fmaxf(red[10], red[11]));
            const float w = __expf(a - amax) * 0.0625f;
            wts[tid] = w; CW[unit * 256 + tid] = w; FL[unit * 256 + tid] = __expf(-bc - amax);
            if (tid == 255) { UN[unit * 2] = amax; UN[unit * 2 + 1] = bc; }
        }
        for (int which = 0; which < 2; ++which) {
            const bf16* src = which ? Vb : Kb; bf16* dst = (which ? VT : KWT) + (size_t)unit * 65536;
            __syncthreads();
#pragma unroll 4
            for (int i = 0; i < 16; ++i) { const int ch = tid + i * 512, row = ch >> 5, cc = ch & 31;
                const u32x4 v = *(const u32x4*)(src + (size_t)(tok0 + row) * DM + h * 256 + cc * 8);
                unsigned* d = (unsigned*)(tile + row * TP + cc * 8); d[0] = v.x; d[1] = v.y; d[2] = v.z; d[3] = v.w; }
            __syncthreads();
            if (which == 0 && tid < 256) { float s = 0.f; for (int r = 0; r < 256; ++r) s += bf2f(tile[r * TP + tid]) * wts[r]; NLOC[unit * 256 + tid] = s; }
            for (int i = 0; i < 16; ++i) {
                const int blk = wave + i * 8;
                const int d = (blk >> 3) * 16 + (lane >> 2), sc = (blk & 7) * 4 + (lane & 3);
                float e[8];
#pragma unroll
                for (int j = 0; j < 8; ++j) { e[j] = bf2f(tile[(sc * 8 + j) * TP + d]); if (which == 0) e[j] *= wts[sc * 8 + j]; }
                u32x4 o; o.x = pk2(e[0], e[1]); o.y = pk2(e[2], e[3]); o.z = pk2(e[4], e[5]); o.w = pk2(e[6], e[7]);
                *(u32x4*)(dst + (size_t)d * 256 + sc * 8) = o;
            }
        }
        __syncthreads();
    }
}
__device__ void ph_scan(const P& p) {
    const bf16* UT = wsp<bf16>(p, O_UT); bf16* CT = wsp<bf16>(p, O_CT);
    const float* UN = wsp<float>(p, WS_UNITS); const float* NLOC = wsp<float>(p, WS_NLOC); float* NS = wsp<float>(p, WS_NS);
    const int nth = gridDim.x * blockDim.x;
    for (int e8 = blockIdx.x * blockDim.x + otid(); e8 < 16 * 8192; e8 += nth) {
        const int bh = e8 >> 13, idx = e8 & 8191; const size_t off = (size_t)idx * 8;
        const bool don = idx < 32;
        float C[8], n[8]; float m = 0.f;
#pragma unroll
        for (int j = 0; j < 8; ++j) { C[j] = 0.f; n[j] = 0.f; }
        for (int c0 = 0; c0 < NCH; c0 += 8) {
            u32x4 uu[8]; float am[8], bl[8];
#pragma unroll
            for (int q = 0; q < 8; ++q) { const int unit = bh * 32 + c0 + q; uu[q] = *(const u32x4*)(UT + (size_t)unit * 65536 + off); am[q] = UN[unit * 2]; bl[q] = UN[unit * 2 + 1]; }
#pragma unroll
            for (int q = 0; q < 8; ++q) {
                const int unit = bh * 32 + c0 + q; const float amax = am[q], blast = bl[q]; const u32x4 u = uu[q];
                const float f1 = __expf(m - amax);
                u32x4 o; o.x = pk2(C[0] * f1, C[1] * f1); o.y = pk2(C[2] * f1, C[3] * f1); o.z = pk2(C[4] * f1, C[5] * f1); o.w = pk2(C[6] * f1, C[7] * f1);
                *(u32x4*)(CT + (size_t)unit * 65536 + off) = o;
                const float mnew = blast + fmaxf(m, amax), d1 = __expf(blast + m - mnew), d2 = __expf(blast + amax - mnew);
                C[0] = d1 * C[0] + d2 * bflo(u.x); C[1] = d1 * C[1] + d2 * bfhi(u.x); C[2] = d1 * C[2] + d2 * bflo(u.y); C[3] = d1 * C[3] + d2 * bfhi(u.y);
                C[4] = d1 * C[4] + d2 * bflo(u.z); C[5] = d1 * C[5] + d2 * bfhi(u.z); C[6] = d1 * C[6] + d2 * bflo(u.w); C[7] = d1 * C[7] + d2 * bfhi(u.w);
                if (don) {
#pragma unroll
                    for (int j = 0; j < 8; ++j) { NS[unit * 256 + idx * 8 + j] = n[j] * f1; n[j] = d1 * n[j] + d2 * NLOC[unit * 256 + idx * 8 + j]; } }
                m = mnew;
            }
        }
    }
}
constexpr int RP = 1032;
__device__ void ph_router(const P& p, float* lds) {
    const int tid = otid(), lane = tid & 63, wave = tid >> 6, tok = lane & 15, kg = lane >> 4;
    bf16* Wh = (bf16*)lds; bf16* Wl = Wh + 32 * RP;
    float* lg = lds + 33024 + wave * 512;
    float* cst = lds + 33024 + 4096;
    int* cnt = (int*)(cst + 32);
    float* rinv = cst + 64 + wave * 16;
    float* red = cst + 64 + 128;
    const float* X1 = wsp<float>(p, O_X1); const float* mod = wsp<float>(p, WS_MOD); unsigned char* HM = wsp<unsigned char>(p, O_HM);
    int* TOPI = wsp<int>(p, WS_TOPI); float* TOPW = wsp<float>(p, WS_TOPW); int* CNT = wsp<int>(p, WS_CNT);
    const float* wr = p.in[I_WR]; const float* gm = p.in[I_GMOE];
    for (int blk = blockIdx.x; blk < T / 128; blk += gridDim.x) {
        const int b = (blk * 128) / SEQ; const float* sc = mod + b * DIN + 4096; const float* sh = mod + b * DIN + 3072;
#pragma unroll 4
        for (int i = 0; i < 64; ++i) { const int idx = tid + i * 512, k = idx >> 5, e = idx & 31;
            const float v = wr[idx] * gm[k] * (1.f + sc[k]); const unsigned h = f2bf(v);
            Wh[e * RP + k] = (bf16)h; Wl[e * RP + k] = (bf16)f2bf(v - bf2f(h)); }
        { const int e = tid & 31, sl = tid >> 5; float a = 0.f;
            for (int k = sl * 64; k < sl * 64 + 64; ++k) a += sh[k] * wr[k * 32 + e];
            red[sl * 32 + e] = a; }
        __syncthreads();
        if (tid < 32) { float a = p.in[I_BR][tid];
#pragma unroll
            for (int sl = 0; sl < 16; ++sl) a += red[sl * 32 + tid];
            cst[tid] = a; cnt[tid] = 0; }
        __syncthreads();
        const int tb = blk * 128 + wave * 16;
        {
            const float* xr = X1 + (size_t)(tb + tok) * DM + kg * 8;
            f32x4 acc0 = {0.f, 0.f, 0.f, 0.f}, acc1 = {0.f, 0.f, 0.f, 0.f}; float ss = 0.f;
            const bf16* wh0 = Wh + tok * RP + kg * 8; const bf16* wl0 = Wl + tok * RP + kg * 8;
#pragma unroll 8
            for (int ks = 0; ks < 32; ++ks) {
                const f32x4 x0 = *(const f32x4*)(xr + ks * 32), x1 = *(const f32x4*)(xr + ks * 32 + 4);
                ss += (x0.x * x0.x + x0.y * x0.y) + (x0.z * x0.z + x0.w * x0.w) + (x1.x * x1.x + x1.y * x1.y) + (x1.z * x1.z + x1.w * x1.w);
                u32x4 hw; hw.x = cvtpk(x0.x, x0.y); hw.y = cvtpk(x0.z, x0.w); hw.z = cvtpk(x1.x, x1.y); hw.w = cvtpk(x1.z, x1.w);
                u32x4 lw; lw.x = cvtpk(x0.x - bflo(hw.x), x0.y - bfhi(hw.x)); lw.y = cvtpk(x0.z - bflo(hw.y), x0.w - bfhi(hw.y));
                lw.z = cvtpk(x1.x - bflo(hw.z), x1.y - bfhi(hw.z)); lw.w = cvtpk(x1.z - bflo(hw.w), x1.w - bfhi(hw.w));
                const bf16x8v ah = __builtin_bit_cast(bf16x8v, hw), al = __builtin_bit_cast(bf16x8v, lw);
                const bf16x8v bh0 = *(const bf16x8v*)(wh0 + ks * 32), bl0 = *(const bf16x8v*)(wl0 + ks * 32);
                const bf16x8v bh1 = *(const bf16x8v*)(wh0 + 16 * RP + ks * 32), bl1 = *(const bf16x8v*)(wl0 + 16 * RP + ks * 32);
                acc0 = __builtin_amdgcn_mfma_f32_16x16x32_bf16(ah, bh0, acc0, 0, 0, 0); acc1 = __builtin_amdgcn_mfma_f32_16x16x32_bf16(ah, bh1, acc1, 0, 0, 0);
                acc0 = __builtin_amdgcn_mfma_f32_16x16x32_bf16(ah, bl0, acc0, 0, 0, 0); acc1 = __builtin_amdgcn_mfma_f32_16x16x32_bf16(ah, bl1, acc1, 0, 0, 0);
                acc0 = __builtin_amdgcn_mfma_f32_16x16x32_bf16(al, bh0, acc0, 0, 0, 0); acc1 = __builtin_amdgcn_mfma_f32_16x16x32_bf16(al, bh1, acc1, 0, 0, 0);
            }
            ss += __shfl_xor(ss, 16); ss += __shfl_xor(ss, 32);
            if (kg == 0) rinv[tok] = rsqrtf(ss * (1.f / DM) + EPS);
#pragma unroll
            for (int r = 0; r < 4; ++r) { lg[(kg * 4 + r) * 32 + tok] = acc0[r]; lg[(kg * 4 + r) * 32 + 16 + tok] = acc1[r]; }
        }
        __builtin_amdgcn_s_waitcnt(0xc07f); asm volatile("" ::: "memory");
        if (lane < 16) {
            const float rr = rinv[lane]; float v[32];
#pragma unroll
            for (int e4 = 0; e4 < 8; ++e4) { const f32x4 t4 = *(const f32x4*)(lg + lane * 32 + e4 * 4), c4 = *(const f32x4*)(cst + e4 * 4);
                v[e4 * 4] = rr * t4.x + c4.x; v[e4 * 4 + 1] = rr * t4.y + c4.y; v[e4 * 4 + 2] = rr * t4.z + c4.z; v[e4 * 4 + 3] = rr * t4.w + c4.w; }
            float tv[4]; int ti[4];
#pragma unroll
            for (int k = 0; k < 4; ++k) { float m = v[0]; int idx = 0;
#pragma unroll
                for (int e = 1; e < 32; ++e) { if (v[e] > m) { m = v[e]; idx = e; } }
                tv[k] = m; ti[k] = idx;
#pragma unroll
                for (int e = 0; e < 32; ++e) if (e == idx) v[e] = -INFINITY; }
            const float e1 = __expf(tv[1] - tv[0]), e2 = __expf(tv[2] - tv[0]), e3 = __expf(tv[3] - tv[0]), inv = 1.f / (1.f + e1 + e2 + e3);
            const int t = tb + lane;
            *(int4*)(TOPI + t * 4) = make_int4(ti[0], ti[1], ti[2], ti[3]);
            *(f32x4*)(TOPW + t * 4) = (f32x4){inv, e1 * inv, e2 * inv, e3 * inv};
            atomicAdd(&cnt[ti[0]], 1); atomicAdd(&cnt[ti[1]], 1); atomicAdd(&cnt[ti[2]], 1); atomicAdd(&cnt[ti[3]], 1);
        }
        {
            f32x4 gs[4], hh[4];
#pragma unroll
            for (int j = 0; j < 4; ++j) { gs[j] = ((const f32x4*)gm)[lane + 64 * j] * (1.f + ((const f32x4*)sc)[lane + 64 * j]); hh[j] = ((const f32x4*)sh)[lane + 64 * j]; }
#pragma unroll 4
            for (int i = 0; i < 16; ++i) { const float r = rinv[i]; const size_t o = (size_t)(tb + i) * DM;
#pragma unroll
                for (int j = 0; j < 4; ++j) { const f32x4 x = (((const f32x4*)(X1 + o))[lane + 64 * j] * r * gs[j] + hh[j]) * S_HM;
                    ((unsigned*)(HM + o))[lane + 64 * j] = pk4_fp8(x.x, x.y, x.z, x.w); } }
        }
        __syncthreads();
        if (tid < 32) CNT[blk * 32 + tid] = cnt[tid];
        __syncthreads();
    }
}
__device__ void ph_scatter(const P& p, float* lds) {
    const int tid = otid(), lane = tid & 63, wave = tid >> 6;
    int* tot = (int*)lds; int* pre = tot + 32; int* startp = tot + 64; int* wc = tot + 128;
    const int* CNT = wsp<int>(p, WS_CNT); const int* TOPI = wsp<int>(p, WS_TOPI);
    int* ROWSLOT = wsp<int>(p, WS_ROWSLOT); int* TILEE = wsp<int>(p, WS_TILEE);
    int* ROWTOK = wsp<int>(p, WS_ROWTOK);
    for (int blk = blockIdx.x; blk < T / 128; blk += gridDim.x) {
        if (tid < 32) { int a = 0, b = 0; for (int j = 0; j < T / 128; ++j) { const int c = CNT[j * 32 + tid]; a += c; if (j < blk) b += c; } tot[tid] = a; pre[tid] = b; }
        __syncthreads();
        if (tid == 0) { int s = 0; for (int e = 0; e < 32; ++e) { startp[e] = s; s += (tot[e] + 255) & ~255; } startp[32] = s; }
        __syncthreads();
        if (blk == 0) {
            if (tid == 0) TILEE[MAXTILES] = startp[32] >> 8;
            for (int e = 0; e < 32; ++e) {
                const int s0 = startp[e], s1 = startp[e + 1];
                for (int tl = (s0 >> 8) + tid; tl < (s1 >> 8); tl += 512) TILEE[tl] = e;
                for (int r = s0 + tot[e] + tid; r < s1; r += 512) { ROWSLOT[r] = -1; ROWTOK[r] = 0; }
            }
        }
        const int slot = blk * 512 + tid, e = TOPI[slot];
        int lrank = 0;
        for (int ee = 0; ee < 32; ++ee) { const unsigned long long m = __ballot(e == ee);
            if (e == ee) lrank = __popcll(m & ((1ull << lane) - 1ull));
            if (lane == 0) wc[wave * 32 + ee] = __popcll(m); }
        __syncthreads();
        int base = startp[e] + pre[e] + lrank;
        for (int w = 0; w < wave; ++w) base += wc[w * 32 + e];
        ROWSLOT[base] = slot; ROWTOK[base] = slot >> 2;
        __syncthreads();
    }
}
__device__ void ph_final(const P& p) {
    const int tid = otid(), lane = tid & 63, gw = blockIdx.x * 8 + (tid >> 6), NGW = gridDim.x * 8;
    const float* X1 = wsp<float>(p, O_X1); const bf16* Y = wsp<bf16>(p, O_Y); const float* mod = wsp<float>(p, WS_MOD); const float* gf = p.in[I_GFIN];
    for (int t = gw; t < T; t += NGW) {
        const int b = t / SEQ; const float* gt2 = mod + b * DIN + 5120;
        f32x4 v[2][2]; float s = 0.f;
#pragma unroll
        for (int j = 0; j < 2; ++j) {
            f32x4 a0 = {0.f, 0.f, 0.f, 0.f}, a1 = {0.f, 0.f, 0.f, 0.f};
#pragma unroll
            for (int k = 0; k < 4; ++k) { const u32x4 u = ((const u32x4*)(Y + (size_t)(t * 4 + k) * DM))[lane + 64 * j];
                a0.x += bflo(u.x); a0.y += bfhi(u.x); a0.z += bflo(u.y); a0.w += bfhi(u.y); a1.x += bflo(u.z); a1.y += bfhi(u.z); a1.z += bflo(u.w); a1.w += bfhi(u.w); }
            const f32x4* xr = (const f32x4*)(X1 + (size_t)t * DM) + 2 * lane + 128 * j; const f32x4* gr = (const f32x4*)gt2 + 2 * lane + 128 * j;
            v[j][0] = xr[0] + gr[0] * a0; v[j][1] = xr[1] + gr[1] * a1;
#pragma unroll
            for (int h = 0; h < 2; ++h) s += (v[j][h].x * v[j][h].x + v[j][h].y * v[j][h].y) + (v[j][h].z * v[j][h].z + v[j][h].w * v[j][h].w);
        }
        const float r = rsqrtf(wave_sum(s) * (1.f / DM) + EPS);
#pragma unroll
        for (int j = 0; j < 2; ++j)
#pragma unroll
            for (int h = 0; h < 2; ++h) ((f32x4*)(p.out + (size_t)t * DM))[2 * lane + 128 * j + h] = v[j][h] * r * ((const f32x4*)gf)[2 * lane + 128 * j + h];
    }
}
__device__ __forceinline__ void unit_dec(int unit, int& tok0, int& h) { const int b = unit >> 7; h = (unit >> 5) & 3; tok0 = b * SEQ + (unit & 31) * CH; }

namespace pg8 {
typedef short bf16x8 __attribute__((ext_vector_type(8)));
constexpr int BM = 256, BK = 64, HALF = 128, HTB = HALF * BK * 2, STAGE_BYTES = 8 * HTB, NXCD = 8, WGM = 8;
__host__ __device__ __forceinline__ int lds_byte(int r, int c) { const int st = (r >> 4) * 2 + (c >> 5), rr = r & 15, cc = c & 31, ob = rr * 64 + cc * 2; return st * 1024 + (ob ^ (((ob >> 9) & 1) << 5)); }
__host__ __device__ __forceinline__ void stage_rc(int b, int& R, int& C) { const int st = b / 1024, sb = b % 1024, swz = sb ^ (((sb >> 9) & 1) << 5); R = (st >> 1) * 16 + swz / 64; C = (st & 1) * 32 + (swz % 64) / 2; }
__host__ __device__ __forceinline__ int perm32(int rho) { const int n = rho >> 4, i = rho & 15; return 8 * (i >> 2) + 4 * n + (i & 3); }
struct Unit { const char* a0; const char* a1; const char* b0; const char* b1; int pm, pn; };
struct Gemm { int lda, ldb, nt, nth; const int* rowtok; };
__device__ __forceinline__ unsigned cvt_pk_bf16(float lo, float hi) { unsigned r; asm volatile("v_cvt_pk_bf16_f32 %0, %1, %2" : "=v"(r) : "v"(lo), "v"(hi)); return r; }
__device__ __forceinline__ u32x4 pack8(const f32x4 v0, const f32x4 v1) { u32x4 w; w.x = cvt_pk_bf16(v0[0], v0[1]); w.y = cvt_pk_bf16(v0[2], v0[3]); w.z = cvt_pk_bf16(v1[0], v1[1]); w.w = cvt_pk_bf16(v1[2], v1[3]); return w; }

typedef int v4i_t __attribute__((ext_vector_type(4))); typedef int v8i_t __attribute__((ext_vector_type(8)));
__device__ __forceinline__ v8i_t cat8(const bf16x8 a, const bf16x8 b) { return __builtin_shufflevector(__builtin_bit_cast(v4i_t, a), __builtin_bit_cast(v4i_t, b), 0, 1, 2, 3, 4, 5, 6, 7); }
template <class Epi, class Sched, bool ALIGN_EPI, bool SPLITK = false, bool GATHER = false, bool FP8 = false>
__device__ __forceinline__ void gemm_phase(LAS unsigned char* lds, const Gemm g, const Sched& S, const Epi& E) {
    const int tid = otid(), wid = __builtin_amdgcn_readfirstlane(tid >> 6), lane = tid & 63, wr = wid >> 2, wc = wid & 3, fr = lane & 15, fq = lane >> 4;
    const int nt = g.nt, nth = g.nth;
    unsigned voffA[2], voffB[2];
#pragma unroll
    for (int i = 0; i < 2; ++i) { int R, C; stage_rc(tid * 16 + i * 8192, R, C); const int Rb = Epi::PERM ? ((R & ~31) + perm32(R & 31)) : R;
        voffA[i] = (unsigned)(R * g.lda + C) * 2u; voffB[i] = (unsigned)(Rb * g.ldb + C) * 2u; }
    LAS int* rt = (LAS int*)(lds + 131072); unsigned vC[2][2], vP[2][2];
    if constexpr (GATHER) { Unit uu; for (int i = 0; S.next(i, uu); ++i) if (tid < 256) rt[i * 256 + tid] = g.rowtok[uu.pm * 256 + tid];
        asm volatile("s_waitcnt vmcnt(0) lgkmcnt(0)" ::: "memory"); __builtin_amdgcn_s_barrier(); asm volatile("" ::: "memory"); }
#define PG8_ROWS(dst, iu) do { const int _t = otid(); _Pragma("unroll") for (int _i = 0; _i < 2; ++_i) { int _R, _C; stage_rc(_t * 16 + _i * 8192, _R, _C); _Pragma("unroll") for (int _h = 0; _h < 2; ++_h) dst[_h][_i] = (unsigned)rt[(iu) * 256 + _h * 128 + _R] * (unsigned)(g.lda * 2) + (unsigned)_C * 2u; } } while (0)
#define PG8_STAGE_A(bufoff, gbase, h, V) do { if constexpr (GATHER) { PG8_STAGE(bufoff, gbase, V[h]); } else { PG8_STAGE(bufoff, (gbase) + (h) * hstepA, voffA); } } while (0)
#define PG8_STAGE_A2(bufoff, gbase, h) do { if constexpr (GATHER) { if (last) { PG8_STAGE(bufoff, gbase, vP[h]); } else { PG8_STAGE(bufoff, gbase, vC[h]); } } else { PG8_STAGE(bufoff, (gbase) + (h) * hstepA, voffA); } } while (0)
    const size_t kstep = (size_t)(BK * 2);
    const size_t hstepA = (size_t)HALF * g.lda * 2, hstepB = (size_t)HALF * g.ldb * 2;
    const unsigned ldsw = (unsigned)wid * 1024u;
    const int aoff = FP8 ? lds_byte(wr * 64 + fr, fq * 16) : lds_byte(wr * 64 + fr, fq * 8), boff = FP8 ? lds_byte(wc * 32 + fr, fq * 16) : lds_byte(wc * 32 + fr, fq * 8);
    const int one8 = 0x7f7f7f7f;
    constexpr int F2 = FP8 ? 16 : 1024;
#define PG8_SA(b, h) (((b) * 2 + (h)) * HTB)
#define PG8_SB(b, h) ((4 + (b) * 2 + (h)) * HTB)
#define PG8_STAGE(bufoff, gbase, voff) do { _Pragma("unroll") for (int _i = 0; _i < 2; ++_i) \
        __builtin_amdgcn_global_load_lds((const unsigned*)((const char*)(gbase) + (voff)[_i]), (LAS unsigned*)(lds + (bufoff) + ldsw + _i * 8192), 16, 0, 0); } while (0)
#define PG8_LDA(dst, b, h) do { _Pragma("unroll") for (int m = 0; m < 4; ++m) { dst[m][0] = *(const LAS bf16x8*)(lds + PG8_SA(b, h) + aoff + m * 2048); dst[m][1] = *(const LAS bf16x8*)(lds + PG8_SA(b, h) + aoff + F2 + m * 2048); } } while (0)
#define PG8_LDB(dst, b, h) do { _Pragma("unroll") for (int n = 0; n < 2; ++n) { dst[n][0] = *(const LAS bf16x8*)(lds + PG8_SB(b, h) + boff + n * 2048); dst[n][1] = *(const LAS bf16x8*)(lds + PG8_SB(b, h) + boff + F2 + n * 2048); } } while (0)
#define PG8_MMA(ai, bj, At, Bt) do { __builtin_amdgcn_s_setprio(1); _Pragma("unroll") for (int m = 0; m < 4; ++m) _Pragma("unroll") for (int n = 0; n < 2; ++n) { \
        if constexpr (FP8) { const v8i_t b8_ = cat8(Bt[n][0], Bt[n][1]), a8_ = cat8(At[m][0], At[m][1]); asm volatile("v_mfma_scale_f32_16x16x128_f8f6f4 %0, %1, %2, %0, %3, %3 op_sel_hi:[0,0,0]" : "+v"(acc[ai][bj][m][n]) : "v"(b8_), "v"(a8_), "v"(one8)); } \
        else { _Pragma("unroll") for (int k = 0; k < 2; ++k) acc[ai][bj][m][n] = __builtin_amdgcn_mfma_f32_16x16x32_bf16(Bt[n][k], At[m][k], acc[ai][bj][m][n], 0, 0, 0); } } __builtin_amdgcn_s_setprio(0); } while (0)
#define PG8_WAIT_V(n) asm volatile("s_waitcnt vmcnt(" #n ")" ::: "memory")
#define PG8_WAIT_L(n) asm volatile("s_waitcnt lgkmcnt(" #n ")" ::: "memory")
#define PG8_BAR __builtin_amdgcn_s_barrier()
#define PG8_SCHED __builtin_amdgcn_sched_barrier(0)
    Unit cur, nxt; int ui = 0;
    if (!S.next(0, cur)) return;
    f32x4 acc[2][2][4][2];
#pragma unroll
    for (int a = 0; a < 2; ++a)
#pragma unroll
        for (int b = 0; b < 2; ++b)
#pragma unroll
            for (int m = 0; m < 4; ++m)
#pragma unroll
                for (int n = 0; n < 2; ++n) acc[a][b][m][n] = (f32x4){0.f, 0.f, 0.f, 0.f};
    bf16x8 At[4][2], B0[2][2], B1[2][2];
    {
        const char* cA = cur.a0; const char* cB = cur.b0;
        if constexpr (GATHER) { PG8_ROWS(vC, 0); }
        PG8_STAGE(PG8_SB(0, 0), cB, voffB); PG8_STAGE(PG8_SB(0, 1), cB + hstepB, voffB); PG8_STAGE_A(PG8_SA(0, 0), cA, 0, vC); PG8_STAGE_A(PG8_SA(0, 1), cA, 1, vC);
        if (wr == 1) PG8_BAR;
        PG8_WAIT_V(2); PG8_BAR;
        PG8_STAGE(PG8_SB(1, 0), cB + kstep, voffB); PG8_STAGE_A(PG8_SA(1, 0), cA + kstep, 0, vC); PG8_STAGE(PG8_SB(1, 1), cB + hstepB + kstep, voffB);
        PG8_WAIT_V(6); PG8_BAR;
    }
    for (;;) {
        const bool has_next = S.next(ui + 1, nxt);
        const char* nA = has_next ? nxt.a0 : cur.a0; const char* nB = has_next ? nxt.b0 : cur.b0;
        if constexpr (GATHER) { PG8_ROWS(vP, has_next ? ui + 1 : ui); }
#pragma unroll 1
        for (int t = 0; t < nt; t += 2) {
            const bool last = (t == nt - 2);
            const char *a1, *a2, *b2;
            if constexpr (SPLITK) {
                a1 = (t + 1 < nth) ? cur.a0 + (size_t)(t + 1) * kstep : cur.a1 + (size_t)(t + 1 - nth) * kstep;
                a2 = last ? nA : ((t + 2 < nth) ? cur.a0 + (size_t)(t + 2) * kstep : cur.a1 + (size_t)(t + 2 - nth) * kstep);
                b2 = last ? nB : ((t + 2 < nth) ? cur.b0 + (size_t)(t + 2) * kstep : cur.b1 + (size_t)(t + 2 - nth) * kstep);
            } else {
                a1 = cur.a0 + (size_t)(t + 1) * kstep; a2 = last ? nA : cur.a0 + (size_t)(t + 2) * kstep; b2 = last ? nB : cur.b0 + (size_t)(t + 2) * kstep;
            }
            const char* a3 = a2 + kstep; const char* b3 = b2 + kstep;
            unsigned v2[2][2];
            if constexpr (GATHER) {
#pragma unroll
                for (int _h = 0; _h < 2; ++_h)
#pragma unroll
                    for (int _i = 0; _i < 2; ++_i) v2[_h][_i] = last ? vP[_h][_i] : vC[_h][_i]; }
            PG8_LDB(B0, 0, 0); PG8_LDB(B1, 0, 1); PG8_SCHED; PG8_LDA(At, 0, 0); PG8_STAGE_A(PG8_SA(1, 1), a1, 1, vC);
            PG8_WAIT_V(8); PG8_WAIT_L(0); PG8_BAR; PG8_MMA(0, 0, At, B0); PG8_MMA(0, 1, At, B1); PG8_BAR; PG8_SCHED;
            PG8_LDA(At, 0, 1); PG8_STAGE(PG8_SB(0, 0), b2, voffB); PG8_STAGE(PG8_SB(0, 1), b2 + hstepB, voffB); PG8_STAGE_A(PG8_SA(0, 0), a2, 0, v2);
            PG8_WAIT_V(8); PG8_WAIT_L(0); PG8_BAR; PG8_MMA(1, 0, At, B0); PG8_MMA(1, 1, At, B1); PG8_BAR; PG8_SCHED;
            PG8_LDB(B0, 1, 0); PG8_LDB(B1, 1, 1); PG8_SCHED; PG8_LDA(At, 1, 0); PG8_STAGE_A(PG8_SA(0, 1), a2, 1, v2);
            PG8_WAIT_V(8); PG8_WAIT_L(0); PG8_BAR; PG8_MMA(0, 0, At, B0); PG8_MMA(0, 1, At, B1); PG8_BAR; PG8_SCHED;
            PG8_LDA(At, 1, 1); PG8_STAGE(PG8_SB(1, 0), b3, voffB); PG8_STAGE(PG8_SB(1, 1), b3 + hstepB, voffB); PG8_STAGE_A(PG8_SA(1, 0), a3, 0, v2);
            PG8_WAIT_V(8); PG8_WAIT_L(0); PG8_BAR; PG8_MMA(1, 0, At, B0); PG8_MMA(1, 1, At, B1); PG8_BAR; PG8_SCHED;
        }
        if constexpr (FP8) asm volatile("s_nop 15\n\ts_nop 15" ::: "memory");
        if constexpr (ALIGN_EPI) { if (wr == 0) PG8_BAR; }
        { int fr_ = fr, fq_ = fq; asm volatile("" : "+v"(fr_), "+v"(fq_)); E(acc, cur, wr, wc, fr_, fq_, lds); }
        if (!has_next) break;
#pragma unroll
        for (int a = 0; a < 2; ++a)
#pragma unroll
            for (int b = 0; b < 2; ++b)
#pragma unroll
                for (int m = 0; m < 4; ++m)
#pragma unroll
                    for (int n = 0; n < 2; ++n) acc[a][b][m][n] = (f32x4){0.f, 0.f, 0.f, 0.f};
        cur = nxt; ++ui;
        if constexpr (GATHER) {
#pragma unroll
            for (int _h = 0; _h < 2; ++_h)
#pragma unroll
                for (int _i = 0; _i < 2; ++_i) vC[_h][_i] = vP[_h][_i]; }
        if constexpr (ALIGN_EPI) { if (wr == 1) PG8_BAR; }
    }
    PG8_WAIT_V(0);
    if constexpr (!ALIGN_EPI) { if (wr == 0) PG8_BAR; }
    PG8_BAR;
#undef PG8_SA
#undef PG8_SB
#undef PG8_STAGE
#undef PG8_STAGE_A
#undef PG8_STAGE_A2
#undef PG8_ROWS
#undef PG8_LDA
#undef PG8_LDB
#undef PG8_MMA
#undef PG8_WAIT_V
#undef PG8_WAIT_L
#undef PG8_BAR
#undef PG8_SCHED
}
struct DenseOrder {
    int nM, nN, nwg, G, c; const char* A; const char* B; size_t tA, tB;
    __device__ void init(int nM_, int nN_, int G_, int c_, const void* A_, int lda, const void* B_, int ldb) { nM = nM_; nN = nN_; nwg = nM * nN; G = G_; c = c_; A = (const char*)A_; B = (const char*)B_; tA = (size_t)BM * lda * 2; tB = (size_t)BM * ldb * 2; }
    __device__ __forceinline__ bool tile(int i, int& pm, int& pn) const {
        const long L = (long)i * G + c; if (L >= nwg) return false;
        int wgid = (int)L; { const int q = nwg / NXCD, r = nwg % NXCD, xcd = wgid % NXCD, off = wgid / NXCD; wgid = (xcd < r ? xcd * (q + 1) : r * (q + 1) + (xcd - r) * q) + off; }
        const int nig = WGM * nN, gid = wgid / nig, fm = gid * WGM, gsz = (nM - fm) < WGM ? (nM - fm) : WGM;
        pm = fm + ((wgid % nig) % gsz); pn = (wgid % nig) / gsz; return true;
    }
    __device__ __forceinline__ bool next(int i, Unit& u) const { int pm, pn; if (!tile(i, pm, pn)) return false; u.pm = pm; u.pn = pn; u.a0 = A + pm * tA; u.b0 = B + pn * tB; u.a1 = u.a0; u.b1 = u.b0; return true; }
};
struct MoeOrder : DenseOrder {
    const int* tile_e; bool gather;
    __device__ __forceinline__ bool next(int i, Unit& u) const { int pm, pn; if (!tile(i, pm, pn)) return false; const int e = tile_e[pm];
        u.pm = pm; u.pn = pn; u.a0 = gather ? A : A + pm * tA; u.b0 = B + ((size_t)e * nN + pn) * tB; u.a1 = u.a0; u.b1 = u.b0; return true; }
};
template <int KIND> struct BatchOrder {
    int G, c; const char* ws;
    __device__ __forceinline__ bool next(int i, Unit& u) const {
        const int unit = i * G + c; if (unit >= NUNIT) return false;
        int t0, h; unit_dec(unit, t0, h); const size_t rowoff = ((size_t)t0 * DM + h * 256) * 2, uoff = (size_t)unit * 131072;
        u.pm = unit; u.pn = 0;
        if (KIND == 0) { u.a0 = ws + O_VT + uoff; u.b0 = ws + O_KWT + uoff; u.a1 = u.a0; u.b1 = u.b0; }
        else if (KIND == 1) { u.a0 = ws + O_Q + rowoff; u.b0 = ws + O_K + rowoff; u.a1 = u.a0; u.b1 = u.b0; }
        else { u.a0 = ws + O_SP + rowoff; u.a1 = ws + O_Q + rowoff; u.b0 = ws + O_VT + uoff; u.b1 = ws + O_CT + uoff; }
        return true;
    }
};
__device__ __forceinline__ f32x4 sig4(const f32x4 v) { f32x4 r; r[0] = sigm(v[0]); r[1] = sigm(v[1]); r[2] = sigm(v[2]); r[3] = sigm(v[3]); return r; }
__device__ __forceinline__ f32x4 lo4(const u32x4 w) { return (f32x4){bflo(w.x), bfhi(w.x), bflo(w.y), bfhi(w.y)}; }
__device__ __forceinline__ f32x4 hi4(const u32x4 w) { return (f32x4){bflo(w.z), bfhi(w.z), bflo(w.w), bfhi(w.w)}; }
typedef f32x4 Acc[2][2][4][2];
struct EpiIn {
    static constexpr bool PERM = true; unsigned char* ws;
    __device__ __forceinline__ void operator()(const Acc& acc, const Unit& u, int wr, int wc, int fr, int fq, LAS unsigned char*) const {
        const int row0 = u.pm * BM + wr * 64 + fr;
        if (u.pn < 8) {
            bf16* O = (bf16*)(ws + O_U1) + u.pn * 128 + wc * 32 + 8 * fq;
#pragma unroll
            for (int ai = 0; ai < 2; ++ai)
#pragma unroll
                for (int m = 0; m < 4; ++m) { const f32x4 v0 = acc[ai][0][m][0] * sig4(acc[ai][1][m][0]), v1 = acc[ai][0][m][1] * sig4(acc[ai][1][m][1]);
                    *(u32x4*)(O + (size_t)(row0 + ai * HALF + m * 16) * DM) = pack8(v0, v1); }
        } else {
            const int t = (u.pn - 8) >> 2; const size_t so = t == 0 ? O_XM : t == 1 ? O_SO : t == 2 ? O_SZA : O_SZB;
            bf16* O = (bf16*)(ws + so) + ((u.pn - 8) & 3) * 256 + wc * 32 + 8 * fq;
#pragma unroll
            for (int ai = 0; ai < 2; ++ai)
#pragma unroll
                for (int m = 0; m < 4; ++m)
#pragma unroll
                    for (int bj = 0; bj < 2; ++bj) { f32x4 v0 = acc[ai][bj][m][0], v1 = acc[ai][bj][m][1]; if (t > 0) { v0 = sig4(v0); v1 = sig4(v1); }
                        *(u32x4*)(O + (size_t)(row0 + ai * HALF + m * 16) * DM + bj * HALF) = pack8(v0, v1); }
        }
    }
};
struct EpiPw {
    static constexpr bool PERM = true; unsigned char* ws; const float* bias;
    __device__ __forceinline__ void operator()(const Acc& acc, const Unit& u, int wr, int wc, int fr, int fq, LAS unsigned char*) const {
        const int row0 = u.pm * BM + wr * 64 + fr, col0 = u.pn * BM + wc * 32 + 8 * fq;
        f32x4 bb[2][2];
#pragma unroll
        for (int bj = 0; bj < 2; ++bj) { bb[bj][0] = *(const f32x4*)(bias + col0 + bj * HALF); bb[bj][1] = *(const f32x4*)(bias + col0 + bj * HALF + 4); }
#pragma unroll
        for (int ai = 0; ai < 2; ++ai) {
            u32x4 z[4][2];
#pragma unroll
            for (int m = 0; m < 4; ++m)
#pragma unroll
                for (int bj = 0; bj < 2; ++bj) z[m][bj] = *(const u32x4*)((const bf16*)(ws + O_SZA) + (size_t)(row0 + ai * HALF + m * 16) * DM + col0 + bj * HALF);
            asm volatile("" ::: "memory");
#pragma unroll
            for (int m = 0; m < 4; ++m)
#pragma unroll
                for (int bj = 0; bj < 2; ++bj) { const size_t o = (size_t)(row0 + ai * HALF + m * 16) * DM + col0 + bj * HALF;
                    *(u32x4*)((bf16*)(ws + O_YAG) + o) = pack8(lo4(z[m][bj]) * (acc[ai][bj][m][0] + bb[bj][0]), hi4(z[m][bj]) * (acc[ai][bj][m][1] + bb[bj][1])); }
            asm volatile("" ::: "memory");
        }
    }
};
struct EpiMo {
    static constexpr bool PERM = true; unsigned char* ws;
    __device__ __forceinline__ void operator()(const Acc& acc, const Unit& u, int wr, int wc, int fr, int fq, LAS unsigned char*) const {
        const int row0 = u.pm * BM + wr * 64 + fr, col0 = u.pn * BM + wc * 32 + 8 * fq;
#pragma unroll
        for (int am = 0; am < 4; ++am) {
            const int ai = am >> 1;
            u32x4 z[2][2], y[2][2];
#pragma unroll
            for (int mm = 0; mm < 2; ++mm)
#pragma unroll
                for (int bj = 0; bj < 2; ++bj) { const size_t o = (size_t)(row0 + ai * HALF + ((am & 1) * 2 + mm) * 16) * DM + col0 + bj * HALF;
                    z[mm][bj] = *(const u32x4*)((const bf16*)(ws + O_SZB) + o); y[mm][bj] = *(const u32x4*)((const bf16*)(ws + O_YAG) + o); }
            asm volatile("" ::: "memory");
#pragma unroll
            for (int mm = 0; mm < 2; ++mm)
#pragma unroll
                for (int bj = 0; bj < 2; ++bj) { const int m = (am & 1) * 2 + mm; const size_t o = (size_t)(row0 + ai * HALF + m * 16) * DM + col0 + bj * HALF;
                    *(u32x4*)((bf16*)(ws + O_MERGED) + o) = pack8(lo4(y[mm][bj]) + lo4(z[mm][bj]) * acc[ai][bj][m][0], hi4(y[mm][bj]) + hi4(z[mm][bj]) * acc[ai][bj][m][1]); }
            asm volatile("" ::: "memory");
        }
    }
};
struct EpiOut {
    static constexpr bool PERM = false; unsigned char* ws; const float* x;
    __device__ __forceinline__ void operator()(const Acc& acc, const Unit& u, int wr, int wc, int fr, int fq, LAS unsigned char*) const {
        const int row0 = u.pm * BM + wr * 64 + fr, col0 = u.pn * BM + wc * 32 + 4 * fq, b = (u.pm * BM) / SEQ;
        const float* gt = (const float*)(ws + WS_MOD) + b * DIN + 2048; float* X1 = (float*)(ws + O_X1);
        f32x4 gv[2][2];
#pragma unroll
        for (int bj = 0; bj < 2; ++bj)
#pragma unroll
            for (int n = 0; n < 2; ++n) gv[bj][n] = *(const f32x4*)(gt + col0 + bj * HALF + n * 16);
#pragma unroll
        for (int am = 0; am < 4; ++am) {
            const int ai = am >> 1;
            f32x4 xr[2][2][2];
#pragma unroll
            for (int mm = 0; mm < 2; ++mm)
#pragma unroll
                for (int bj = 0; bj < 2; ++bj)
#pragma unroll
                    for (int n = 0; n < 2; ++n) xr[mm][bj][n] = *(const f32x4*)(x + (size_t)(row0 + ai * HALF + ((am & 1) * 2 + mm) * 16) * DM + col0 + bj * HALF + n * 16);
            asm volatile("" ::: "memory");
#pragma unroll
            for (int mm = 0; mm < 2; ++mm)
#pragma unroll
                for (int bj = 0; bj < 2; ++bj)
#pragma unroll
                    for (int n = 0; n < 2; ++n) { const int m = (am & 1) * 2 + mm; *(f32x4*)(X1 + (size_t)(row0 + ai * HALF + m * 16) * DM + col0 + bj * HALF + n * 16) = xr[mm][bj][n] + gv[bj][n] * acc[ai][bj][m][n]; }
            asm volatile("" ::: "memory");
        }
    }
};
struct EpiU {
    static constexpr bool PERM = true; unsigned char* ws;
    __device__ __forceinline__ void operator()(const Acc& acc, const Unit& u, int wr, int wc, int fr, int fq, LAS unsigned char*) const {
        bf16* O = (bf16*)(ws + O_UT) + (size_t)u.pm * 65536 + (wr * 64 + fr) * 256 + wc * 32 + 8 * fq;
#pragma unroll
        for (int ai = 0; ai < 2; ++ai)
#pragma unroll
            for (int m = 0; m < 4; ++m)
#pragma unroll
                for (int bj = 0; bj < 2; ++bj) *(u32x4*)(O + (ai * HALF + m * 16) * 256 + bj * HALF) = pack8(acc[ai][bj][m][0], acc[ai][bj][m][1]);
    }
};
struct EpiS {
    static constexpr bool PERM = true; unsigned char* ws;
    __device__ __forceinline__ void operator()(const Acc& acc, const Unit& u, int wr, int wc, int fr, int fq, LAS unsigned char*) const {
        int t0, h; unit_dec(u.pm, t0, h);
        const int r0 = wr * 64 + fr, c0 = wc * 32 + 8 * fq;
        const float* cw = (const float*)(ws + WS_CW) + u.pm * 256 + c0; float* denp = (float*)(ws + WS_DENP) + (size_t)u.pm * 1024;
        bf16* O = (bf16*)(ws + O_SP) + (size_t)t0 * DM + h * 256 + c0;
        f32x4 w[2][2];
#pragma unroll
        for (int bj = 0; bj < 2; ++bj)
#pragma unroll
            for (int n = 0; n < 2; ++n) w[bj][n] = *(const f32x4*)(cw + bj * HALF + 4 * n);
#pragma unroll
        for (int ai = 0; ai < 2; ++ai)
#pragma unroll
            for (int m = 0; m < 4; ++m) { const int r = r0 + ai * HALF + m * 16; float rs = 0.f;
#pragma unroll
                for (int bj = 0; bj < 2; ++bj) { f32x4 v[2];
#pragma unroll
                    for (int n = 0; n < 2; ++n) { v[n] = acc[ai][bj][m][n] * w[bj][n]; const int c = c0 + bj * HALF + 4 * n;
#pragma unroll
                        for (int j = 0; j < 4; ++j) { if (c + j > r) v[n][j] = 0.f; rs += v[n][j]; } }
                    *(u32x4*)(O + (size_t)r * DM + bj * HALF) = pack8(v[0], v[1]); }
                rs += __shfl_xor(rs, 16); rs += __shfl_xor(rs, 32);
                if (fq == 0) denp[r * 4 + wc] = rs;
                asm volatile("" ::: "memory"); }
    }
};
struct EpiO {
    static constexpr bool PERM = true; unsigned char* ws; const float* hng; const float* skip;
    __device__ __forceinline__ void operator()(Acc& acc, const Unit& u, int wr, int wc, int fr, int fq, LAS unsigned char* lds) const {
        int t0, h; unit_dec(u.pm, t0, h);
        LAS float* inv = (LAS float*)(lds + 131072);
        LAS float* PS = inv + 256;
        LAS float* nsl = PS + 2048;
        const int tid = otid();
        const int r0 = wr * 64 + fr, c0 = wc * 32 + 8 * fq;
        {
            const int row = tid >> 1, hf = tid & 1;
            const bf16* q = (const bf16*)(ws + O_Q) + (size_t)(t0 + row) * DM + h * 256 + hf * 128;
            u32x4 qq[8];
#pragma unroll
            for (int i = 0; i < 8; ++i) qq[i] = ((const u32x4*)q)[i];
            const f32x4 dp = *(const f32x4*)((const float*)(ws + WS_DENP) + (size_t)u.pm * 1024 + row * 4); const float fl = ((const float*)(ws + WS_FLOOR))[u.pm * 256 + row];
            if (tid < 256) nsl[tid] = ((const float*)(ws + WS_NS))[u.pm * 256 + tid];
            asm volatile("s_waitcnt vmcnt(0) lgkmcnt(0)" ::: "memory"); __builtin_amdgcn_s_barrier(); asm volatile("" ::: "memory");
            float s = 0.f;
#pragma unroll
            for (int hh = 0; hh < 2; ++hh) {
                if (hh == 1) {
#pragma unroll
                    for (int i = 0; i < 8; ++i) qq[i] = ((const u32x4*)q)[8 + i];
                    asm volatile("" ::: "memory"); }
#pragma unroll
                for (int i = 0; i < 8; ++i) { const f32x4 n0 = *(const LAS f32x4*)(nsl + hf * 128 + 64 * hh + 8 * i), n1 = *(const LAS f32x4*)(nsl + hf * 128 + 64 * hh + 8 * i + 4); const f32x4 a = lo4(qq[i]) * n0 + hi4(qq[i]) * n1; s += (a[0] + a[1]) + (a[2] + a[3]); }
            }
            s += __shfl_xor(s, 1);
            if (hf == 0) { const float den = s + (dp[0] + dp[1]) + (dp[2] + dp[3]); inv[row] = __builtin_amdgcn_rcpf(fmaxf(fabsf(den), fl)); }
        }
        u32x4 gin[4][2];
        asm volatile("s_waitcnt lgkmcnt(0)" ::: "memory"); __builtin_amdgcn_s_barrier(); asm volatile("" ::: "memory");
#pragma unroll
        for (int ai = 0; ai < 2; ++ai) {
#pragma unroll
            for (int m = 0; m < 4; ++m)
#pragma unroll
                for (int bj = 0; bj < 2; ++bj) gin[m][bj] = *(const u32x4*)((const bf16*)(ws + O_SO) + (size_t)(t0 + r0 + ai * HALF + m * 16) * DM + h * 256 + c0 + bj * HALF);
            asm volatile("" ::: "memory");
#pragma unroll
            for (int m = 0; m < 4; ++m) { const int r = r0 + ai * HALF + m * 16; const float iv = inv[r]; float s = 0.f, q = 0.f;
#pragma unroll
                for (int bj = 0; bj < 2; ++bj) { const u32x4 so = gin[m][bj];
                    const f32x4 v0 = acc[ai][bj][m][0] * iv * lo4(so), v1 = acc[ai][bj][m][1] * iv * hi4(so); acc[ai][bj][m][0] = v0; acc[ai][bj][m][1] = v1;
                    s += (v0[0] + v0[1]) + (v0[2] + v0[3]) + (v1[0] + v1[1]) + (v1[2] + v1[3]);
                    q += (v0[0] * v0[0] + v0[1] * v0[1]) + (v0[2] * v0[2] + v0[3] * v0[3]) + (v1[0] * v1[0] + v1[1] * v1[1]) + (v1[2] * v1[2] + v1[3] * v1[3]); }
                s += __shfl_xor(s, 16); s += __shfl_xor(s, 32); q += __shfl_xor(q, 16); q += __shfl_xor(q, 32);
                if (fq == 0) { PS[(r * 4 + wc) * 2] = s; PS[(r * 4 + wc) * 2 + 1] = q; } }
            asm volatile("" ::: "memory");
        }
        f32x4 g[2][2], sk[2][2];
#pragma unroll
        for (int bj = 0; bj < 2; ++bj)
#pragma unroll
            for (int n = 0; n < 2; ++n) { g[bj][n] = *(const f32x4*)(hng + h * 256 + c0 + bj * HALF + 4 * n); sk[bj][n] = *(const f32x4*)(skip + h * 256 + c0 + bj * HALF + 4 * n); }
        asm volatile("s_waitcnt lgkmcnt(0)" ::: "memory"); __builtin_amdgcn_s_barrier(); asm volatile("" ::: "memory");
#pragma unroll
        for (int ai = 0; ai < 2; ++ai) {
#pragma unroll
            for (int m = 0; m < 4; ++m)
#pragma unroll
                for (int bj = 0; bj < 2; ++bj) gin[m][bj] = *(const u32x4*)((const bf16*)(ws + O_XC) + (size_t)(t0 + r0 + ai * HALF + m * 16) * DM + h * 256 + c0 + bj * HALF);
            asm volatile("" ::: "memory");
#pragma unroll
            for (int m = 0; m < 4; ++m) { const int r = r0 + ai * HALF + m * 16;
                const f32x4 p0 = *(const LAS f32x4*)(PS + r * 8), p1 = *(const LAS f32x4*)(PS + r * 8 + 4);
                const float mu = ((p0[0] + p0[2]) + (p1[0] + p1[2])) * (1.f / 256.f), ex2 = ((p0[1] + p0[3]) + (p1[1] + p1[3])) * (1.f / 256.f), rs = rsqrtf(fmaxf(ex2 - mu * mu, 0.f) + EPS);
#pragma unroll
                for (int bj = 0; bj < 2; ++bj) { const size_t o = (size_t)(t0 + r) * DM + h * 256 + c0 + bj * HALF; const u32x4 xc = gin[m][bj];
                    const f32x4 v0 = (acc[ai][bj][m][0] - mu) * rs * g[bj][0] + sk[bj][0] * lo4(xc), v1 = (acc[ai][bj][m][1] - mu) * rs * g[bj][1] + sk[bj][1] * hi4(xc);
                    *(u32x4*)((bf16*)(ws + O_MOIN) + o) = pack8(v0, v1); } }
            asm volatile("" ::: "memory");
        }
        asm volatile("s_waitcnt lgkmcnt(0)" ::: "memory"); __builtin_amdgcn_s_barrier(); asm volatile("" ::: "memory");
    }
};
struct EpiGu {
    static constexpr bool PERM = true; unsigned char* ws; const float* bgu;
    __device__ __forceinline__ void operator()(const Acc& acc, const Unit& u, int wr, int wc, int fr, int fq, LAS unsigned char*) const {
        const int e = ((const int*)(ws + WS_TILEE))[u.pm]; const int ch0 = u.pn * 128 + wc * 32 + 8 * fq;
        const float* bb = bgu + e * 2048 + ch0;
        const f32x4 bg0 = *(const f32x4*)(bb), bg1 = *(const f32x4*)(bb + 4), bu0 = *(const f32x4*)(bb + 1024), bu1 = *(const f32x4*)(bb + 1028);
        unsigned char* O = ws + O_ACT + (size_t)(u.pm * BM + wr * 64 + fr) * DM + ch0;
        constexpr float ds = 1.f / (S_HM * S_W);
#pragma unroll
        for (int ai = 0; ai < 2; ++ai)
#pragma unroll
            for (int m = 0; m < 4; ++m) { f32x4 v[2];
#pragma unroll
                for (int n = 0; n < 2; ++n) { const f32x4 gt = acc[ai][0][m][n] * ds + (n ? bg1 : bg0), up = acc[ai][1][m][n] * ds + (n ? bu1 : bu0);
#pragma unroll
                    for (int j = 0; j < 4; ++j) { const float gg = fminf(gt[j], 7.f), uu = __builtin_amdgcn_fmed3f(up[j], -7.f, 7.f);
                        const float sg = __builtin_amdgcn_rcpf(1.f + __builtin_amdgcn_exp2f(gg * (-1.702f * 1.4426950408889634f)));
                        v[n][j] = (uu * S_ACT + S_ACT) * (gg * sg); } }
                u32x2 w8; w8.x = pk4_fp8_nc(v[0][0], v[0][1], v[0][2], v[0][3]); w8.y = pk4_fp8_nc(v[1][0], v[1][1], v[1][2], v[1][3]);
                *(u32x2*)(O + (size_t)(ai * HALF + m * 16) * DM) = w8; }
    }
};
struct EpiDn {
    static constexpr bool PERM = true; unsigned char* ws; const float* bdn;
    __device__ __forceinline__ void operator()(const Acc& acc, const Unit& u, int wr, int wc, int fr, int fq, LAS unsigned char*) const {
        const int e = ((const int*)(ws + WS_TILEE))[u.pm]; const int col0 = u.pn * BM + wc * 32 + 8 * fq, row0 = u.pm * BM + wr * 64 + fr;
        const int* rowslot = (const int*)(ws + WS_ROWSLOT); const float* topw = (const float*)(ws + WS_TOPW); bf16* Y = (bf16*)(ws + O_Y);
        f32x4 b[2][2];
#pragma unroll
        for (int bj = 0; bj < 2; ++bj)
#pragma unroll
            for (int n = 0; n < 2; ++n) b[bj][n] = *(const f32x4*)(bdn + e * DM + col0 + bj * HALF + 4 * n);
        int slot[2][4]; float w[2][4];
#pragma unroll
        for (int ai = 0; ai < 2; ++ai)
#pragma unroll
            for (int m = 0; m < 4; ++m) slot[ai][m] = rowslot[row0 + ai * HALF + m * 16];
#pragma unroll
        for (int ai = 0; ai < 2; ++ai)
#pragma unroll
            for (int m = 0; m < 4; ++m) w[ai][m] = slot[ai][m] >= 0 ? topw[slot[ai][m]] : 0.f;
        asm volatile("" ::: "memory");
#pragma unroll
        for (int ai = 0; ai < 2; ++ai)
#pragma unroll
            for (int m = 0; m < 4; ++m) if (slot[ai][m] >= 0) {
#pragma unroll
                for (int bj = 0; bj < 2; ++bj) *(u32x4*)(Y + (size_t)slot[ai][m] * DM + col0 + bj * HALF) = pack8((acc[ai][bj][m][0] * (1.f / (S_ACT * S_W)) + b[bj][0]) * w[ai][m], (acc[ai][bj][m][1] * (1.f / (S_ACT * S_W)) + b[bj][1]) * w[ai][m]); }
    }
};
}


__device__ __forceinline__ void ph_g_in(const P& p, LAS unsigned char* lds) {
    pg8::Gemm g{DM, DM, 16, 16, nullptr}; pg8::DenseOrder S; S.init(T / 256, DIN / 256, gridDim.x, blockIdx.x, p.ws + O_HA, DM, p.ws + WS_WIN, DM);
    pg8::EpiIn E{p.ws}; pg8::gemm_phase<pg8::EpiIn, pg8::DenseOrder, true>(lds, g, S, E);
}
__device__ __forceinline__ void ph_g_pw(const P& p, LAS unsigned char* lds) {
    pg8::Gemm g{DM, DM, 16, 16, nullptr}; pg8::DenseOrder S; S.init(T / 256, 4, gridDim.x, blockIdx.x, p.ws + O_YAPRE, DM, p.ws + WS_WPW, DM);
    pg8::EpiPw E{p.ws, p.in[I_BPW]}; pg8::gemm_phase<pg8::EpiPw, pg8::DenseOrder, true>(lds, g, S, E);
}
__device__ __forceinline__ void ph_g_mo(const P& p, LAS unsigned char* lds) {
    pg8::Gemm g{DM, DM, 16, 16, nullptr}; pg8::DenseOrder S; S.init(T / 256, 4, gridDim.x, blockIdx.x, p.ws + O_MOIN, DM, p.ws + WS_WMO, DM);
    pg8::EpiMo E{p.ws}; pg8::gemm_phase<pg8::EpiMo, pg8::DenseOrder, true>(lds, g, S, E);
}
__device__ __forceinline__ void ph_g_out(const P& p, LAS unsigned char* lds) {
    pg8::Gemm g{DM, DM, 16, 16, nullptr}; pg8::DenseOrder S; S.init(T / 256, 4, gridDim.x, blockIdx.x, p.ws + O_MERGED, DM, p.ws + WS_WOUT, DM);
    pg8::EpiOut E{p.ws, p.in[I_X]}; pg8::gemm_phase<pg8::EpiOut, pg8::DenseOrder, true>(lds, g, S, E);
}
__device__ __forceinline__ void ph_g_u(const P& p, LAS unsigned char* lds) {
    pg8::Gemm g{256, 256, 4, 4, nullptr}; pg8::BatchOrder<0> S{(int)gridDim.x, (int)blockIdx.x, (const char*)p.ws};
    pg8::EpiU E{p.ws}; pg8::gemm_phase<pg8::EpiU, pg8::BatchOrder<0>, true>(lds, g, S, E);
}
__device__ __forceinline__ void ph_g_s(const P& p, LAS unsigned char* lds) {
    pg8::Gemm g{DM, DM, 4, 4, nullptr}; pg8::BatchOrder<1> S{(int)gridDim.x, (int)blockIdx.x, (const char*)p.ws};
    pg8::EpiS E{p.ws}; pg8::gemm_phase<pg8::EpiS, pg8::BatchOrder<1>, true>(lds, g, S, E);
}
__device__ __forceinline__ void ph_g_o(const P& p, LAS unsigned char* lds) {
    pg8::Gemm g{DM, 256, 8, 4, nullptr}; pg8::BatchOrder<2> S{(int)gridDim.x, (int)blockIdx.x, (const char*)p.ws};
    pg8::EpiO E{p.ws, p.in[I_HNG], p.in[I_SKIP]}; pg8::gemm_phase<pg8::EpiO, pg8::BatchOrder<2>, true, true>(lds, g, S, E);
}
__device__ __forceinline__ void ph_g_gu(const P& p, LAS unsigned char* lds) {
    const int nt_ = __builtin_amdgcn_readfirstlane(wsp<int>(p, WS_TILEE)[MAXTILES]);
    pg8::Gemm g{512, 512, 8, 8, wsp<int>(p, WS_ROWTOK)}; pg8::MoeOrder S; S.init(nt_, 8, gridDim.x, blockIdx.x, p.ws + O_HM, 512, p.ws + WS_WGU, 512); S.tile_e = wsp<int>(p, WS_TILEE); S.gather = true;
    pg8::EpiGu E{p.ws, p.in[I_BGU]}; pg8::gemm_phase<pg8::EpiGu, pg8::MoeOrder, true, false, true, true>(lds, g, S, E);
}
__device__ __forceinline__ void ph_g_dn(const P& p, LAS unsigned char* lds) {
    const int nt_ = __builtin_amdgcn_readfirstlane(wsp<int>(p, WS_TILEE)[MAXTILES]);
    pg8::Gemm g{512, 512, 8, 8, nullptr}; pg8::MoeOrder S; S.init(nt_, 4, gridDim.x, blockIdx.x, p.ws + O_ACT, 512, p.ws + WS_WDN, 512); S.tile_e = wsp<int>(p, WS_TILEE); S.gather = false;
    pg8::EpiDn E{p.ws, p.in[I_BDN]}; pg8::gemm_phase<pg8::EpiDn, pg8::MoeOrder, true, false, false, true>(lds, g, S, E);
}

#define XB_TMO      128
#define XB_XCNT(j)  (256  + 64 * (j))
#define XB_XSUB(j)  (1280 + 64 * (j))
#define XB_XGEN(j)  (2304 + 64 * (j))
#define XB_TOP      3328
#define XB_TOPGEN   3392
#define XCD_BAR_WORDS 3456
#define XB_SPIN_CAP (1u << 18)
__device__ __forceinline__ unsigned xb_ld(unsigned* p)              { return __hip_atomic_load(p, __ATOMIC_RELAXED, __HIP_MEMORY_SCOPE_AGENT); }
__device__ __forceinline__ unsigned xb_add(unsigned* p, unsigned v) { return __hip_atomic_fetch_add(p, v, __ATOMIC_RELAXED, __HIP_MEMORY_SCOPE_AGENT); }
__device__ __forceinline__ unsigned xb_xcc_id() { return (unsigned)__builtin_amdgcn_s_getreg((3 << 11) | 20) & 0xFu; }
#define XB_SPIN(cond, bar) do { unsigned _sp = 0; while (cond) { __builtin_amdgcn_s_sleep(1); \
    if ((++_sp & 255u) == 0u) { if (xb_ld(&(bar)[XB_TMO])) break; if (_sp > XB_SPIN_CAP) { atomicAdd(&(bar)[XB_TMO], 1u); break; } } } } while (0)
struct XcdBarrier { unsigned* bar; unsigned x; volatile LAS unsigned* st; };
__device__ __forceinline__ XcdBarrier xcd_barrier_post(unsigned* bar, volatile LAS unsigned* st) {
    XcdBarrier b; b.bar = bar; b.x = xb_xcc_id(); b.st = st;
    if (threadIdx.x == 0) (void)xb_add(&bar[XB_XCNT(b.x)], 1u);
    return b;
}
__device__ __forceinline__ void xcd_barrier_complete(unsigned* bar, unsigned x, unsigned& nloc, unsigned& nx) {
    const unsigned G = gridDim.x * gridDim.y * gridDim.z;
    unsigned sum, cnt, mine, sp = 0u;
    for (;;) {
        sum = 0u; cnt = 0u; mine = 0u;
#pragma unroll
        for (unsigned j = 0; j < 16; ++j) { const unsigned c = xb_ld(&bar[XB_XCNT(j)]); sum += c; cnt += (c > 0u) ? 1u : 0u; mine = (j == x) ? c : mine; }
        if (sum == G) break;
        __builtin_amdgcn_s_sleep(1);
        if ((++sp & 255u) == 0u) { if (xb_ld(&bar[XB_TMO])) break; if (sp > XB_SPIN_CAP) { atomicAdd(&bar[XB_TMO], 1u); break; } }
    }
    nloc = mine > 0u ? mine : 1u; nx = cnt > 0u ? cnt : 1u;
}
__device__ __forceinline__ void xcd_barrier(const XcdBarrier& b) {
    asm volatile("s_waitcnt vmcnt(0)" ::: "memory");
    __syncthreads();
    if (threadIdx.x == 0) {
        unsigned* bar = b.bar;
        __builtin_amdgcn_s_waitcnt(0);
        unsigned nloc = b.st[0], nx = b.st[1];
        if (nloc == 0u) { xcd_barrier_complete(bar, b.x, nloc, nx); b.st[0] = nloc; b.st[1] = nx; }
        const unsigned old = xb_add(&bar[XB_XSUB(b.x)], 1u);
        const unsigned gen = old / nloc;
        if (old + 1u == (gen + 1u) * nloc) {
            __builtin_amdgcn_fence(__ATOMIC_RELEASE, "agent");
            asm volatile("s_waitcnt vmcnt(0)" ::: "memory");
            const unsigned og = xb_add(&bar[XB_TOP], 1u);
            const unsigned tg = og / nx;
            if (og + 1u == (tg + 1u) * nx) xb_add(&bar[XB_TOPGEN], 1u);
            else XB_SPIN(xb_ld(&bar[XB_TOPGEN]) == tg, bar);
            __builtin_amdgcn_fence(__ATOMIC_ACQUIRE, "agent");
            xb_add(&bar[XB_XGEN(b.x)], 1u);
            asm volatile("s_waitcnt vmcnt(0)" ::: "memory");
        } else {
            XB_SPIN(xb_ld(&bar[XB_XGEN(b.x)]) == gen, bar);
            __builtin_amdgcn_fence(__ATOMIC_ACQUIRE, "agent");
            asm volatile("s_waitcnt vmcnt(0)" ::: "memory");
        }
    }
    __syncthreads();
}

constexpr int LDS_BYTES = 155648, MISC_OFF = LDS_BYTES - 64;
constexpr int NPHASE = 15;
#ifndef DUP
#define DUP 0
#endif
#define RUN(id, call) do { call; if ((DUP >> (id)) & 1) { __syncthreads(); call; } } while (0)
__global__ void __launch_bounds__(512, 2) mega(P p, int lo, int hi) {
    extern __shared__ __attribute__((aligned(16))) unsigned char lds_raw[];
    float* lds = (float*)lds_raw; LAS unsigned char* l3 = (LAS unsigned char*)lds_raw;
    volatile LAS unsigned* misc = (volatile LAS unsigned*)(l3 + MISC_OFF);
    if (threadIdx.x < 16) misc[threadIdx.x] = 0u;
    __syncthreads();
    XcdBarrier bar; bar.bar = wsp<unsigned>(p, WS_CTL); bar.x = 0; bar.st = misc;
    if (hi - lo > 1) bar = xcd_barrier_post(wsp<unsigned>(p, WS_CTL), misc);
    for (int ph = lo; ph < hi; ++ph) {
        switch (ph) {
            case 0: RUN(0, ph_mod(p, lds)); RUN(1, ph_wconv(p, lds)); break;
            case 1: RUN(2, ph_norm1(p)); break;
            case 2: RUN(3, ph_g_in(p, l3)); break;
            case 3: RUN(4, ph_conv(p, lds)); RUN(5, ph_m1(p, lds)); break;
            case 4: RUN(6, ph_m2(p, lds)); RUN(7, ph_g_pw(p, l3)); break;
            case 5: RUN(8, ph_g_u(p, l3)); RUN(9, ph_g_s(p, l3)); break;
            case 6: RUN(10, ph_scan(p)); break;
            case 7: RUN(11, ph_g_o(p, l3)); break;
            case 8: RUN(12, ph_g_mo(p, l3)); break;
            case 9: RUN(13, ph_g_out(p, l3)); break;
            case 10: RUN(14, ph_router(p, lds)); break;
            case 11: RUN(15, ph_scatter(p, lds)); break;
            case 12: RUN(16, ph_g_gu(p, l3)); break;
            case 13: RUN(17, ph_g_dn(p, l3)); break;
            case 14: RUN(18, ph_final(p)); break;
        }
        if (ph + 1 < hi) xcd_barrier(bar);
    }
}

#ifndef N_LAUNCHES
#define N_LAUNCHES 1
#endif
extern "C" void kernel_launch(void* const* d_in, const int* in_sizes, int n_in, void* d_out, int out_size, void* d_ws, size_t ws_size, hipStream_t stream) {
    static int grid = 0;
    if (grid == 0) {
        if (n_in != 31 || ws_size < WS_NEED || out_size != T * DM) { fprintf(stderr, "kernel_launch: unexpected shapes: n_in %d ws %zu out %d\n", n_in, ws_size, out_size); grid = -1; return; }
        int dev = 0, cus = 0, per_cu = 0;
        if (hipGetDevice(&dev) != hipSuccess || hipDeviceGetAttribute(&cus, hipDeviceAttributeMultiprocessorCount, dev) != hipSuccess) { fprintf(stderr, "kernel_launch: device query failed\n"); grid = -1; return; }
        if (hipFuncSetAttribute((const void*)mega, hipFuncAttributeMaxDynamicSharedMemorySize, LDS_BYTES) != hipSuccess) { fprintf(stderr, "kernel_launch: hipFuncSetAttribute failed\n"); grid = -1; return; }
        if (hipOccupancyMaxActiveBlocksPerMultiprocessor(&per_cu, (const void*)mega, 512, LDS_BYTES) != hipSuccess || per_cu < 1) { fprintf(stderr, "kernel_launch: occupancy query says %d blocks per CU\n", per_cu); (void)hipGetLastError(); grid = -1; return; }
        grid = cus;
    }
    if (grid < 0) return;
    P p{};
    for (int i = 0; i < 31; ++i) p.in[i] = (const float*)d_in[i];
    p.out = (float*)d_out; p.ws = (unsigned char*)d_ws;
    (void)hipMemsetAsync((char*)d_ws + WS_CTL, 0, 65536, stream);
    if (N_LAUNCHES == 1) hipLaunchKernelGGL(mega, dim3(grid), dim3(512), LDS_BYTES, stream, p, 0, NPHASE);
    else for (int ph = 0; ph < NPHASE; ++ph) hipLaunchKernelGGL(mega, dim3(grid), dim3(512), LDS_BYTES, stream, p, ph, ph + 1);
}
```

```cpp
#include <hip/hip_runtime.h>
#include <cstdio>
#include <cstdint>

constexpr int DM = 1024, NB_ = 4, SEQ = 8192, T = NB_ * SEQ, NE = 32, TOPK = 4, DIN = 6144;
constexpr int CH = 256;
constexpr int NCH = SEQ / CH;
constexpr int NUNIT = NB_ * 4 * NCH;
constexpr int MAXTILES = 544;
constexpr float EPS = 1e-6f;

typedef unsigned short bf16;
typedef float f32x4 __attribute__((ext_vector_type(4)));
typedef unsigned u32x4 __attribute__((ext_vector_type(4)));
typedef unsigned u32x2 __attribute__((ext_vector_type(2)));

constexpr size_t MB = 1u << 20;
constexpr size_t WS_WGU = 0, WS_WDN = 76 * MB;
constexpr size_t SLAB0 = 192 * MB, SLABSZ = 64 * MB;
#define SLAB(i) (SLAB0 + (size_t)(i) * SLABSZ)
constexpr size_t WS_WIN = 960 * MB, WS_WPW = 972 * MB, WS_WMO = 974 * MB, WS_WOUT = 976 * MB;
constexpr size_t WS_CTL = 978 * MB, WS_MOD = 979 * MB, WS_IG = 980 * MB, WS_LOGF = 980 * MB + 512 * 1024;
constexpr size_t WS_CW = 981 * MB, WS_FLOOR = 981 * MB + 512 * 1024, WS_UNITS = 982 * MB, WS_NLOC = 983 * MB, WS_NS = 984 * MB;
constexpr size_t WS_DENP = 985 * MB, WS_DEN = 987 * MB, WS_TOPI = 988 * MB, WS_TOPW = 989 * MB, WS_CNT = 990 * MB, WS_ROWSLOT = 991 * MB, WS_TILEE = 992 * MB;
constexpr size_t WS_ROWTOK = 997 * MB;
constexpr size_t WS_SSQ = WS_DENP;
constexpr size_t WS_MODCNT = WS_CTL + 40960;
constexpr size_t WS_WPR = 998 * MB;
constexpr size_t WS_GP = 993 * MB;
constexpr size_t WS_NEED = 1024 * MB;
constexpr size_t O_HA = SLAB(0), O_YAPRE = SLAB(0), O_MOIN = SLAB(0);
constexpr size_t O_UT = SLAB(11);
constexpr size_t O_SP = 116 * MB;
constexpr size_t O_U1 = SLAB(1), O_KWT = SLAB(1), O_CT = SLAB(1);
constexpr size_t O_XM = SLAB(2), O_VT = SLAB(8);
constexpr size_t O_SO = SLAB(3);
constexpr size_t O_SZA = SLAB(4);
constexpr size_t O_SZB = SLAB(5);
constexpr size_t O_Q = SLAB(6), O_K = SLAB(7), O_V = SLAB(8), O_XC = SLAB(9), O_YAG = SLAB(10), O_MERGED = SLAB(11);
constexpr size_t O_HG = SLAB(7);
constexpr size_t O_X1 = SLAB(0);
constexpr size_t O_HM = SLAB(2);
constexpr size_t O_XS = SLAB(3), O_Y = SLAB(3);
constexpr size_t O_ACT = SLAB(8);

struct P { const float* in[31]; float* out; unsigned char* ws; };
enum { I_X = 0, I_C, I_WADA, I_BADA, I_GMIX, I_WIN, I_WDW, I_BDW, I_LNG, I_LNB, I_WPW, I_BPW, I_WSC, I_BSC, I_WQ, I_WK, I_WV, I_WIF, I_BIF, I_HNG, I_SKIP,
       I_WMO, I_WOUT, I_GMOE, I_WR, I_BR, I_WGU, I_BGU, I_WDN, I_BDN, I_GFIN };

#define LAS __attribute__((address_space(3)))
__device__ __forceinline__ unsigned f2bf(float f) { unsigned u = __float_as_uint(f); return (u + 0x7fffu + ((u >> 16) & 1u)) >> 16; }
__device__ __forceinline__ float bf2f(unsigned h) { return __uint_as_float(h << 16); }
__device__ __forceinline__ unsigned pk2(float lo, float hi) { unsigned r; asm volatile("v_cvt_pk_bf16_f32 %0, %1, %2" : "=v"(r) : "v"(lo), "v"(hi)); return r; }
__device__ __forceinline__ float bflo(unsigned w) { return __uint_as_float(w << 16); }
__device__ __forceinline__ float bfhi(unsigned w) { return __uint_as_float(w & 0xffff0000u); }
__device__ __forceinline__ unsigned pk4_fp8(float a, float b, float c, float d) {
    a = fminf(fmaxf(a, -448.f), 448.f); b = fminf(fmaxf(b, -448.f), 448.f); c = fminf(fmaxf(c, -448.f), 448.f); d = fminf(fmaxf(d, -448.f), 448.f);
    int w = 0; w = __builtin_amdgcn_cvt_pk_fp8_f32(a, b, w, false); w = __builtin_amdgcn_cvt_pk_fp8_f32(c, d, w, true); return (unsigned)w; }
__device__ __forceinline__ unsigned pk4_fp8_nc(float a, float b, float c, float d) { int w = 0; w = __builtin_amdgcn_cvt_pk_fp8_f32(a, b, w, false); w = __builtin_amdgcn_cvt_pk_fp8_f32(c, d, w, true); return (unsigned)w; }
typedef float f32x2_ __attribute__((ext_vector_type(2)));
constexpr int KP8 = 1152;
constexpr float S_HM = 32.f, S_W = 1024.f, S_ACT = 4.f, S_Y = 32.f;
__device__ __forceinline__ float sigm(float x) { return __builtin_amdgcn_rcpf(1.f + __expf(-x)); }
__device__ __forceinline__ float silu(float x) { return x * __builtin_amdgcn_rcpf(1.f + __expf(-x)); }
__device__ __forceinline__ float wave_sum(float v) {
#pragma unroll
    for (int o = 1; o < 64; o <<= 1) v += __shfl_xor(v, o);
    return v;
}
__device__ __forceinline__ float wave_max(float v) {
#pragma unroll
    for (int o = 1; o < 64; o <<= 1) v = fmaxf(v, __shfl_xor(v, o));
    return v;
}
__device__ __forceinline__ int ld_agent(const int* p) { return __hip_atomic_load(p, __ATOMIC_RELAXED, __HIP_MEMORY_SCOPE_AGENT); }
__device__ __forceinline__ int otid() { int t = threadIdx.x; asm volatile("" : "+v"(t)); return t; }
template <class Tp> __device__ __forceinline__ Tp* wsp(const P& p, size_t off) { return (Tp*)(p.ws + off); }

__device__ void ph_mod(const P& p, float* lds) {
    const int tid = otid();
    const float* c = p.in[I_C]; const float* w = p.in[I_WADA]; const float* ba = p.in[I_BADA];
    float* mod = wsp<float>(p, WS_MOD);
    float* sc_ = lds + 2048;
    for (int i = tid; i < NB_ * DM; i += 512) sc_[i] = silu(c[i]);
    __syncthreads();
    for (int cb = blockIdx.x; cb < DIN / 24; cb += gridDim.x) {
        if (tid < 384) {
            const int col = cb * 24 + (tid % 24), ks = tid / 24;
            float a0 = 0.f, a1 = 0.f, a2 = 0.f, a3 = 0.f;
#pragma unroll 8
            for (int k = ks * 64; k < ks * 64 + 64; ++k) {
                const float wv = w[(size_t)k * DIN + col];
                a0 += sc_[k] * wv; a1 += sc_[DM + k] * wv; a2 += sc_[2 * DM + k] * wv; a3 += sc_[3 * DM + k] * wv;
            }
            float* r = lds + (ks * 24 + (tid % 24)) * 4; r[0] = a0; r[1] = a1; r[2] = a2; r[3] = a3;
        }
        __syncthreads();
        if (tid < 96) {
            const int cl = tid % 24, b = tid / 24; float s = 0.f;
            for (int ks = 0; ks < 16; ++ks) s += lds[(ks * 24 + cl) * 4 + b];
            mod[b * DIN + cb * 24 + cl] = s + ba[cb * 24 + cl];
        }
        __syncthreads();
    }
    int done = 0; for (int cb = blockIdx.x; cb < DIN / 24; cb += gridDim.x) ++done;
    asm volatile("s_waitcnt vmcnt(0)" ::: "memory"); __syncthreads();
    if (tid == 0) { __builtin_amdgcn_fence(__ATOMIC_RELEASE, "agent"); asm volatile("s_waitcnt vmcnt(0)" ::: "memory");
        __hip_atomic_fetch_add(wsp<int>(p, WS_MODCNT), done, __ATOMIC_RELAXED, __HIP_MEMORY_SCOPE_AGENT); }
}
__device__ void mod_wait(const P& p) {
    if (otid() == 0) { const int* c = wsp<int>(p, WS_MODCNT); unsigned spins = 0;
        while (ld_agent(c) < DIN / 24 && ++spins < (1u << 22)) __builtin_amdgcn_s_sleep(2);
        __builtin_amdgcn_fence(__ATOMIC_ACQUIRE, "agent"); asm volatile("s_waitcnt vmcnt(0)" ::: "memory"); }
    __syncthreads();
}
__device__ __forceinline__ int glu_row(int n, int half) { const int ch = n % half, isg = n / half; return (ch >> 7) * 256 + isg * 128 + (ch & 127); }
__device__ __forceinline__ void transpose_item(const float* W, int K, int N, bf16* WT, int drow0, float* scr, int kb, int nb, int lane) {
    const int k0 = 64 * kb, n0 = 32 * nb;
#pragma unroll 8
    for (int i = 0; i < 32; ++i) { const int kk = 2 * i + (lane >> 5); scr[kk * 33 + (lane & 31)] = W[(size_t)(k0 + kk) * N + n0 + (lane & 31)]; }
    __builtin_amdgcn_s_waitcnt(0xc07f); asm volatile("" ::: "memory");
    const int c = lane & 7;
#pragma unroll
    for (int j = 0; j < 4; ++j) { const int n = (lane >> 3) + 8 * j; const float* s = scr + (8 * c) * 33 + n;
        u32x4 o; o.x = pk2(s[0 * 33], s[1 * 33]); o.y = pk2(s[2 * 33], s[3 * 33]); o.z = pk2(s[4 * 33], s[5 * 33]); o.w = pk2(s[6 * 33], s[7 * 33]);
        *(u32x4*)(WT + (size_t)(drow0 + n) * K + k0 + 8 * c) = o; }
    __builtin_amdgcn_s_waitcnt(0xc07f); asm volatile("" ::: "memory");
}
__device__ __forceinline__ void transpose_item8(const float* W, int pitch, int N, unsigned char* WT, int drow0, float* scr, int kb, int nb, int lane) {
    const int k0 = 128 * kb, n0 = 32 * nb;
#pragma unroll 8
    for (int i = 0; i < 64; ++i) { const int kk = 2 * i + (lane >> 5); scr[kk * 33 + (lane & 31)] = W[(size_t)(k0 + kk) * N + n0 + (lane & 31)]; }
    __builtin_amdgcn_s_waitcnt(0xc07f); asm volatile("" ::: "memory");
    const int c = lane & 7;
#pragma unroll
    for (int j = 0; j < 4; ++j) { const int n = (lane >> 3) + 8 * j; const float* q = scr + (16 * c) * 33 + n;
        u32x4 o; o.x = pk4_fp8(q[0] * S_W, q[33] * S_W, q[66] * S_W, q[99] * S_W); o.y = pk4_fp8(q[132] * S_W, q[165] * S_W, q[198] * S_W, q[231] * S_W);
        o.z = pk4_fp8(q[264] * S_W, q[297] * S_W, q[330] * S_W, q[363] * S_W); o.w = pk4_fp8(q[396] * S_W, q[429] * S_W, q[462] * S_W, q[495] * S_W);
        *(u32x4*)(WT + (size_t)(drow0 + n) * pitch + k0 + 16 * c) = o; }
    __builtin_amdgcn_s_waitcnt(0xc07f); asm volatile("" ::: "memory");
}
__device__ void ph_wconv(const P& p, float* lds) {
    const int tid = otid(), lane = tid & 63, wave = tid >> 6;
    float* scr = lds + wave * (128 * 33);
    const int gw = blockIdx.x * 8 + wave, NGW = gridDim.x * 8;
    constexpr int I_IN = 16 * 192, I_SQ = 16 * 32, I_GU = 8 * 64, I_DN = 8 * 32;
    constexpr int NITEMS = I_IN + 3 * I_SQ + NE * I_GU + NE * I_DN;
    for (int it = gw; it < NITEMS; it += NGW) {
        int r = it;
        if (r < I_IN) { const int kb = r / 192, nb = r % 192, n0 = nb * 32; const int d = n0 < 2048 ? glu_row(n0, 1024) : n0;
            transpose_item(p.in[I_WIN], DM, DIN, wsp<bf16>(p, WS_WIN), d, scr, kb, nb, lane); continue; } r -= I_IN;
        if (r < I_SQ) { transpose_item(p.in[I_WPW], DM, DM, wsp<bf16>(p, WS_WPW), (r % 32) * 32, scr, r / 32, r % 32, lane); continue; } r -= I_SQ;
        if (r < I_SQ) { transpose_item(p.in[I_WMO], DM, DM, wsp<bf16>(p, WS_WMO), (r % 32) * 32, scr, r / 32, r % 32, lane); continue; } r -= I_SQ;
        if (r < I_SQ) { transpose_item(p.in[I_WOUT], DM, DM, wsp<bf16>(p, WS_WOUT), (r % 32) * 32, scr, r / 32, r % 32, lane); continue; } r -= I_SQ;
        if (r < NE * I_GU) { const int e = r / I_GU, q = r % I_GU, kb = q / 64, nb = q % 64;
            transpose_item8(p.in[I_WGU] + (size_t)e * DM * 2048, KP8, 2048, wsp<unsigned char>(p, WS_WGU) + (size_t)e * 2048 * KP8, glu_row(nb * 32, 1024), scr, kb, nb, lane); continue; } r -= NE * I_GU;
        { const int e = r / I_DN, q = r % I_DN, kb = q / 32, nb = q % 32;
            transpose_item8(p.in[I_WDN] + (size_t)e * DM * DM, KP8, DM, wsp<unsigned char>(p, WS_WDN) + (size_t)e * DM * KP8, nb * 32, scr, kb, nb, lane); }
    }
}
__device__ __forceinline__ void adanorm_row(const float* xrow, const float* g, const float* sc, const float* sh, bf16* orow, int lane) {
    f32x4 v[4]; float s = 0.f;
#pragma unroll
    for (int j = 0; j < 4; ++j) { v[j] = ((const f32x4*)xrow)[lane + 64 * j]; s += (v[j].x * v[j].x + v[j].y * v[j].y) + (v[j].z * v[j].z + v[j].w * v[j].w); }
    const float r = rsqrtf(wave_sum(s) * (1.f / DM) + EPS);
#pragma unroll
    for (int j = 0; j < 4; ++j) { const f32x4 gg = ((const f32x4*)g)[lane + 64 * j], ss = ((const f32x4*)sc)[lane + 64 * j], hh = ((const f32x4*)sh)[lane + 64 * j];
        const f32x4 o = v[j] * r * gg * (1.f + ss) + hh;
        u32x2 w; w.x = pk2(o.x, o.y); w.y = pk2(o.z, o.w); ((u32x2*)orow)[lane + 64 * j] = w; }
}
__device__ void ph_norm1(const P& p) {
    const int tid = otid(), lane = tid & 63, gw = blockIdx.x * 8 + (tid >> 6), NGW = gridDim.x * 8;
    const float* mod = wsp<float>(p, WS_MOD); bf16* HA = wsp<bf16>(p, O_HA); const float* X = p.in[I_X];
    const int per = (T + NGW - 1) / NGW;
    for (int m0 = gw * per; m0 < T && m0 < (gw + 1) * per; ) {
        const int b = m0 / SEQ; int m1 = (gw + 1) * per; if (m1 > T) m1 = T; if (m1 > (b + 1) * SEQ) m1 = (b + 1) * SEQ;
        f32x4 gs[4], hh[4];
#pragma unroll
        for (int j = 0; j < 4; ++j) { gs[j] = ((const f32x4*)p.in[I_GMIX])[lane + 64 * j] * (1.f + ((const f32x4*)(mod + b * DIN + 1024))[lane + 64 * j]); hh[j] = ((const f32x4*)(mod + b * DIN))[lane + 64 * j]; }
        int m = m0;
        for (; m + 4 <= m1; m += 4) {
            f32x4 v[4][4]; float ss[4];
#pragma unroll
            for (int r = 0; r < 4; ++r)
#pragma unroll
                for (int j = 0; j < 4; ++j) v[r][j] = ((const f32x4*)(X + (size_t)(m + r) * DM))[lane + 64 * j];
#pragma unroll
            for (int r = 0; r < 4; ++r) { float q = 0.f;
#pragma unroll
                for (int j = 0; j < 4; ++j) q += (v[r][j].x * v[r][j].x + v[r][j].y * v[r][j].y) + (v[r][j].z * v[r][j].z + v[r][j].w * v[r][j].w);
                ss[r] = rsqrtf(wave_sum(q) * (1.f / DM) + EPS); }
#pragma unroll
            for (int r = 0; r < 4; ++r)
#pragma unroll
                for (int j = 0; j < 4; ++j) { const f32x4 o = v[r][j] * ss[r] * gs[j] + hh[j]; u32x2 w; w.x = pk2(o.x, o.y); w.y = pk2(o.z, o.w); ((u32x2*)(HA + (size_t)(m + r) * DM))[lane + 64 * j] = w; }
        }
        for (; m < m1; ++m) adanorm_row(X + (size_t)m * DM, p.in[I_GMIX], mod + b * DIN + 1024, mod + b * DIN, HA + (size_t)m * DM, lane);
        m0 = m1;
    }
}
__device__ void ph_conv(const P& p, float* lds) {
    const int tid = otid(), lane = tid & 63, wave = tid >> 6, c2 = tid * 2;
    const bf16* U1 = wsp<bf16>(p, O_U1); bf16* YA = wsp<bf16>(p, O_YAPRE);
    bf16* tin = (bf16*)(lds + 256);
    bf16* tout = tin + 2 * 8192;
    const float* wd = p.in[I_WDW];
    float w0[31], w1[31];
#pragma unroll
    for (int j = 0; j < 31; ++j) { w0[j] = wd[j * DM + c2]; w1[j] = wd[j * DM + c2 + 1]; }
    const float b0 = p.in[I_BDW][c2], b1 = p.in[I_BDW][c2 + 1];
    const float g0 = p.in[I_LNG][c2], g1 = p.in[I_LNG][c2 + 1], lb0 = p.in[I_LNB][c2], lb1 = p.in[I_LNB][c2 + 1];
    const int crow = tid >> 7, ccol = (tid & 127) * 8;
    for (int blk = blockIdx.x; blk < T / 128; blk += gridDim.x) {
        const int tb = blk * 128, sb = tb % SEQ;
        unsigned win[38];
#pragma unroll
        for (int j = 0; j < 30; ++j) win[j] = (sb - 30 + j >= 0) ? *(const unsigned*)(U1 + (size_t)(tb - 30 + j) * DM + c2) : 0u;
        u32x4 r0 = *(const u32x4*)(U1 + (size_t)(tb + crow) * DM + ccol), r1 = *(const u32x4*)(U1 + (size_t)(tb + crow + 4) * DM + ccol);
        for (int grp = 0; grp < 16; ++grp) {
            const int t0 = tb + grp * 8;
            bf16* ti = tin + (grp & 1) * 8192;
            *(u32x4*)(ti + crow * 1024 + ccol) = r0; *(u32x4*)(ti + (crow + 4) * 1024 + ccol) = r1;
            if (grp < 15) { r0 = *(const u32x4*)(U1 + (size_t)(t0 + 8 + crow) * DM + ccol); r1 = *(const u32x4*)(U1 + (size_t)(t0 + 12 + crow) * DM + ccol); }
            __syncthreads();
            if (grp > 0) { const bf16* to = tout + ((grp - 1) & 1) * 8192;
                *(u32x4*)(YA + (size_t)(t0 - 8 + crow) * DM + ccol) = *(const u32x4*)(to + crow * 1024 + ccol);
                *(u32x4*)(YA + (size_t)(t0 - 4 + crow) * DM + ccol) = *(const u32x4*)(to + (crow + 4) * 1024 + ccol); }
#pragma unroll
            for (int j = 0; j < 8; ++j) win[30 + j] = *(const unsigned*)(ti + j * 1024 + c2);
            float a0[8], a1[8];
#pragma unroll
            for (int i = 0; i < 8; ++i) { a0[i] = b0; a1[i] = b1; }
#pragma unroll
            for (int j = 0; j < 38; ++j) { const float u0 = bflo(win[j]), u1 = bfhi(win[j]);
#pragma unroll
                for (int i = 0; i < 8; ++i) { const int tap = j - i; if (tap >= 0 && tap <= 30) { a0[i] += u0 * w0[tap]; a1[i] += u1 * w1[tap]; } } }
#pragma unroll
            for (int j = 0; j < 30; ++j) win[j] = win[j + 8];
            float st[16];
#pragma unroll
            for (int i = 0; i < 8; ++i) { st[2 * i] = a0[i] + a1[i]; st[2 * i + 1] = a0[i] * a0[i] + a1[i] * a1[i]; }
            float s8[8], s4[4], s2[2], s1;
            { const bool hi = lane & 32;
#pragma unroll
              for (int i = 0; i < 8; ++i) { const float keep = hi ? st[2 * i + 1] : st[2 * i], send = hi ? st[2 * i] : st[2 * i + 1]; s8[i] = keep + __shfl_xor(send, 32); } }
            { const bool hi = lane & 16;
#pragma unroll
              for (int i = 0; i < 4; ++i) { const float keep = hi ? s8[2 * i + 1] : s8[2 * i], send = hi ? s8[2 * i] : s8[2 * i + 1]; s4[i] = keep + __shfl_xor(send, 16); } }
            { const bool hi = lane & 8;
#pragma unroll
              for (int i = 0; i < 2; ++i) { const float keep = hi ? s4[2 * i + 1] : s4[2 * i], send = hi ? s4[2 * i] : s4[2 * i + 1]; s2[i] = keep + __shfl_xor(send, 8); } }
            { const bool hi = lane & 4; const float keep = hi ? s2[1] : s2[0], send = hi ? s2[0] : s2[1]; s1 = keep + __shfl_xor(send, 4); }
            s1 += __shfl_xor(s1, 2); s1 += __shfl_xor(s1, 1);
            float* red = lds + (grp & 1) * 128;
            if ((lane & 3) == 0) { const int idx = ((lane >> 2) & 1) * 8 + ((lane >> 3) & 1) * 4 + ((lane >> 4) & 1) * 2 + ((lane >> 5) & 1); red[idx * 8 + wave] = s1; }
            __syncthreads();
            float* fin = lds + 16640 + (grp & 1) * 16;
            if (tid < 8) { const f32x4 s0 = *(const f32x4*)(red + tid * 16), s1 = *(const f32x4*)(red + tid * 16 + 4), q0 = *(const f32x4*)(red + tid * 16 + 8), q1 = *(const f32x4*)(red + tid * 16 + 12);
                const float s = ((s0.x + s0.y) + (s0.z + s0.w)) + ((s1.x + s1.y) + (s1.z + s1.w)), q = ((q0.x + q0.y) + (q0.z + q0.w)) + ((q1.x + q1.y) + (q1.z + q1.w));
                const float mu = s * (1.f / DM), var = fmaxf(q * (1.f / DM) - mu * mu, 0.f); fin[tid * 2] = mu; fin[tid * 2 + 1] = rsqrtf(var + EPS); }
            __syncthreads();
            bf16* to = tout + (grp & 1) * 8192;
            const f32x4 f0 = *(const f32x4*)fin, f1 = *(const f32x4*)(fin + 4), f2 = *(const f32x4*)(fin + 8), f3 = *(const f32x4*)(fin + 12);
            const float mus[8] = {f0.x, f0.z, f1.x, f1.z, f2.x, f2.z, f3.x, f3.z}, rss[8] = {f0.y, f0.w, f1.y, f1.w, f2.y, f2.w, f3.y, f3.w};
#pragma unroll
            for (int i = 0; i < 8; ++i) {
                const float mu = mus[i], rs = rss[i];
                const float y0 = (a0[i] - mu) * rs * g0 + lb0, y1 = (a1[i] - mu) * rs * g1 + lb1;
                *(unsigned*)(to + i * 1024 + c2) = pk2(silu(y0), silu(y1));
            }
        }
        __syncthreads();
        { const bf16* to = tout + 8192;
            *(u32x4*)(YA + (size_t)(tb + 120 + crow) * DM + ccol) = *(const u32x4*)(to + crow * 1024 + ccol);
            *(u32x4*)(YA + (size_t)(tb + 124 + crow) * DM + ccol) = *(const u32x4*)(to + (crow + 4) * 1024 + ccol); }
        __syncthreads();
    }
}
typedef short bf16x8v __attribute__((ext_vector_type(8)));
__device__ __forceinline__ unsigned cvtpk(float lo, float hi) { unsigned r; asm volatile("v_cvt_pk_bf16_f32 %0, %1, %2" : "=v"(r) : "v"(lo), "v"(hi)); return r; }
__device__ __forceinline__ bf16x8v pack_frag(const float* v) { u32x4 w; w.x = cvtpk(v[0], v[1]); w.y = cvtpk(v[2], v[3]); w.z = cvtpk(v[4], v[5]); w.w = cvtpk(v[6], v[7]); return __builtin_bit_cast(bf16x8v, w); }
__device__ void ph_m1(const P& p, float* lds) {
    const int tid = otid(), lane = tid & 63, wave = tid >> 6, tok = lane & 15, kg = lane >> 4;
    const bf16* XM = wsp<bf16>(p, O_XM);
    bf16* Q = wsp<bf16>(p, O_Q); bf16* K = wsp<bf16>(p, O_K); bf16* XC = wsp<bf16>(p, O_XC);
    float* GP = wsp<float>(p, WS_GP);
    for (int item = blockIdx.x; item < 256; item += gridDim.x) {
        const int cb = item & 3, range = item >> 2, c8 = cb * 256 + wave * 32 + kg * 8;
        float wsc[4][8], bsc[8];
        float* bd = lds + 4096 + (wave * 4 + kg) * 96;
#pragma unroll
        for (int j = 0; j < 4; ++j) { const f32x4 a = *(const f32x4*)(p.in[I_WSC] + j * DM + c8), b = *(const f32x4*)(p.in[I_WSC] + j * DM + c8 + 4);
            wsc[j][0] = a.x; wsc[j][1] = a.y; wsc[j][2] = a.z; wsc[j][3] = a.w; wsc[j][4] = b.x; wsc[j][5] = b.y; wsc[j][6] = b.z; wsc[j][7] = b.w; }
        { const f32x4 a = *(const f32x4*)(p.in[I_BSC] + c8), b = *(const f32x4*)(p.in[I_BSC] + c8 + 4); bsc[0] = a.x; bsc[1] = a.y; bsc[2] = a.z; bsc[3] = a.w; bsc[4] = b.x; bsc[5] = b.y; bsc[6] = b.z; bsc[7] = b.w; }
#pragma unroll
        for (int g = 0; g < 2; ++g)
#pragma unroll
            for (int i = 0; i < 16; ++i) { const int o = (c8 / 4 + g) * 16 + i; if (tok == 0) { bd[(g * 3 + 0) * 16 + i] = p.in[I_WQ][o]; bd[(g * 3 + 1) * 16 + i] = p.in[I_WK][o]; bd[(g * 3 + 2) * 16 + i] = p.in[I_WV][o]; } }
        __syncthreads();
        bf16x8v bq, bk, bv;
        { float t0[8], t1[8], t2[8];
#pragma unroll
            for (int j = 0; j < 8; ++j) { const bool on = tok < 8; const int gi = tok & 7;
                t0[j] = on ? p.in[I_WIF][(size_t)(c8 + j) * 8 + gi] : 0.f; t1[j] = on ? p.in[I_WIF][(size_t)(DM + c8 + j) * 8 + gi] : 0.f; t2[j] = on ? p.in[I_WIF][(size_t)(2 * DM + c8 + j) * 8 + gi] : 0.f; }
            bq = pack_frag(t0); bk = pack_frag(t1); bv = pack_frag(t2); }
        u32x4 nx[4];
#pragma unroll
        for (int j = 0; j < 4; ++j) { const int t_ = range * 512 + tok, s_ = t_ % SEQ; nx[j] = (u32x4){0u, 0u, 0u, 0u}; if (s_ - 3 + j >= 0) nx[j] = *(const u32x4*)(XM + (size_t)(t_ - 3 + j) * DM + c8); }
        for (int tt = 0; tt < 32; ++tt) {
            const int t = range * 512 + tt * 16 + tok;
            float xm[4][8];
#pragma unroll
            for (int j = 0; j < 4; ++j) { const u32x4 u = nx[j];
                xm[j][0] = bflo(u.x); xm[j][1] = bfhi(u.x); xm[j][2] = bflo(u.y); xm[j][3] = bfhi(u.y); xm[j][4] = bflo(u.z); xm[j][5] = bfhi(u.z); xm[j][6] = bflo(u.w); xm[j][7] = bfhi(u.w); }
            if (tt < 31) {
#pragma unroll
                for (int j = 0; j < 4; ++j) nx[j] = *(const u32x4*)(XM + (size_t)(t + 16 - 3 + j) * DM + c8); }
            float xc[8], q[8], k[8], v[8];
#pragma unroll
            for (int c = 0; c < 8; ++c) { float a = bsc[c];
#pragma unroll
                for (int j = 0; j < 4; ++j) a += xm[j][c] * wsc[j][c];
                xc[c] = silu(a); }
#pragma unroll
            for (int g = 0; g < 2; ++g)
                {   f32x4 aq = {0.f, 0.f, 0.f, 0.f}, ak = aq, av = aq;
#pragma unroll
                    for (int ii = 0; ii < 4; ++ii) { const f32x4 w_q = *(const f32x4*)(bd + (g * 3 + 0) * 16 + ii * 4), w_k = *(const f32x4*)(bd + (g * 3 + 1) * 16 + ii * 4), w_v = *(const f32x4*)(bd + (g * 3 + 2) * 16 + ii * 4);
                        aq += w_q * xc[g * 4 + ii]; ak += w_k * xc[g * 4 + ii]; av += w_v * xm[3][g * 4 + ii]; }
#pragma unroll
                    for (int o = 0; o < 4; ++o) { q[g * 4 + o] = aq[o]; k[g * 4 + o] = ak[o]; v[g * 4 + o] = av[o]; } }
            const bf16x8v fq_ = pack_frag(q), fk_ = pack_frag(k), fv_ = pack_frag(v), fx_ = pack_frag(xc);
            f32x4 acc = {0.f, 0.f, 0.f, 0.f};
            acc = __builtin_amdgcn_mfma_f32_16x16x32_bf16(fq_, bq, acc, 0, 0, 0);
            acc = __builtin_amdgcn_mfma_f32_16x16x32_bf16(fk_, bk, acc, 0, 0, 0);
            acc = __builtin_amdgcn_mfma_f32_16x16x32_bf16(fv_, bv, acc, 0, 0, 0);
            float* red = lds + (tt & 3) * 1024 + wave * 128;
            if (tok < 8) {
#pragma unroll
                for (int r = 0; r < 4; ++r) red[(kg * 4 + r) * 8 + tok] = acc[r]; }
            *(bf16x8v*)(Q + (size_t)t * DM + c8) = fq_; *(bf16x8v*)(K + (size_t)t * DM + c8) = fk_; *(bf16x8v*)(XC + (size_t)t * DM + c8) = fx_;
            if (tt & 1) {
                __syncthreads();
                if (tid < 256) { const int tl = tt - 1 + (tid >> 7), e = tid & 127; const float* rr = lds + (tl & 3) * 1024 + e; float sum = 0.f;
#pragma unroll
                    for (int w = 0; w < 8; ++w) sum += rr[w * 128];
                    GP[(size_t)cb * T * 8 + (size_t)(range * 512 + tl * 16) * 8 + e] = sum; }
            }
        }
        __syncthreads();
    }
}
constexpr int TP = 258;
__device__ void ph_m2(const P& p, float* ldsf) {
    const int tid = otid(), lane = tid & 63, wave = tid >> 6;
    bf16* tile = (bf16*)ldsf;
    float* wts = ldsf + 33024;
    float* red = ldsf + 33024 + 256;
    const bf16* Kb = wsp<bf16>(p, O_K); const bf16* Vb = wsp<bf16>(p, O_XM);
    bf16* KWT = wsp<bf16>(p, O_KWT); bf16* VT = wsp<bf16>(p, O_VT);
    const float* GP = wsp<float>(p, WS_GP); const float* bif = p.in[I_BIF];
    float* CW = wsp<float>(p, WS_CW); float* FL = wsp<float>(p, WS_FLOOR); float* UN = wsp<float>(p, WS_UNITS); float* NLOC = wsp<float>(p, WS_NLOC);
    for (int unit = blockIdx.x; unit < NUNIT; unit += gridDim.x) {
        const int b = unit >> 7, h = (unit >> 5) & 3, c = unit & 31, tok0 = b * SEQ + c * CH;
        float bc = 0.f, a = 0.f, igv = 0.f;
        if (tid < 256) {
            float gi_ = bif[h], gf_ = bif[4 + h];
#pragma unroll
            for (int cb = 0; cb < 4; ++cb) { const float* g8 = GP + (size_t)cb * T * 8 + (size_t)(tok0 + tid) * 8; gi_ += g8[h]; gf_ += g8[4 + h]; }
            igv = gi_;
            float lf = fminf(gf_, 0.f) - log1pf(__expf(-fabsf(gf_)));
#pragma unroll
            for (int o = 1; o < 64; o <<= 1) { const float n = __shfl_up(lf, o); if (lane >= o) lf += n; }
            if (lane == 63) red[wave] = lf;
            bc = lf;
        }
        __syncthreads();
        if (tid < 256) {
            for (int w = 0; w < wave; ++w) bc += red[w];
            a = igv - bc;
            const float m = wave_max(a);
            if (lane == 0) red[8 + wave] = m;
        }
        __syncthreads();
        if (tid < 256) {
            const float amax = fmaxf(fmaxf(red[8], red[9]), fmaxf(red[10], red[11]));
            const float w = __expf(a - amax) * 0.0625f;
            wts[tid] = w; CW[unit * 256 + tid] = w; FL[unit * 256 + tid] = __expf(-bc - amax);
            if (tid == 255) { UN[unit * 2] = amax; UN[unit * 2 + 1] = bc; }
        }
        float wvb[2][16];
#pragma unroll
        for (int g = 0; g < 2; ++g)
#pragma unroll
            for (int i = 0; i < 16; ++i) wvb[g][i] = p.in[I_WV][(h * 64 + (tid & 31) * 2 + g) * 16 + i];
        for (int which = 0; which < 2; ++which) {
            const bf16* src = which ? Vb : Kb; bf16* dst = (which ? VT : KWT) + (size_t)unit * 65536;
            __syncthreads();
            u32x4 ld[16];
#pragma unroll
            for (int i = 0; i < 16; ++i) { const int ch = tid + i * 512, row = ch >> 5, cc = ch & 31; ld[i] = *(const u32x4*)(src + (size_t)(tok0 + row) * DM + h * 256 + cc * 8); }
#pragma unroll
            for (int i = 0; i < 16; ++i) { const int ch = tid + i * 512, row = ch >> 5, cc = ch & 31;
                u32x4 v = ld[i];
                if (which) { const float x[8] = {bflo(v.x), bfhi(v.x), bflo(v.y), bfhi(v.y), bflo(v.z), bfhi(v.z), bflo(v.w), bfhi(v.w)}; float o[8];
#pragma unroll
                    for (int g = 0; g < 2; ++g)
#pragma unroll
                        for (int oo = 0; oo < 4; ++oo) { float a = 0.f;
#pragma unroll
                            for (int ii = 0; ii < 4; ++ii) a += x[g * 4 + ii] * wvb[g][ii * 4 + oo];
                            o[g * 4 + oo] = a; }
                    v.x = pk2(o[0], o[1]); v.y = pk2(o[2], o[3]); v.z = pk2(o[4], o[5]); v.w = pk2(o[6], o[7]); }
                unsigned* d = (unsigned*)(tile + row * TP + cc * 8); d[0] = v.x; d[1] = v.y; d[2] = v.z; d[3] = v.w; }
            __syncthreads();
            if (which == 0 && tid < 256) { float s = 0.f; for (int r = 0; r < 256; ++r) s += bf2f(tile[r * TP + tid]) * wts[r]; NLOC[unit * 256 + tid] = s; }
            for (int i = 0; i < 8; ++i) {
                const int blk = wave + i * 8;
                const int d = (blk >> 2) * 16 + 2 * (lane >> 3), sc = (blk & 3) * 8 + (lane & 7);
                float e0[8], e1[8];
#pragma unroll
                for (int j = 0; j < 8; ++j) { const unsigned w2 = *(const unsigned*)(tile + (sc * 8 + j) * TP + d); e0[j] = bflo(w2); e1[j] = bfhi(w2); }
                if (which == 0) { const f32x4 wa = *(const f32x4*)(wts + sc * 8), wb = *(const f32x4*)(wts + sc * 8 + 4); const float ww[8] = {wa.x, wa.y, wa.z, wa.w, wb.x, wb.y, wb.z, wb.w};
#pragma unroll
                    for (int j = 0; j < 8; ++j) { e0[j] *= ww[j]; e1[j] *= ww[j]; } }
                u32x4 o; o.x = pk2(e0[0], e0[1]); o.y = pk2(e0[2], e0[3]); o.z = pk2(e0[4], e0[5]); o.w = pk2(e0[6], e0[7]);
                *(u32x4*)(dst + (size_t)d * 256 + sc * 8) = o;
                o.x = pk2(e1[0], e1[1]); o.y = pk2(e1[2], e1[3]); o.z = pk2(e1[4], e1[5]); o.w = pk2(e1[6], e1[7]);
                *(u32x4*)(dst + (size_t)(d + 1) * 256 + sc * 8) = o;
            }
        }
        __syncthreads();
    }
}
__device__ void ph_scan(const P& p) {
    const bf16* UT = wsp<bf16>(p, O_UT); bf16* CT = wsp<bf16>(p, O_CT);
    const float* UN = wsp<float>(p, WS_UNITS); const float* NLOC = wsp<float>(p, WS_NLOC); float* NS = wsp<float>(p, WS_NS);
    const int nth = gridDim.x * blockDim.x;
    for (int e8 = blockIdx.x * blockDim.x + otid(); e8 < 16 * 8192; e8 += nth) {
        const int bh = e8 >> 13, idx = e8 & 8191; const size_t off = (size_t)idx * 8;
        const bool don = idx < 32;
        float C[8], n[8]; float m = 0.f;
#pragma unroll
        for (int j = 0; j < 8; ++j) { C[j] = 0.f; n[j] = 0.f; }
        for (int c0 = 0; c0 < NCH; c0 += 8) {
            u32x4 uu[8]; float am[8], bl[8];
#pragma unroll
            for (int q = 0; q < 8; ++q) { const int unit = bh * 32 + c0 + q; uu[q] = *(const u32x4*)(UT + (size_t)unit * 65536 + off); am[q] = UN[unit * 2]; bl[q] = UN[unit * 2 + 1]; }
#pragma unroll
            for (int q = 0; q < 8; ++q) {
                const int unit = bh * 32 + c0 + q; const float amax = am[q], blast = bl[q]; const u32x4 u = uu[q];
                const float f1 = __expf(m - amax);
                u32x4 o; o.x = pk2(C[0] * f1, C[1] * f1); o.y = pk2(C[2] * f1, C[3] * f1); o.z = pk2(C[4] * f1, C[5] * f1); o.w = pk2(C[6] * f1, C[7] * f1);
                *(u32x4*)(CT + (size_t)unit * 65536 + off) = o;
                const float mnew = blast + fmaxf(m, amax), d1 = __expf(blast + m - mnew), d2 = __expf(blast + amax - mnew);
                C[0] = d1 * C[0] + d2 * bflo(u.x); C[1] = d1 * C[1] + d2 * bfhi(u.x); C[2] = d1 * C[2] + d2 * bflo(u.y); C[3] = d1 * C[3] + d2 * bfhi(u.y);
                C[4] = d1 * C[4] + d2 * bflo(u.z); C[5] = d1 * C[5] + d2 * bfhi(u.z); C[6] = d1 * C[6] + d2 * bflo(u.w); C[7] = d1 * C[7] + d2 * bfhi(u.w);
                if (don) {
#pragma unroll
                    for (int j = 0; j < 8; ++j) { NS[unit * 256 + idx * 8 + j] = n[j] * f1; n[j] = d1 * n[j] + d2 * NLOC[unit * 256 + idx * 8 + j]; } }
                m = mnew;
            }
        }
    }
}
constexpr int RP = 1032;
__device__ void ph_wprime(const P& p, float* lds) {
    const int tid = otid();
    const float* mod = wsp<float>(p, WS_MOD); const float* wr = p.in[I_WR]; const float* gm = p.in[I_GMOE];
    bf16* img = wsp<bf16>(p, WS_WPR); float* cstg = (float*)(img + 4 * 2 * 32 * RP);
    for (int it = blockIdx.x; it < 128; it += gridDim.x) {
        const int b = it >> 5, e = it & 31; const float* sc = mod + b * DIN + 4096; const float* sh = mod + b * DIN + 3072;
        float a = 0.f;
#pragma unroll
        for (int q = 0; q < 2; ++q) { const int k = tid + q * 512; const float w = wr[k * 32 + e]; const float v = w * gm[k] * (1.f + sc[k]); const unsigned h = f2bf(v);
            img[((size_t)(b * 2 + 0) * 32 + e) * RP + k] = (bf16)h; img[((size_t)(b * 2 + 1) * 32 + e) * RP + k] = (bf16)f2bf(v - bf2f(h)); a += sh[k] * w; }
        a = wave_sum(a);
        if ((tid & 63) == 0) lds[tid >> 6] = a;
        __syncthreads();
        if (tid == 0) { float t = p.in[I_BR][e];
#pragma unroll
            for (int w = 0; w < 8; ++w) t += lds[w];
            cstg[b * 32 + e] = t; }
        __syncthreads();
    }
}
__device__ void ph_router(const P& p, float* lds) {
    const int tid = otid(), lane = tid & 63, wave = tid >> 6, tok = lane & 15, kg = lane >> 4;
    bf16* Wh = (bf16*)lds; bf16* Wl = Wh + 32 * RP;
    float* lg = lds + 33024 + wave * 512;
    float* cst = lds + 33024 + 4096;
    int* cnt = (int*)(cst + 32);
    float* rinv = cst + 64 + wave * 16;
    float* red = cst + 64 + 128;
    const float* X1 = wsp<float>(p, O_X1); const float* mod = wsp<float>(p, WS_MOD); unsigned char* HM = wsp<unsigned char>(p, O_HM);
    int* TOPI = wsp<int>(p, WS_TOPI); float* TOPW = wsp<float>(p, WS_TOPW); int* CNT = wsp<int>(p, WS_CNT);
    const float* wr = p.in[I_WR]; const float* gm = p.in[I_GMOE];
    for (int blk = blockIdx.x; blk < T / 128; blk += gridDim.x) {
        const int b = (blk * 128) / SEQ; const float* sc = mod + b * DIN + 4096; const float* sh = mod + b * DIN + 3072;
        { const u32x4* src = (const u32x4*)(wsp<bf16>(p, WS_WPR) + (size_t)b * 2 * 32 * RP); u32x4* dst = (u32x4*)Wh;
#pragma unroll
            for (int i = 0; i < 17; ++i) { const int idx = tid + i * 512; if (idx < 8256) dst[idx] = src[idx]; }
            if (tid < 32) { cst[tid] = ((const float*)(wsp<bf16>(p, WS_WPR) + 4 * 2 * 32 * RP))[b * 32 + tid]; cnt[tid] = 0; } }
        __syncthreads();
        const int tb = blk * 128 + wave * 16;
        {
            const float* xr = X1 + (size_t)(tb + tok) * DM + kg * 8;
            float rr;
            { const f32x4* sp = (const f32x4*)(wsp<float>(p, WS_SSQ) + (size_t)(tb + tok) * 16); const f32x4 a = sp[0], b4 = sp[1], c4 = sp[2], d4 = sp[3];
              const float ss = ((a.x + a.y) + (a.z + a.w)) + ((b4.x + b4.y) + (b4.z + b4.w)) + ((c4.x + c4.y) + (c4.z + c4.w)) + ((d4.x + d4.y) + (d4.z + d4.w));
              rr = rsqrtf(ss * (1.f / DM) + EPS); }
            if (kg == 0) rinv[tok] = rr;
            const float rs = rr * S_HM;
            unsigned char* ho = HM + (size_t)(tb + tok) * DM + kg * 8;
            f32x4 acc0 = {0.f, 0.f, 0.f, 0.f}, acc1 = {0.f, 0.f, 0.f, 0.f};
            const bf16* wh0 = Wh + tok * RP + kg * 8; const bf16* wl0 = Wl + tok * RP + kg * 8;
#pragma unroll 4
            for (int ks = 0; ks < 32; ++ks) {
                const f32x4 x0 = *(const f32x4*)(xr + ks * 32), x1 = *(const f32x4*)(xr + ks * 32 + 4);
                { const int k0 = ks * 32 + kg * 8;
                  const f32x4 g0 = *(const f32x4*)(gm + k0) * (1.f + *(const f32x4*)(sc + k0)), g1 = *(const f32x4*)(gm + k0 + 4) * (1.f + *(const f32x4*)(sc + k0 + 4));
                  const f32x4 h0 = x0 * rs * g0 + *(const f32x4*)(sh + k0) * S_HM, h1 = x1 * rs * g1 + *(const f32x4*)(sh + k0 + 4) * S_HM;
                  u32x2 w8; w8.x = pk4_fp8(h0.x, h0.y, h0.z, h0.w); w8.y = pk4_fp8(h1.x, h1.y, h1.z, h1.w); *(u32x2*)(ho + ks * 32) = w8; }
                u32x4 hw; hw.x = cvtpk(x0.x, x0.y); hw.y = cvtpk(x0.z, x0.w); hw.z = cvtpk(x1.x, x1.y); hw.w = cvtpk(x1.z, x1.w);
                u32x4 lw; lw.x = cvtpk(x0.x - bflo(hw.x), x0.y - bfhi(hw.x)); lw.y = cvtpk(x0.z - bflo(hw.y), x0.w - bfhi(hw.y));
                lw.z = cvtpk(x1.x - bflo(hw.z), x1.y - bfhi(hw.z)); lw.w = cvtpk(x1.z - bflo(hw.w), x1.w - bfhi(hw.w));
                const bf16x8v ah = __builtin_bit_cast(bf16x8v, hw), al = __builtin_bit_cast(bf16x8v, lw);
                const bf16x8v bh0 = *(const bf16x8v*)(wh0 + ks * 32), bl0 = *(const bf16x8v*)(wl0 + ks * 32);
                const bf16x8v bh1 = *(const bf16x8v*)(wh0 + 16 * RP + ks * 32), bl1 = *(const bf16x8v*)(wl0 + 16 * RP + ks * 32);
                acc0 = __builtin_amdgcn_mfma_f32_16x16x32_bf16(ah, bh0, acc0, 0, 0, 0); acc1 = __builtin_amdgcn_mfma_f32_16x16x32_bf16(ah, bh1, acc1, 0, 0, 0);
                acc0 = __builtin_amdgcn_mfma_f32_16x16x32_bf16(ah, bl0, acc0, 0, 0, 0); acc1 = __builtin_amdgcn_mfma_f32_16x16x32_bf16(ah, bl1, acc1, 0, 0, 0);
                acc0 = __builtin_amdgcn_mfma_f32_16x16x32_bf16(al, bh0, acc0, 0, 0, 0); acc1 = __builtin_amdgcn_mfma_f32_16x16x32_bf16(al, bh1, acc1, 0, 0, 0);
            }
#pragma unroll
            for (int r = 0; r < 4; ++r) { lg[(kg * 4 + r) * 32 + tok] = acc0[r]; lg[(kg * 4 + r) * 32 + 16 + tok] = acc1[r]; }
        }
        __builtin_amdgcn_s_waitcnt(0xc07f); asm volatile("" ::: "memory");
        if (lane < 16) {
            const float rr = rinv[lane]; float v[32];
#pragma unroll
            for (int e4 = 0; e4 < 8; ++e4) { const f32x4 t4 = *(const f32x4*)(lg + lane * 32 + e4 * 4), c4 = *(const f32x4*)(cst + e4 * 4);
                v[e4 * 4] = rr * t4.x + c4.x; v[e4 * 4 + 1] = rr * t4.y + c4.y; v[e4 * 4 + 2] = rr * t4.z + c4.z; v[e4 * 4 + 3] = rr * t4.w + c4.w; }
            float tv[4]; int ti[4];
#pragma unroll
            for (int k = 0; k < 4; ++k) { float m = v[0]; int idx = 0;
#pragma unroll
                for (int e = 1; e < 32; ++e) { if (v[e] > m) { m = v[e]; idx = e; } }
                tv[k] = m; ti[k] = idx;
#pragma unroll
                for (int e = 0; e < 32; ++e) if (e == idx) v[e] = -INFINITY; }
            const float e1 = __expf(tv[1] - tv[0]), e2 = __expf(tv[2] - tv[0]), e3 = __expf(tv[3] - tv[0]), inv = 1.f / (1.f + e1 + e2 + e3);
            const int t = tb + lane;
            *(int4*)(TOPI + t * 4) = make_int4(ti[0], ti[1], ti[2], ti[3]);
            *(f32x4*)(TOPW + t * 4) = (f32x4){inv, e1 * inv, e2 * inv, e3 * inv};
            atomicAdd(&cnt[ti[0]], 1); atomicAdd(&cnt[ti[1]], 1); atomicAdd(&cnt[ti[2]], 1); atomicAdd(&cnt[ti[3]], 1);
        }
        __syncthreads();
        if (tid < 32) CNT[blk * 32 + tid] = cnt[tid];
        __syncthreads();
    }
}
__device__ void ph_scatter(const P& p, float* lds) {
    const int tid = otid(), lane = tid & 63, wave = tid >> 6;
    int* tot = (int*)lds; int* pre = tot + 32; int* startp = tot + 64; int* wc = tot + 128;
    const int* CNT = wsp<int>(p, WS_CNT); const int* TOPI = wsp<int>(p, WS_TOPI);
    float* ROWW = wsp<float>(p, WS_ROWSLOT); int* TILEE = wsp<int>(p, WS_TILEE);
    int* ROWTOK = wsp<int>(p, WS_ROWTOK); int* POS = wsp<int>(p, WS_DEN); const float* TOPW = wsp<float>(p, WS_TOPW);
    for (int blk = blockIdx.x; blk < T / 128; blk += gridDim.x) {
        { const int e = tid & 31, g = tid >> 5; int a = 0, b = 0;
#pragma unroll
            for (int q = 0; q < 16; ++q) { const int j = g + 16 * q; const int c = CNT[j * 32 + e]; a += c; if (j < blk) b += c; }
            wc[g * 32 + e] = a; wc[512 + g * 32 + e] = b; }
        __syncthreads();
        if (tid < 32) { int a = 0, b = 0;
#pragma unroll
            for (int g = 0; g < 16; ++g) { a += wc[g * 32 + tid]; b += wc[512 + g * 32 + tid]; }
            tot[tid] = a; pre[tid] = b; }
        __syncthreads();
        if (tid == 0) { int s = 0; for (int e = 0; e < 32; ++e) { startp[e] = s; s += (tot[e] + 255) & ~255; } startp[32] = s; }
        __syncthreads();
        if (blk == 0) {
            if (tid == 0) TILEE[MAXTILES] = startp[32] >> 8;
            for (int e = 0; e < 32; ++e) {
                const int s0 = startp[e], s1 = startp[e + 1];
                for (int tl = (s0 >> 8) + tid; tl < (s1 >> 8); tl += 512) TILEE[tl] = e;
                for (int r = s0 + tot[e] + tid; r < s1; r += 512) { ROWW[r] = 0.f; ROWTOK[r] = 0; }
            }
        }
        const int slot = blk * 512 + tid, e = TOPI[slot]; const float wgt = TOPW[slot];
        int lrank = 0;
        for (int ee = 0; ee < 32; ++ee) { const unsigned long long m = __ballot(e == ee);
            if (e == ee) lrank = __popcll(m & ((1ull << lane) - 1ull));
            if (lane == 0) wc[wave * 32 + ee] = __popcll(m); }
        __syncthreads();
        int base = startp[e] + pre[e] + lrank;
        for (int w = 0; w < wave; ++w) base += wc[w * 32 + e];
        __syncthreads();
        ROWW[base] = wgt; ROWTOK[base] = slot >> 2; POS[slot] = base;
        __syncthreads();
    }
}
__device__ void ph_final(const P& p) {
    const int tid = otid(), lane = tid & 63, gw = blockIdx.x * 8 + (tid >> 6), NGW = gridDim.x * 8;
    const float* X1 = wsp<float>(p, O_X1); const bf16* Y = wsp<bf16>(p, O_Y); const float* mod = wsp<float>(p, WS_MOD); const float* gf = p.in[I_GFIN];
    for (int t = gw; t < T; t += NGW) {
        const int b = t / SEQ; const float* gt2 = mod + b * DIN + 5120;
        const int4 p4 = *(const int4*)(wsp<int>(p, WS_DEN) + t * 4); const int pos[4] = {p4.x, p4.y, p4.z, p4.w};
        f32x4 v[2][2]; float s = 0.f;
#pragma unroll
        for (int j = 0; j < 2; ++j) {
            f32x4 a0 = {0.f, 0.f, 0.f, 0.f}, a1 = {0.f, 0.f, 0.f, 0.f};
#pragma unroll
            for (int k = 0; k < 4; ++k) { const u32x4 u = ((const u32x4*)(Y + (size_t)pos[k] * DM))[lane + 64 * j];
                a0.x += bflo(u.x); a0.y += bfhi(u.x); a0.z += bflo(u.y); a0.w += bfhi(u.y); a1.x += bflo(u.z); a1.y += bfhi(u.z); a1.z += bflo(u.w); a1.w += bfhi(u.w); }
            const f32x4* xr = (const f32x4*)(X1 + (size_t)t * DM) + 2 * lane + 128 * j; const f32x4* gr = (const f32x4*)gt2 + 2 * lane + 128 * j;
            v[j][0] = xr[0] + gr[0] * a0; v[j][1] = xr[1] + gr[1] * a1;
#pragma unroll
            for (int h = 0; h < 2; ++h) s += (v[j][h].x * v[j][h].x + v[j][h].y * v[j][h].y) + (v[j][h].z * v[j][h].z + v[j][h].w * v[j][h].w);
        }
        const float r = rsqrtf(wave_sum(s) * (1.f / DM) + EPS);
#pragma unroll
        for (int j = 0; j < 2; ++j)
#pragma unroll
            for (int h = 0; h < 2; ++h) ((f32x4*)(p.out + (size_t)t * DM))[2 * lane + 128 * j + h] = v[j][h] * r * ((const f32x4*)gf)[2 * lane + 128 * j + h];
    }
}
__device__ __forceinline__ void unit_dec(int unit, int& tok0, int& h) { const int b = unit >> 7; h = (unit >> 5) & 3; tok0 = b * SEQ + (unit & 31) * CH; }

namespace pg8 {
typedef short bf16x8 __attribute__((ext_vector_type(8)));
constexpr int BM = 256, BK = 64, HALF = 128, HTB = HALF * BK * 2, STAGE_BYTES = 8 * HTB, NXCD = 8, WGM = 8;
__host__ __device__ __forceinline__ int lds_byte(int r, int c) { const int st = (r >> 4) * 2 + (c >> 5), rr = r & 15, cc = c & 31, ob = rr * 64 + cc * 2; return st * 1024 + (ob ^ (((ob >> 9) & 1) << 5)); }
__host__ __device__ __forceinline__ void stage_rc(int b, int& R, int& C) { const int st = b / 1024, sb = b % 1024, swz = sb ^ (((sb >> 9) & 1) << 5); R = (st >> 1) * 16 + swz / 64; C = (st & 1) * 32 + (swz % 64) / 2; }
__host__ __device__ __forceinline__ int perm32(int rho) { const int n = rho >> 4, i = rho & 15; return 8 * (i >> 2) + 4 * n + (i & 3); }
struct Unit { const char* a0; const char* a1; const char* b0; const char* b1; int pm, pn; };
struct Gemm { int lda, ldb, nt, nth; const int* rowtok; };
__device__ __forceinline__ unsigned cvt_pk_bf16(float lo, float hi) { unsigned r; asm volatile("v_cvt_pk_bf16_f32 %0, %1, %2" : "=v"(r) : "v"(lo), "v"(hi)); return r; }
__device__ __forceinline__ u32x4 pack8(const f32x4 v0, const f32x4 v1) { u32x4 w; w.x = cvt_pk_bf16(v0[0], v0[1]); w.y = cvt_pk_bf16(v0[2], v0[3]); w.z = cvt_pk_bf16(v1[0], v1[1]); w.w = cvt_pk_bf16(v1[2], v1[3]); return w; }

typedef int v4i_t __attribute__((ext_vector_type(4))); typedef int v8i_t __attribute__((ext_vector_type(8)));
__device__ __forceinline__ v8i_t cat8(const bf16x8 a, const bf16x8 b) { return __builtin_shufflevector(__builtin_bit_cast(v4i_t, a), __builtin_bit_cast(v4i_t, b), 0, 1, 2, 3, 4, 5, 6, 7); }
template <class Epi, class Sched, bool ALIGN_EPI, bool SPLITK = false, bool GATHER = false, bool FP8 = false>
__device__ __forceinline__ void gemm_phase(LAS unsigned char* lds, const Gemm g, const Sched& S, const Epi& E) {
    const int tid = otid(), wid = __builtin_amdgcn_readfirstlane(tid >> 6), lane = tid & 63, wr = wid >> 2, wc = wid & 3, fr = lane & 15, fq = lane >> 4;
    const int nt = g.nt, nth = g.nth;
    unsigned voffA[2], voffB[2];
#pragma unroll
    for (int i = 0; i < 2; ++i) { int R, C; stage_rc(tid * 16 + i * 8192, R, C); const int Rb = Epi::PERM ? ((R & ~31) + perm32(R & 31)) : R;
        voffA[i] = (unsigned)(R * g.lda + C) * 2u; voffB[i] = (unsigned)(Rb * g.ldb + C) * 2u; }
    LAS int* rt = (LAS int*)(lds + 131072); unsigned vC[2][2], vP[2][2];
    if constexpr (GATHER) { Unit uu; for (int i = 0; S.next(i, uu); ++i) if (tid < 256) rt[i * 256 + tid] = g.rowtok[uu.pm * 256 + tid];
        asm volatile("s_waitcnt vmcnt(0) lgkmcnt(0)" ::: "memory"); __builtin_amdgcn_s_barrier(); asm volatile("" ::: "memory"); }
#define PG8_ROWS(dst, iu) do { const int _t = otid(); _Pragma("unroll") for (int _i = 0; _i < 2; ++_i) { int _R, _C; stage_rc(_t * 16 + _i * 8192, _R, _C); _Pragma("unroll") for (int _h = 0; _h < 2; ++_h) dst[_h][_i] = (unsigned)rt[(iu) * 256 + _h * 128 + _R] * (unsigned)(g.lda * 2) + (unsigned)_C * 2u; } } while (0)
#define PG8_STAGE_A(bufoff, gbase, h, V) do { if constexpr (GATHER) { PG8_STAGE(bufoff, gbase, V[h]); } else { PG8_STAGE(bufoff, (gbase) + (h) * hstepA, voffA); } } while (0)
#define PG8_STAGE_A2(bufoff, gbase, h) do { if constexpr (GATHER) { if (last) { PG8_STAGE(bufoff, gbase, vP[h]); } else { PG8_STAGE(bufoff, gbase, vC[h]); } } else { PG8_STAGE(bufoff, (gbase) + (h) * hstepA, voffA); } } while (0)
    const size_t kstep = (size_t)(BK * 2);
    const size_t hstepA = (size_t)HALF * g.lda * 2, hstepB = (size_t)HALF * g.ldb * 2;
    const unsigned ldsw = (unsigned)wid * 1024u;
    const int aoff = lds_byte(wr * 64 + fr, fq * 8), boff = lds_byte(wc * 32 + fr, fq * 8);
    const int one8 = 0x7f7f7f7f;
    constexpr int F2 = 1024;
#define PG8_SA(b, h) (((b) * 2 + (h)) * HTB)
#define PG8_SB(b, h) ((4 + (b) * 2 + (h)) * HTB)
#define PG8_STAGE(bufoff, gbase, voff) do { _Pragma("unroll") for (int _i = 0; _i < 2; ++_i) \
        __builtin_amdgcn_global_load_lds((const unsigned*)((const char*)(gbase) + (voff)[_i]), (LAS unsigned*)(lds + (bufoff) + ldsw + _i * 8192), 16, 0, 0); } while (0)
#define PG8_LDA(dst, b, h) do { _Pragma("unroll") for (int m = 0; m < 4; ++m) { dst[m][0] = *(const LAS bf16x8*)(lds + PG8_SA(b, h) + aoff + m * 2048); dst[m][1] = *(const LAS bf16x8*)(lds + PG8_SA(b, h) + aoff + F2 + m * 2048); } } while (0)
#define PG8_LDB(dst, b, h) do { _Pragma("unroll") for (int n = 0; n < 2; ++n) { dst[n][0] = *(const LAS bf16x8*)(lds + PG8_SB(b, h) + boff + n * 2048); dst[n][1] = *(const LAS bf16x8*)(lds + PG8_SB(b, h) + boff + F2 + n * 2048); } } while (0)
#define PG8_MMA(ai, bj, At, Bt) do { __builtin_amdgcn_s_setprio(1); _Pragma("unroll") for (int m = 0; m < 4; ++m) _Pragma("unroll") for (int n = 0; n < 2; ++n) { \
        if constexpr (FP8) { const v8i_t b8_ = cat8(Bt[n][0], Bt[n][1]), a8_ = cat8(At[m][0], At[m][1]); asm volatile("v_mfma_scale_f32_16x16x128_f8f6f4 %0, %1, %2, %0, %3, %3 op_sel_hi:[0,0,0]" : "+v"(acc[ai][bj][m][n]) : "v"(b8_), "v"(a8_), "v"(one8)); } \
        else { _Pragma("unroll") for (int k = 0; k < 2; ++k) acc[ai][bj][m][n] = __builtin_amdgcn_mfma_f32_16x16x32_bf16(Bt[n][k], At[m][k], acc[ai][bj][m][n], 0, 0, 0); } } __builtin_amdgcn_s_setprio(0); } while (0)
#define PG8_WAIT_V(n) asm volatile("s_waitcnt vmcnt(" #n ")" ::: "memory")
#define PG8_WAIT_L(n) asm volatile("s_waitcnt lgkmcnt(" #n ")" ::: "memory")
#define PG8_BAR __builtin_amdgcn_s_barrier()
#define PG8_SCHED __builtin_amdgcn_sched_barrier(0)
    Unit cur, nxt; int ui = 0;
    if (!S.next(0, cur)) return;
    f32x4 acc[2][2][4][2];
#pragma unroll
    for (int a = 0; a < 2; ++a)
#pragma unroll
        for (int b = 0; b < 2; ++b)
#pragma unroll
            for (int m = 0; m < 4; ++m)
#pragma unroll
                for (int n = 0; n < 2; ++n) acc[a][b][m][n] = (f32x4){0.f, 0.f, 0.f, 0.f};
    bf16x8 At[4][2], B0[2][2], B1[2][2];
    {
        const char* cA = cur.a0; const char* cB = cur.b0;
        if constexpr (GATHER) { PG8_ROWS(vC, 0); }
        PG8_STAGE(PG8_SB(0, 0), cB, voffB); PG8_STAGE(PG8_SB(0, 1), cB + hstepB, voffB); PG8_STAGE_A(PG8_SA(0, 0), cA, 0, vC); PG8_STAGE_A(PG8_SA(0, 1), cA, 1, vC);
        if (wr == 1) PG8_BAR;
        PG8_WAIT_V(2); PG8_BAR;
        PG8_STAGE(PG8_SB(1, 0), cB + kstep, voffB); PG8_STAGE_A(PG8_SA(1, 0), cA + kstep, 0, vC); PG8_STAGE(PG8_SB(1, 1), cB + hstepB + kstep, voffB);
        PG8_WAIT_V(6); PG8_BAR;
    }
    for (;;) {
        const bool has_next = S.next(ui + 1, nxt);
        const char* nA = has_next ? nxt.a0 : cur.a0; const char* nB = has_next ? nxt.b0 : cur.b0;
        if constexpr (GATHER) { PG8_ROWS(vP, has_next ? ui + 1 : ui); }
#pragma unroll 1
        for (int t = 0; t < nt; t += 2) {
            const bool last = (t == nt - 2);
            const char *a1, *a2, *b2;
            if constexpr (SPLITK) {
                a1 = (t + 1 < nth) ? cur.a0 + (size_t)(t + 1) * kstep : cur.a1 + (size_t)(t + 1 - nth) * kstep;
                a2 = last ? nA : ((t + 2 < nth) ? cur.a0 + (size_t)(t + 2) * kstep : cur.a1 + (size_t)(t + 2 - nth) * kstep);
                b2 = last ? nB : ((t + 2 < nth) ? cur.b0 + (size_t)(t + 2) * kstep : cur.b1 + (size_t)(t + 2 - nth) * kstep);
            } else {
                a1 = cur.a0 + (size_t)(t + 1) * kstep; a2 = last ? nA : cur.a0 + (size_t)(t + 2) * kstep; b2 = last ? nB : cur.b0 + (size_t)(t + 2) * kstep;
            }
            const char* a3 = a2 + kstep; const char* b3 = b2 + kstep;
            PG8_LDB(B0, 0, 0); PG8_LDB(B1, 0, 1); PG8_SCHED; PG8_LDA(At, 0, 0); PG8_STAGE_A(PG8_SA(1, 1), a1, 1, vC);
            if constexpr (GATHER) { if (last) { _Pragma("unroll") for (int _h = 0; _h < 2; ++_h) _Pragma("unroll") for (int _i = 0; _i < 2; ++_i) vC[_h][_i] = vP[_h][_i]; } }
            PG8_WAIT_V(8); PG8_WAIT_L(0); PG8_BAR; PG8_MMA(0, 0, At, B0); PG8_MMA(0, 1, At, B1); PG8_BAR; PG8_SCHED;
            PG8_LDA(At, 0, 1); PG8_STAGE(PG8_SB(0, 0), b2, voffB); PG8_STAGE(PG8_SB(0, 1), b2 + hstepB, voffB); PG8_STAGE_A(PG8_SA(0, 0), a2, 0, vC);
            PG8_WAIT_V(8); PG8_WAIT_L(0); PG8_BAR; PG8_MMA(1, 0, At, B0); PG8_MMA(1, 1, At, B1); PG8_BAR; PG8_SCHED;
            PG8_LDB(B0, 1, 0); PG8_LDB(B1, 1, 1); PG8_SCHED; PG8_LDA(At, 1, 0); PG8_STAGE_A(PG8_SA(0, 1), a2, 1, vC);
            PG8_WAIT_V(8); PG8_WAIT_L(0); PG8_BAR; PG8_MMA(0, 0, At, B0); PG8_MMA(0, 1, At, B1); PG8_BAR; PG8_SCHED;
            PG8_LDA(At, 1, 1); PG8_STAGE(PG8_SB(1, 0), b3, voffB); PG8_STAGE(PG8_SB(1, 1), b3 + hstepB, voffB); PG8_STAGE_A(PG8_SA(1, 0), a3, 0, vC);
            PG8_WAIT_V(8); PG8_WAIT_L(0); PG8_BAR; PG8_MMA(1, 0, At, B0); PG8_MMA(1, 1, At, B1); PG8_BAR; PG8_SCHED;
        }
        if constexpr (FP8) asm volatile("s_nop 15\n\ts_nop 15" ::: "memory");
        if constexpr (ALIGN_EPI) { if (wr == 0) PG8_BAR; }
        { int fr_ = fr, fq_ = fq; asm volatile("" : "+v"(fr_), "+v"(fq_)); E(acc, cur, wr, wc, fr_, fq_, lds); }
        if (!has_next) break;
#pragma unroll
        for (int a = 0; a < 2; ++a)
#pragma unroll
            for (int b = 0; b < 2; ++b)
#pragma unroll
                for (int m = 0; m < 4; ++m)
#pragma unroll
                    for (int n = 0; n < 2; ++n) acc[a][b][m][n] = (f32x4){0.f, 0.f, 0.f, 0.f};
        cur = nxt; ++ui;
        if constexpr (GATHER) {
#pragma unroll
            for (int _h = 0; _h < 2; ++_h)
#pragma unroll
                for (int _i = 0; _i < 2; ++_i) vC[_h][_i] = vP[_h][_i]; }
        if constexpr (ALIGN_EPI) { if (wr == 1) PG8_BAR; }
    }
    PG8_WAIT_V(0);
    if constexpr (!ALIGN_EPI) { if (wr == 0) PG8_BAR; }
    PG8_BAR;
#undef PG8_SA
#undef PG8_SB
#undef PG8_STAGE
#undef PG8_STAGE_A
#undef PG8_STAGE_A2
#undef PG8_ROWS
#undef PG8_LDA
#undef PG8_LDB
#undef PG8_MMA
#undef PG8_WAIT_V
#undef PG8_WAIT_L
#undef PG8_BAR
#undef PG8_SCHED
}
struct DenseOrder {
    int nM, nN, nwg, G, c; const char* A; const char* B; size_t tA, tB;
    __device__ void init(int nM_, int nN_, int G_, int c_, const void* A_, int lda, const void* B_, int ldb) { nM = nM_; nN = nN_; nwg = nM * nN; G = G_; c = c_; A = (const char*)A_; B = (const char*)B_; tA = (size_t)BM * lda * 2; tB = (size_t)BM * ldb * 2; }
    __device__ __forceinline__ bool tile(int i, int& pm, int& pn) const {
        const long L = (long)i * G + c; if (L >= nwg) return false;
        int wgid = (int)L; { const int q = nwg / NXCD, r = nwg % NXCD, xcd = wgid % NXCD, off = wgid / NXCD; wgid = (xcd < r ? xcd * (q + 1) : r * (q + 1) + (xcd - r) * q) + off; }
        const int nig = WGM * nN, gid = wgid / nig, fm = gid * WGM, gsz = (nM - fm) < WGM ? (nM - fm) : WGM;
        pm = fm + ((wgid % nig) % gsz); pn = (wgid % nig) / gsz; return true;
    }
    __device__ __forceinline__ bool next(int i, Unit& u) const { int pm, pn; if (!tile(i, pm, pn)) return false; u.pm = pm; u.pn = pn; u.a0 = A + pm * tA; u.b0 = B + pn * tB; u.a1 = u.a0; u.b1 = u.b0; return true; }
};
struct MoeOrder : DenseOrder {
    const int* tile_e; bool gather;
    __device__ __forceinline__ bool next(int i, Unit& u) const { int pm, pn; if (!tile(i, pm, pn)) return false; const int e = tile_e[pm];
        u.pm = pm; u.pn = pn; u.a0 = gather ? A : A + pm * tA; u.b0 = B + ((size_t)e * nN + pn) * tB; u.a1 = u.a0; u.b1 = u.b0; return true; }
};
template <int KIND> struct BatchOrder {
    int G, c; const char* ws;
    __device__ __forceinline__ bool next(int i, Unit& u) const {
        const int unit = i * G + c; if (unit >= NUNIT) return false;
        int t0, h; unit_dec(unit, t0, h); const size_t rowoff = ((size_t)t0 * DM + h * 256) * 2, uoff = (size_t)unit * 131072;
        u.pm = unit; u.pn = 0;
        if (KIND == 0) { u.a0 = ws + O_VT + uoff; u.b0 = ws + O_KWT + uoff; u.a1 = u.a0; u.b1 = u.b0; }
        else if (KIND == 1) { u.a0 = ws + O_Q + rowoff; u.b0 = ws + O_K + rowoff; u.a1 = u.a0; u.b1 = u.b0; }
        else { u.a0 = ws + O_SP + rowoff; u.a1 = ws + O_Q + rowoff; u.b0 = ws + O_VT + uoff; u.b1 = ws + O_CT + uoff; }
        return true;
    }
};
__device__ __forceinline__ f32x4 sig4(const f32x4 v) { f32x4 r; r[0] = sigm(v[0]); r[1] = sigm(v[1]); r[2] = sigm(v[2]); r[3] = sigm(v[3]); return r; }
__device__ __forceinline__ f32x4 lo4(const u32x4 w) { return (f32x4){bflo(w.x), bfhi(w.x), bflo(w.y), bfhi(w.y)}; }
__device__ __forceinline__ f32x4 hi4(const u32x4 w) { return (f32x4){bflo(w.z), bfhi(w.z), bflo(w.w), bfhi(w.w)}; }
typedef f32x4 Acc[2][2][4][2];
struct EpiIn {
    static constexpr bool PERM = true; unsigned char* ws;
    __device__ __forceinline__ void operator()(const Acc& acc, const Unit& u, int wr, int wc, int fr, int fq, LAS unsigned char*) const {
        const int row0 = u.pm * BM + wr * 64 + fr;
        if (u.pn < 8) {
            bf16* O = (bf16*)(ws + O_U1) + u.pn * 128 + wc * 32 + 8 * fq;
#pragma unroll
            for (int ai = 0; ai < 2; ++ai)
#pragma unroll
                for (int m = 0; m < 4; ++m) { const f32x4 v0 = acc[ai][0][m][0] * sig4(acc[ai][1][m][0]), v1 = acc[ai][0][m][1] * sig4(acc[ai][1][m][1]);
                    *(u32x4*)(O + (size_t)(row0 + ai * HALF + m * 16) * DM) = pack8(v0, v1); }
        } else {
            const int t = (u.pn - 8) >> 2; const size_t so = t == 0 ? O_XM : t == 1 ? O_SO : t == 2 ? O_SZA : O_SZB;
            bf16* O = (bf16*)(ws + so) + ((u.pn - 8) & 3) * 256 + wc * 32 + 8 * fq;
#pragma unroll
            for (int ai = 0; ai < 2; ++ai)
#pragma unroll
                for (int m = 0; m < 4; ++m)
#pragma unroll
                    for (int bj = 0; bj < 2; ++bj) { f32x4 v0 = acc[ai][bj][m][0], v1 = acc[ai][bj][m][1]; if (t > 0) { v0 = sig4(v0); v1 = sig4(v1); }
                        *(u32x4*)(O + (size_t)(row0 + ai * HALF + m * 16) * DM + bj * HALF) = pack8(v0, v1); }
        }
    }
};
struct EpiPw {
    static constexpr bool PERM = true; unsigned char* ws; const float* bias;
    __device__ __forceinline__ void operator()(const Acc& acc, const Unit& u, int wr, int wc, int fr, int fq, LAS unsigned char*) const {
        const int row0 = u.pm * BM + wr * 64 + fr, col0 = u.pn * BM + wc * 32 + 8 * fq;
        f32x4 bb[2][2];
#pragma unroll
        for (int bj = 0; bj < 2; ++bj) { bb[bj][0] = *(const f32x4*)(bias + col0 + bj * HALF); bb[bj][1] = *(const f32x4*)(bias + col0 + bj * HALF + 4); }
#pragma unroll
        for (int ai = 0; ai < 2; ++ai) {
            u32x4 z[4][2];
#pragma unroll
            for (int m = 0; m < 4; ++m)
#pragma unroll
                for (int bj = 0; bj < 2; ++bj) z[m][bj] = *(const u32x4*)((const bf16*)(ws + O_SZA) + (size_t)(row0 + ai * HALF + m * 16) * DM + col0 + bj * HALF);
            asm volatile("" ::: "memory");
#pragma unroll
            for (int m = 0; m < 4; ++m)
#pragma unroll
                for (int bj = 0; bj < 2; ++bj) { const size_t o = (size_t)(row0 + ai * HALF + m * 16) * DM + col0 + bj * HALF;
                    *(u32x4*)((bf16*)(ws + O_YAG) + o) = pack8(lo4(z[m][bj]) * (acc[ai][bj][m][0] + bb[bj][0]), hi4(z[m][bj]) * (acc[ai][bj][m][1] + bb[bj][1])); }
            asm volatile("" ::: "memory");
        }
    }
};
struct EpiMo {
    static constexpr bool PERM = true; unsigned char* ws;
    __device__ __forceinline__ void operator()(const Acc& acc, const Unit& u, int wr, int wc, int fr, int fq, LAS unsigned char*) const {
        const int row0 = u.pm * BM + wr * 64 + fr, col0 = u.pn * BM + wc * 32 + 8 * fq;
#pragma unroll
        for (int am = 0; am < 4; ++am) {
            const int ai = am >> 1;
            u32x4 z[2][2], y[2][2];
#pragma unroll
            for (int mm = 0; mm < 2; ++mm)
#pragma unroll
                for (int bj = 0; bj < 2; ++bj) { const size_t o = (size_t)(row0 + ai * HALF + ((am & 1) * 2 + mm) * 16) * DM + col0 + bj * HALF;
                    z[mm][bj] = *(const u32x4*)((const bf16*)(ws + O_SZB) + o); y[mm][bj] = *(const u32x4*)((const bf16*)(ws + O_YAG) + o); }
            asm volatile("" ::: "memory");
#pragma unroll
            for (int mm = 0; mm < 2; ++mm)
#pragma unroll
                for (int bj = 0; bj < 2; ++bj) { const int m = (am & 1) * 2 + mm; const size_t o = (size_t)(row0 + ai * HALF + m * 16) * DM + col0 + bj * HALF;
                    *(u32x4*)((bf16*)(ws + O_MERGED) + o) = pack8(lo4(y[mm][bj]) + lo4(z[mm][bj]) * acc[ai][bj][m][0], hi4(y[mm][bj]) + hi4(z[mm][bj]) * acc[ai][bj][m][1]); }
            asm volatile("" ::: "memory");
        }
    }
};
struct EpiOut {
    static constexpr bool PERM = false; unsigned char* ws; const float* x;
    __device__ __forceinline__ void operator()(const Acc& acc, const Unit& u, int wr, int wc, int fr, int fq, LAS unsigned char*) const {
        const int row0 = u.pm * BM + wr * 64 + fr, col0 = u.pn * BM + wc * 32 + 4 * fq, b = (u.pm * BM) / SEQ;
        const float* gt = (const float*)(ws + WS_MOD) + b * DIN + 2048; float* X1 = (float*)(ws + O_X1); float* ssq = (float*)(ws + WS_SSQ);
        f32x4 gv[2][2];
#pragma unroll
        for (int bj = 0; bj < 2; ++bj)
#pragma unroll
            for (int n = 0; n < 2; ++n) gv[bj][n] = *(const f32x4*)(gt + col0 + bj * HALF + n * 16);
#pragma unroll
        for (int am = 0; am < 4; ++am) {
            const int ai = am >> 1;
            f32x4 xr[2][2][2]; float sq[2] = {0.f, 0.f};
#pragma unroll
            for (int mm = 0; mm < 2; ++mm)
#pragma unroll
                for (int bj = 0; bj < 2; ++bj)
#pragma unroll
                    for (int n = 0; n < 2; ++n) xr[mm][bj][n] = *(const f32x4*)(x + (size_t)(row0 + ai * HALF + ((am & 1) * 2 + mm) * 16) * DM + col0 + bj * HALF + n * 16);
            asm volatile("" ::: "memory");
#pragma unroll
            for (int mm = 0; mm < 2; ++mm)
#pragma unroll
                for (int bj = 0; bj < 2; ++bj)
#pragma unroll
                    for (int n = 0; n < 2; ++n) { const int m = (am & 1) * 2 + mm; const f32x4 v = xr[mm][bj][n] + gv[bj][n] * acc[ai][bj][m][n];
                        *(f32x4*)(X1 + (size_t)(row0 + ai * HALF + m * 16) * DM + col0 + bj * HALF + n * 16) = v; sq[mm] += (v[0] * v[0] + v[1] * v[1]) + (v[2] * v[2] + v[3] * v[3]); }
#pragma unroll
            for (int mm = 0; mm < 2; ++mm) { float q = sq[mm]; q += __shfl_xor(q, 16); q += __shfl_xor(q, 32);
                if (fq == 0) ssq[(size_t)(row0 + ai * HALF + ((am & 1) * 2 + mm) * 16) * 16 + u.pn * 4 + wc] = q; }
            asm volatile("" ::: "memory");
        }
    }
};
struct EpiU {
    static constexpr bool PERM = true; unsigned char* ws;
    __device__ __forceinline__ void operator()(const Acc& acc, const Unit& u, int wr, int wc, int fr, int fq, LAS unsigned char*) const {
        bf16* O = (bf16*)(ws + O_UT) + (size_t)u.pm * 65536 + (wr * 64 + fr) * 256 + wc * 32 + 8 * fq;
#pragma unroll
        for (int ai = 0; ai < 2; ++ai)
#pragma unroll
            for (int m = 0; m < 4; ++m)
#pragma unroll
                for (int bj = 0; bj < 2; ++bj) *(u32x4*)(O + (ai * HALF + m * 16) * 256 + bj * HALF) = pack8(acc[ai][bj][m][0], acc[ai][bj][m][1]);
    }
};
struct EpiS {
    static constexpr bool PERM = true; unsigned char* ws;
    __device__ __forceinline__ void operator()(const Acc& acc, const Unit& u, int wr, int wc, int fr, int fq, LAS unsigned char*) const {
        int t0, h; unit_dec(u.pm, t0, h);
        const int r0 = wr * 64 + fr, c0 = wc * 32 + 8 * fq;
        const float* cw = (const float*)(ws + WS_CW) + u.pm * 256 + c0; float* denp = (float*)(ws + WS_DENP) + (size_t)u.pm * 1024;
        bf16* O = (bf16*)(ws + O_SP) + (size_t)t0 * DM + h * 256 + c0;
        f32x4 w[2][2];
#pragma unroll
        for (int bj = 0; bj < 2; ++bj)
#pragma unroll
            for (int n = 0; n < 2; ++n) w[bj][n] = *(const f32x4*)(cw + bj * HALF + 4 * n);
#pragma unroll
        for (int ai = 0; ai < 2; ++ai)
#pragma unroll
            for (int m = 0; m < 4; ++m) { const int r = r0 + ai * HALF + m * 16; float rs = 0.f;
#pragma unroll
                for (int bj = 0; bj < 2; ++bj) { f32x4 v[2];
#pragma unroll
                    for (int n = 0; n < 2; ++n) { v[n] = acc[ai][bj][m][n] * w[bj][n]; const int c = c0 + bj * HALF + 4 * n;
#pragma unroll
                        for (int j = 0; j < 4; ++j) { if (c + j > r) v[n][j] = 0.f; rs += v[n][j]; } }
                    *(u32x4*)(O + (size_t)r * DM + bj * HALF) = pack8(v[0], v[1]); }
                rs += __shfl_xor(rs, 16); rs += __shfl_xor(rs, 32);
                if (fq == 0) denp[r * 4 + wc] = rs;
                asm volatile("" ::: "memory"); }
    }
};
struct EpiO {
    static constexpr bool PERM = true; unsigned char* ws; const float* hng; const float* skip;
    __device__ __forceinline__ void operator()(Acc& acc, const Unit& u, int wr, int wc, int fr, int fq, LAS unsigned char* lds) const {
        int t0, h; unit_dec(u.pm, t0, h);
        LAS float* inv = (LAS float*)(lds + 131072);
        LAS float* PS = inv + 256;
        LAS float* nsl = PS + 2048;
        const int tid = otid();
        const int r0 = wr * 64 + fr, c0 = wc * 32 + 8 * fq;
        if (tid < 256) {
            const f32x4 dp = *(const f32x4*)((const float*)(ws + WS_DENP) + (size_t)u.pm * 1024 + tid * 4); const float fl = ((const float*)(ws + WS_FLOOR))[u.pm * 256 + tid];
            const float den = nsl[((u.pm - (int)blockIdx.x) / (int)gridDim.x) * 256 + tid] + (dp[0] + dp[1]) + (dp[2] + dp[3]);
            inv[tid] = __builtin_amdgcn_rcpf(fmaxf(fabsf(den), fl)); }
        u32x4 gin[4][2];
        asm volatile("s_waitcnt lgkmcnt(0)" ::: "memory"); __builtin_amdgcn_s_barrier(); asm volatile("" ::: "memory");
#pragma unroll
        for (int ai = 0; ai < 2; ++ai) {
#pragma unroll
            for (int m = 0; m < 4; ++m)
#pragma unroll
                for (int bj = 0; bj < 2; ++bj) gin[m][bj] = *(const u32x4*)((const bf16*)(ws + O_SO) + (size_t)(t0 + r0 + ai * HALF + m * 16) * DM + h * 256 + c0 + bj * HALF);
            asm volatile("" ::: "memory");
#pragma unroll
            for (int m = 0; m < 4; ++m) { const int r = r0 + ai * HALF + m * 16; const float iv = inv[r]; float s = 0.f, q = 0.f;
#pragma unroll
                for (int bj = 0; bj < 2; ++bj) { const u32x4 so = gin[m][bj];
                    const f32x4 v0 = acc[ai][bj][m][0] * iv * lo4(so), v1 = acc[ai][bj][m][1] * iv * hi4(so); acc[ai][bj][m][0] = v0; acc[ai][bj][m][1] = v1;
                    s += (v0[0] + v0[1]) + (v0[2] + v0[3]) + (v1[0] + v1[1]) + (v1[2] + v1[3]);
                    q += (v0[0] * v0[0] + v0[1] * v0[1]) + (v0[2] * v0[2] + v0[3] * v0[3]) + (v1[0] * v1[0] + v1[1] * v1[1]) + (v1[2] * v1[2] + v1[3] * v1[3]); }
                s += __shfl_xor(s, 16); s += __shfl_xor(s, 32); q += __shfl_xor(q, 16); q += __shfl_xor(q, 32);
                if (fq == 0) { PS[(r * 4 + wc) * 2] = s; PS[(r * 4 + wc) * 2 + 1] = q; } }
            asm volatile("" ::: "memory");
        }
        asm volatile("s_waitcnt lgkmcnt(0)" ::: "memory"); __builtin_amdgcn_s_barrier(); asm volatile("" ::: "memory");
#pragma unroll
        for (int ai = 0; ai < 2; ++ai) {
#pragma unroll
            for (int m = 0; m < 4; ++m)
#pragma unroll
                for (int bj = 0; bj < 2; ++bj) gin[m][bj] = *(const u32x4*)((const bf16*)(ws + O_XC) + (size_t)(t0 + r0 + ai * HALF + m * 16) * DM + h * 256 + c0 + bj * HALF);
            asm volatile("" ::: "memory");
#pragma unroll
            for (int m = 0; m < 4; ++m) { const int r = r0 + ai * HALF + m * 16;
                const f32x4 p0 = *(const LAS f32x4*)(PS + r * 8), p1 = *(const LAS f32x4*)(PS + r * 8 + 4);
                const float mu = ((p0[0] + p0[2]) + (p1[0] + p1[2])) * (1.f / 256.f), ex2 = ((p0[1] + p0[3]) + (p1[1] + p1[3])) * (1.f / 256.f), rs = rsqrtf(fmaxf(ex2 - mu * mu, 0.f) + EPS);
#pragma unroll
                for (int bj = 0; bj < 2; ++bj) { const size_t o = (size_t)(t0 + r) * DM + h * 256 + c0 + bj * HALF; const u32x4 xc = gin[m][bj];
                    const float* gp = hng + h * 256 + c0 + bj * HALF; const float* sp_ = skip + h * 256 + c0 + bj * HALF;
                    const f32x4 v0 = (acc[ai][bj][m][0] - mu) * rs * *(const f32x4*)gp + *(const f32x4*)sp_ * lo4(xc), v1 = (acc[ai][bj][m][1] - mu) * rs * *(const f32x4*)(gp + 4) + *(const f32x4*)(sp_ + 4) * hi4(xc);
                    *(u32x4*)((bf16*)(ws + O_MOIN) + o) = pack8(v0, v1); } }
            asm volatile("" ::: "memory");
        }
        asm volatile("s_waitcnt lgkmcnt(0)" ::: "memory"); __builtin_amdgcn_s_barrier(); asm volatile("" ::: "memory");
    }
};
struct EpiGu {
    static constexpr bool PERM = true; unsigned char* ws; const float* bgu;
    __device__ __forceinline__ void operator()(const Acc& acc, const Unit& u, int wr, int wc, int fr, int fq, LAS unsigned char*) const {
        const int e = ((const int*)(ws + WS_TILEE))[u.pm]; const int ch0 = u.pn * 128 + wc * 32 + 8 * fq;
        const float* bb = bgu + e * 2048 + ch0;
        const f32x4 bg0 = *(const f32x4*)(bb), bg1 = *(const f32x4*)(bb + 4), bu0 = *(const f32x4*)(bb + 1024), bu1 = *(const f32x4*)(bb + 1028);
        unsigned char* O = ws + O_ACT + (size_t)(u.pm * BM + wr * 64 + fr) * KP8 + ch0;
        constexpr float ds = 1.f / (S_HM * S_W);
#pragma unroll
        for (int ai = 0; ai < 2; ++ai)
#pragma unroll
            for (int m = 0; m < 4; ++m) { f32x4 v[2];
#pragma unroll
                for (int n = 0; n < 2; ++n) { const f32x4 gt = acc[ai][0][m][n] * ds + (n ? bg1 : bg0), up = acc[ai][1][m][n] * ds + (n ? bu1 : bu0);
#pragma unroll
                    for (int j = 0; j < 4; ++j) { const float gg = fminf(gt[j], 7.f), uu = __builtin_amdgcn_fmed3f(up[j], -7.f, 7.f);
                        const float sg = __builtin_amdgcn_rcpf(1.f + __builtin_amdgcn_exp2f(gg * (-1.702f * 1.4426950408889634f)));
                        v[n][j] = (uu * S_ACT + S_ACT) * (gg * sg); } }
                u32x2 w8; w8.x = pk4_fp8_nc(v[0][0], v[0][1], v[0][2], v[0][3]); w8.y = pk4_fp8_nc(v[1][0], v[1][1], v[1][2], v[1][3]);
                *(u32x2*)(O + (size_t)(ai * HALF + m * 16) * KP8) = w8; }
    }
};
struct EpiDn {
    static constexpr bool PERM = true; unsigned char* ws; const float* bdn;
    __device__ __forceinline__ void operator()(const Acc& acc, const Unit& u, int wr, int wc, int fr, int fq, LAS unsigned char*) const {
        const int e = ((const int*)(ws + WS_TILEE))[u.pm]; const int col0 = u.pn * BM + wc * 32 + 8 * fq, row0 = u.pm * BM + wr * 64 + fr;
        const float* roww = (const float*)(ws + WS_ROWSLOT); bf16* Y = (bf16*)(ws + O_Y);
        float w[2][4];
#pragma unroll
        for (int ai = 0; ai < 2; ++ai)
#pragma unroll
            for (int m = 0; m < 4; ++m) w[ai][m] = roww[row0 + ai * HALF + m * 16];
        f32x4 b[2][2];
#pragma unroll
        for (int bj = 0; bj < 2; ++bj)
#pragma unroll
            for (int n = 0; n < 2; ++n) b[bj][n] = *(const f32x4*)(bdn + e * DM + col0 + bj * HALF + 4 * n);
        asm volatile("" ::: "memory");
#pragma unroll
        for (int ai = 0; ai < 2; ++ai)
#pragma unroll
            for (int m = 0; m < 4; ++m)
#pragma unroll
                for (int bj = 0; bj < 2; ++bj) *(u32x4*)(Y + (size_t)(row0 + ai * HALF + m * 16) * DM + col0 + bj * HALF) = pack8((acc[ai][bj][m][0] * (1.f / (S_ACT * S_W)) + b[bj][0]) * w[ai][m], (acc[ai][bj][m][1] * (1.f / (S_ACT * S_W)) + b[bj][1]) * w[ai][m]);
    }
};
}


__device__ __forceinline__ void ph_g_in(const P& p, LAS unsigned char* lds) {
    pg8::Gemm g{DM, DM, 16, 16, nullptr}; pg8::DenseOrder S; S.init(T / 256, DIN / 256, gridDim.x, blockIdx.x, p.ws + O_HA, DM, p.ws + WS_WIN, DM);
    pg8::EpiIn E{p.ws}; pg8::gemm_phase<pg8::EpiIn, pg8::DenseOrder, true>(lds, g, S, E);
}
__device__ __forceinline__ void ph_g_pw(const P& p, LAS unsigned char* lds) {
    pg8::Gemm g{DM, DM, 16, 16, nullptr}; pg8::DenseOrder S; S.init(T / 256, 4, gridDim.x, blockIdx.x, p.ws + O_YAPRE, DM, p.ws + WS_WPW, DM);
    pg8::EpiPw E{p.ws, p.in[I_BPW]}; pg8::gemm_phase<pg8::EpiPw, pg8::DenseOrder, true>(lds, g, S, E);
}
__device__ __forceinline__ void ph_g_mo(const P& p, LAS unsigned char* lds) {
    pg8::Gemm g{DM, DM, 16, 16, nullptr}; pg8::DenseOrder S; S.init(T / 256, 4, gridDim.x, blockIdx.x, p.ws + O_MOIN, DM, p.ws + WS_WMO, DM);
    pg8::EpiMo E{p.ws}; pg8::gemm_phase<pg8::EpiMo, pg8::DenseOrder, true>(lds, g, S, E);
}
__device__ __forceinline__ void ph_g_out(const P& p, LAS unsigned char* lds) {
    pg8::Gemm g{DM, DM, 16, 16, nullptr}; pg8::DenseOrder S; S.init(T / 256, 4, gridDim.x, blockIdx.x, p.ws + O_MERGED, DM, p.ws + WS_WOUT, DM);
    pg8::EpiOut E{p.ws, p.in[I_X]}; pg8::gemm_phase<pg8::EpiOut, pg8::DenseOrder, true>(lds, g, S, E);
}
__device__ __forceinline__ void ph_g_u(const P& p, LAS unsigned char* lds) {
    pg8::Gemm g{256, 256, 4, 4, nullptr}; pg8::BatchOrder<0> S{(int)gridDim.x, (int)blockIdx.x, (const char*)p.ws};
    pg8::EpiU E{p.ws}; pg8::gemm_phase<pg8::EpiU, pg8::BatchOrder<0>, true>(lds, g, S, E);
}
__device__ __forceinline__ void ph_g_s(const P& p, LAS unsigned char* lds) {
    pg8::Gemm g{DM, DM, 4, 4, nullptr}; pg8::BatchOrder<1> S{(int)gridDim.x, (int)blockIdx.x, (const char*)p.ws};
    pg8::EpiS E{p.ws}; pg8::gemm_phase<pg8::EpiS, pg8::BatchOrder<1>, true>(lds, g, S, E);
}
__device__ __forceinline__ void g_o_qn(const P& p, LAS unsigned char* lds) {
    const int tid = otid(), lane = tid & 63, wave = tid >> 6;
    LAS float* qn = (LAS float*)(lds + 131072) + 256 + 2048;
    int ui = 0;
    for (int unit = blockIdx.x; unit < NUNIT; unit += gridDim.x, ++ui) {
        int t0, h; unit_dec(unit, t0, h);
        const f32x4 n4 = ((const f32x4*)(wsp<float>(p, WS_NS) + unit * 256))[lane];
        const bf16* q = wsp<bf16>(p, O_Q) + (size_t)(t0 + wave * 32) * DM + h * 256 + 4 * lane;
        float v[32];
#pragma unroll
        for (int r = 0; r < 32; ++r) { const u32x2 w2 = *(const u32x2*)(q + (size_t)r * DM); v[r] = (bflo(w2.x) * n4.x + bfhi(w2.x) * n4.y) + (bflo(w2.y) * n4.z + bfhi(w2.y) * n4.w); }
        float a16[16], a8[8], a4[4], a2[2], a1;
        { const bool hi = lane & 32;
#pragma unroll
          for (int i = 0; i < 16; ++i) { const float keep = hi ? v[2 * i + 1] : v[2 * i], send = hi ? v[2 * i] : v[2 * i + 1]; a16[i] = keep + __shfl_xor(send, 32); } }
        { const bool hi = lane & 16;
#pragma unroll
          for (int i = 0; i < 8; ++i) { const float keep = hi ? a16[2 * i + 1] : a16[2 * i], send = hi ? a16[2 * i] : a16[2 * i + 1]; a8[i] = keep + __shfl_xor(send, 16); } }
        { const bool hi = lane & 8;
#pragma unroll
          for (int i = 0; i < 4; ++i) { const float keep = hi ? a8[2 * i + 1] : a8[2 * i], send = hi ? a8[2 * i] : a8[2 * i + 1]; a4[i] = keep + __shfl_xor(send, 8); } }
        { const bool hi = lane & 4;
#pragma unroll
          for (int i = 0; i < 2; ++i) { const float keep = hi ? a4[2 * i + 1] : a4[2 * i], send = hi ? a4[2 * i] : a4[2 * i + 1]; a2[i] = keep + __shfl_xor(send, 4); } }
        { const bool hi = lane & 2; const float keep = hi ? a2[1] : a2[0], send = hi ? a2[0] : a2[1]; a1 = keep + __shfl_xor(send, 2); }
        a1 += __shfl_xor(a1, 1);
        if ((lane & 1) == 0) { const int r = ((lane >> 1) & 1) * 16 + ((lane >> 2) & 1) * 8 + ((lane >> 3) & 1) * 4 + ((lane >> 4) & 1) * 2 + ((lane >> 5) & 1); qn[ui * 256 + wave * 32 + r] = a1; }
    }
    asm volatile("s_waitcnt lgkmcnt(0)" ::: "memory"); __syncthreads();
}
__device__ __forceinline__ void ph_g_o(const P& p, LAS unsigned char* lds) {
    g_o_qn(p, lds);
    pg8::Gemm g{DM, 256, 8, 4, nullptr}; pg8::BatchOrder<2> S{(int)gridDim.x, (int)blockIdx.x, (const char*)p.ws};
    pg8::EpiO E{p.ws, p.in[I_HNG], p.in[I_SKIP]}; pg8::gemm_phase<pg8::EpiO, pg8::BatchOrder<2>, true, true>(lds, g, S, E);
}
__device__ __forceinline__ void ph_g_gu(const P& p, LAS unsigned char* lds) {
    const int nt_ = __builtin_amdgcn_readfirstlane(wsp<int>(p, WS_TILEE)[MAXTILES]);
    pg8::Gemm g{512, KP8 / 2, 8, 8, wsp<int>(p, WS_ROWTOK)}; pg8::MoeOrder S; S.init(nt_, 8, gridDim.x, blockIdx.x, p.ws + O_HM, 512, p.ws + WS_WGU, KP8 / 2); S.tile_e = wsp<int>(p, WS_TILEE); S.gather = true;
    pg8::EpiGu E{p.ws, p.in[I_BGU]}; pg8::gemm_phase<pg8::EpiGu, pg8::MoeOrder, true, false, true, true>(lds, g, S, E);
}
__device__ __forceinline__ void ph_g_dn(const P& p, LAS unsigned char* lds) {
    const int nt_ = __builtin_amdgcn_readfirstlane(wsp<int>(p, WS_TILEE)[MAXTILES]);
    pg8::Gemm g{KP8 / 2, KP8 / 2, 8, 8, nullptr}; pg8::MoeOrder S; S.init(nt_, 4, gridDim.x, blockIdx.x, p.ws + O_ACT, KP8 / 2, p.ws + WS_WDN, KP8 / 2); S.tile_e = wsp<int>(p, WS_TILEE); S.gather = false;
    pg8::EpiDn E{p.ws, p.in[I_BDN]}; pg8::gemm_phase<pg8::EpiDn, pg8::MoeOrder, true, false, false, true>(lds, g, S, E);
}

#define XB_TMO      128
#define XB_XCNT(j)  (256  + 64 * (j))
#define XB_XSUB(j)  (1280 + 64 * (j))
#define XB_XGEN(j)  (2304 + 64 * (j))
#define XB_TOP      3328
#define XB_TOPGEN   3392
#define XCD_BAR_WORDS 3456
#define XB_SPIN_CAP (1u << 18)
__device__ __forceinline__ unsigned xb_ld(unsigned* p)              { return __hip_atomic_load(p, __ATOMIC_RELAXED, __HIP_MEMORY_SCOPE_AGENT); }
__device__ __forceinline__ unsigned xb_add(unsigned* p, unsigned v) { return __hip_atomic_fetch_add(p, v, __ATOMIC_RELAXED, __HIP_MEMORY_SCOPE_AGENT); }
__device__ __forceinline__ unsigned xb_xcc_id() { return (unsigned)__builtin_amdgcn_s_getreg((3 << 11) | 20) & 0xFu; }
#define XB_SPIN(cond, bar) do { unsigned _sp = 0; while (cond) { __builtin_amdgcn_s_sleep(1); \
    if ((++_sp & 255u) == 0u) { if (xb_ld(&(bar)[XB_TMO])) break; if (_sp > XB_SPIN_CAP) { atomicAdd(&(bar)[XB_TMO], 1u); break; } } } } while (0)
struct XcdBarrier { unsigned* bar; unsigned x; volatile LAS unsigned* st; };
__device__ __forceinline__ XcdBarrier xcd_barrier_post(unsigned* bar, volatile LAS unsigned* st) {
    XcdBarrier b; b.bar = bar; b.x = xb_xcc_id(); b.st = st;
    if (threadIdx.x == 0) (void)xb_add(&bar[XB_XCNT(b.x)], 1u);
    return b;
}
__device__ __forceinline__ void xcd_barrier_complete(unsigned* bar, unsigned x, unsigned& nloc, unsigned& nx) {
    const unsigned G = gridDim.x * gridDim.y * gridDim.z;
    unsigned sum, cnt, mine, sp = 0u;
    for (;;) {
        sum = 0u; cnt = 0u; mine = 0u;
#pragma unroll
        for (unsigned j = 0; j < 16; ++j) { const unsigned c = xb_ld(&bar[XB_XCNT(j)]); sum += c; cnt += (c > 0u) ? 1u : 0u; mine = (j == x) ? c : mine; }
        if (sum == G) break;
        __builtin_amdgcn_s_sleep(1);
        if ((++sp & 255u) == 0u) { if (xb_ld(&bar[XB_TMO])) break; if (sp > XB_SPIN_CAP) { atomicAdd(&bar[XB_TMO], 1u); break; } }
    }
    nloc = mine > 0u ? mine : 1u; nx = cnt > 0u ? cnt : 1u;
}
__device__ __forceinline__ void xcd_barrier(const XcdBarrier& b) {
    asm volatile("s_waitcnt vmcnt(0)" ::: "memory");
    __syncthreads();
    if (threadIdx.x == 0) {
        unsigned* bar = b.bar;
        __builtin_amdgcn_s_waitcnt(0);
        unsigned nloc = b.st[0], nx = b.st[1];
        if (nloc == 0u) { xcd_barrier_complete(bar, b.x, nloc, nx); b.st[0] = nloc; b.st[1] = nx; }
        const unsigned old = xb_add(&bar[XB_XSUB(b.x)], 1u);
        const unsigned gen = old / nloc;
        if (old + 1u == (gen + 1u) * nloc) {
            __builtin_amdgcn_fence(__ATOMIC_RELEASE, "agent");
            asm volatile("s_waitcnt vmcnt(0)" ::: "memory");
            const unsigned og = xb_add(&bar[XB_TOP], 1u);
            const unsigned tg = og / nx;
            if (og + 1u == (tg + 1u) * nx) xb_add(&bar[XB_TOPGEN], 1u);
            else XB_SPIN(xb_ld(&bar[XB_TOPGEN]) == tg, bar);
            __builtin_amdgcn_fence(__ATOMIC_ACQUIRE, "agent");
            xb_add(&bar[XB_XGEN(b.x)], 1u);
            asm volatile("s_waitcnt vmcnt(0)" ::: "memory");
        } else {
            XB_SPIN(xb_ld(&bar[XB_XGEN(b.x)]) == gen, bar);
            __builtin_amdgcn_fence(__ATOMIC_ACQUIRE, "agent");
            asm volatile("s_waitcnt vmcnt(0)" ::: "memory");
        }
    }
    __syncthreads();
}

constexpr int LDS_BYTES = 155648, MISC_OFF = LDS_BYTES - 64;
constexpr int NPHASE = 13;
#ifndef DUP
#define DUP 0
#endif
#ifndef SPINMASK
#define SPINMASK 0
#endif
#define RUN(id, call) do { call; if ((DUP >> (id)) & 1) { __syncthreads(); call; } } while (0)
__global__ void __launch_bounds__(512, 2) mega(P p, int lo, int hi) {
    extern __shared__ __attribute__((aligned(16))) unsigned char lds_raw[];
    float* lds = (float*)lds_raw; LAS unsigned char* l3 = (LAS unsigned char*)lds_raw;
    volatile LAS unsigned* misc = (volatile LAS unsigned*)(l3 + MISC_OFF);
    if (threadIdx.x < 16) misc[threadIdx.x] = 0u;
    __syncthreads();
    XcdBarrier bar; bar.bar = wsp<unsigned>(p, WS_CTL); bar.x = 0; bar.st = misc;
    if (hi - lo > 1) bar = xcd_barrier_post(wsp<unsigned>(p, WS_CTL), misc);
    for (int ph = lo; ph < hi; ++ph) {
        const unsigned long long t0_ = SPINMASK ? __builtin_amdgcn_s_memrealtime() : 0ull;
        switch (ph) {
            case 0: ph_mod(p, lds); RUN(1, ph_wconv(p, lds)); mod_wait(p); RUN(2, ph_norm1(p)); break;
            case 1: RUN(3, ph_g_in(p, l3)); break;
            case 2: ph_wprime(p, lds); RUN(4, ph_conv(p, lds)); RUN(5, ph_m1(p, lds)); break;
            case 3: RUN(6, ph_m2(p, lds));
                    asm volatile("s_waitcnt vmcnt(0)" ::: "memory"); __syncthreads();
                    RUN(8, ph_g_u(p, l3)); RUN(7, ph_g_pw(p, l3)); break;
            case 4: RUN(10, ph_scan(p)); break;
            case 5: RUN(9, ph_g_s(p, l3));
                    asm volatile("s_waitcnt vmcnt(0)" ::: "memory"); __syncthreads();
                    RUN(11, ph_g_o(p, l3)); break;
            case 6: RUN(12, ph_g_mo(p, l3)); break;
            case 7: RUN(13, ph_g_out(p, l3)); break;
            case 8: RUN(14, ph_router(p, lds)); break;
            case 9: RUN(15, ph_scatter(p, lds)); break;
            case 10: RUN(16, ph_g_gu(p, l3)); break;
            case 11: RUN(17, ph_g_dn(p, l3)); break;
            case 12: RUN(18, ph_final(p)); break;
        }
        if (ph + 1 < hi || (SPINMASK >> ph) & 1) xcd_barrier(bar);
        if ((SPINMASK >> ph) & 1) { const unsigned long long t1_ = __builtin_amdgcn_s_memrealtime(), d_ = t1_ - t0_; while (__builtin_amdgcn_s_memrealtime() - t1_ < d_) __builtin_amdgcn_s_sleep(8); }
    }
}

#ifndef N_LAUNCHES
#define N_LAUNCHES 1
#endif
extern "C" void kernel_launch(void* const* d_in, const int* in_sizes, int n_in, void* d_out, int out_size, void* d_ws, size_t ws_size, hipStream_t stream) {
    static int grid = 0;
    if (grid == 0) {
        if (n_in != 31 || ws_size < WS_NEED || out_size != T * DM) { fprintf(stderr, "kernel_launch: unexpected shapes: n_in %d ws %zu out %d\n", n_in, ws_size, out_size); grid = -1; return; }
        int dev = 0, cus = 0, per_cu = 0;
        if (hipGetDevice(&dev) != hipSuccess || hipDeviceGetAttribute(&cus, hipDeviceAttributeMultiprocessorCount, dev) != hipSuccess) { fprintf(stderr, "kernel_launch: device query failed\n"); grid = -1; return; }
        if (hipFuncSetAttribute((const void*)mega, hipFuncAttributeMaxDynamicSharedMemorySize, LDS_BYTES) != hipSuccess) { fprintf(stderr, "kernel_launch: hipFuncSetAttribute failed\n"); grid = -1; return; }
        if (hipOccupancyMaxActiveBlocksPerMultiprocessor(&per_cu, (const void*)mega, 512, LDS_BYTES) != hipSuccess || per_cu < 1) { fprintf(stderr, "kernel_launch: occupancy query says %d blocks per CU\n", per_cu); (void)hipGetLastError(); grid = -1; return; }
        grid = cus;
    }
    if (grid < 0) return;
    P p{};
    for (int i = 0; i < 31; ++i) p.in[i] = (const float*)d_in[i];
    p.out = (float*)d_out; p.ws = (unsigned char*)d_ws;
    (void)hipMemsetAsync((char*)d_ws + WS_CTL, 0, 65536, stream);
    if (N_LAUNCHES == 1) hipLaunchKernelGGL(mega, dim3(grid), dim3(512), LDS_BYTES, stream, p, 0, NPHASE);
    else for (int ph = 0; ph < NPHASE; ++ph) hipLaunchKernelGGL(mega, dim3(grid), dim3(512), LDS_BYTES, stream, p, ph, ph + 1);
}
```

```cpp
#include <hip/hip_runtime.h>
#include <cstdio>
#include <cstdint>

constexpr int DM = 1024, NB_ = 4, SEQ = 8192, T = NB_ * SEQ, NE = 32, TOPK = 4, DIN = 6144;
constexpr int CH = 256;
constexpr int NCH = SEQ / CH;
constexpr int NUNIT = NB_ * 4 * NCH;
constexpr int MAXTILES = 544;
constexpr float EPS = 1e-6f;

typedef unsigned short bf16;
typedef float f32x4 __attribute__((ext_vector_type(4)));
typedef unsigned u32x4 __attribute__((ext_vector_type(4)));
typedef unsigned u32x2 __attribute__((ext_vector_type(2)));

constexpr size_t MB = 1u << 20;
constexpr size_t WS_WGU = 0, WS_WDN = 76 * MB;
constexpr size_t SLAB0 = 192 * MB, SLABSZ = 64 * MB;
#define SLAB(i) (SLAB0 + (size_t)(i) * SLABSZ)
constexpr size_t WS_WIN = 960 * MB, WS_WPW = 972 * MB, WS_WMO = 974 * MB, WS_WOUT = 976 * MB;
constexpr size_t WS_CTL = 978 * MB, WS_MOD = 979 * MB, WS_IG = 980 * MB, WS_LOGF = 980 * MB + 512 * 1024;
constexpr size_t WS_CW = 981 * MB, WS_FLOOR = 981 * MB + 512 * 1024, WS_UNITS = 982 * MB, WS_NLOC = 983 * MB, WS_NS = 984 * MB;
constexpr size_t WS_DENP = 985 * MB, WS_DEN = 987 * MB, WS_TOPI = 988 * MB, WS_TOPW = 989 * MB, WS_CNT = 990 * MB, WS_ROWSLOT = 991 * MB, WS_TILEE = 992 * MB;
constexpr size_t WS_ROWTOK = 997 * MB;
constexpr size_t WS_SSQ = WS_DENP;
constexpr size_t WS_MODCNT = WS_CTL + 40960;
constexpr size_t WS_WPR = 998 * MB;
constexpr size_t WS_GP = 993 * MB;
constexpr size_t WS_NEED = 1024 * MB;
constexpr size_t O_HA = SLAB(0), O_YAPRE = SLAB(0), O_MOIN = SLAB(0);
constexpr size_t O_UT = SLAB(11);
constexpr size_t O_SP = 116 * MB;
constexpr size_t O_U1 = SLAB(1), O_KWT = SLAB(1), O_CT = SLAB(1);
constexpr size_t O_XM = SLAB(2), O_VT = SLAB(8);
constexpr size_t O_SO = SLAB(3);
constexpr size_t O_SZA = SLAB(4);
constexpr size_t O_SZB = SLAB(5);
constexpr size_t O_Q = SLAB(6), O_K = SLAB(7), O_V = SLAB(8), O_XC = SLAB(9), O_YAG = SLAB(10), O_MERGED = SLAB(11);
constexpr size_t O_HG = SLAB(7);
constexpr size_t O_X1 = SLAB(0);
constexpr size_t O_HM = SLAB(2);
constexpr size_t O_XS = SLAB(3), O_Y = SLAB(3);
constexpr size_t O_ACT = SLAB(8);

struct P { const float* in[31]; float* out; unsigned char* ws; };
enum { I_X = 0, I_C, I_WADA, I_BADA, I_GMIX, I_WIN, I_WDW, I_BDW, I_LNG, I_LNB, I_WPW, I_BPW, I_WSC, I_BSC, I_WQ, I_WK, I_WV, I_WIF, I_BIF, I_HNG, I_SKIP,
       I_WMO, I_WOUT, I_GMOE, I_WR, I_BR, I_WGU, I_BGU, I_WDN, I_BDN, I_GFIN };

#define LAS __attribute__((address_space(3)))
__device__ __forceinline__ unsigned f2bf(float f) { unsigned u = __float_as_uint(f); return (u + 0x7fffu + ((u >> 16) & 1u)) >> 16; }
__device__ __forceinline__ float bf2f(unsigned h) { return __uint_as_float(h << 16); }
__device__ __forceinline__ unsigned pk2(float lo, float hi) { unsigned r; asm volatile("v_cvt_pk_bf16_f32 %0, %1, %2" : "=v"(r) : "v"(lo), "v"(hi)); return r; }
__device__ __forceinline__ float bflo(unsigned w) { return __uint_as_float(w << 16); }
__device__ __forceinline__ float bfhi(unsigned w) { return __uint_as_float(w & 0xffff0000u); }
__device__ __forceinline__ unsigned pk4_fp8(float a, float b, float c, float d) {
    a = fminf(fmaxf(a, -448.f), 448.f); b = fminf(fmaxf(b, -448.f), 448.f); c = fminf(fmaxf(c, -448.f), 448.f); d = fminf(fmaxf(d, -448.f), 448.f);
    int w = 0; w = __builtin_amdgcn_cvt_pk_fp8_f32(a, b, w, false); w = __builtin_amdgcn_cvt_pk_fp8_f32(c, d, w, true); return (unsigned)w; }
__device__ __forceinline__ unsigned pk4_fp8_nc(float a, float b, float c, float d) { int w = 0; w = __builtin_amdgcn_cvt_pk_fp8_f32(a, b, w, false); w = __builtin_amdgcn_cvt_pk_fp8_f32(c, d, w, true); return (unsigned)w; }
typedef float f32x2_ __attribute__((ext_vector_type(2)));
constexpr int KP8 = 1152;
constexpr float S_HM = 32.f, S_W = 1024.f, S_ACT = 4.f, S_Y = 32.f;
__device__ __forceinline__ float sigm(float x) { return __builtin_amdgcn_rcpf(1.f + __expf(-x)); }
__device__ __forceinline__ float silu(float x) { return x * __builtin_amdgcn_rcpf(1.f + __expf(-x)); }
__device__ __forceinline__ float wave_sum(float v) {
#pragma unroll
    for (int o = 1; o < 64; o <<= 1) v += __shfl_xor(v, o);
    return v;
}
__device__ __forceinline__ float wave_max(float v) {
#pragma unroll
    for (int o = 1; o < 64; o <<= 1) v = fmaxf(v, __shfl_xor(v, o));
    return v;
}
__device__ __forceinline__ int ld_agent(const int* p) { return __hip_atomic_load(p, __ATOMIC_RELAXED, __HIP_MEMORY_SCOPE_AGENT); }
__device__ __forceinline__ int otid() { int t = threadIdx.x; asm volatile("" : "+v"(t)); return t; }
template <class Tp> __device__ __forceinline__ Tp* wsp(const P& p, size_t off) { return (Tp*)(p.ws + off); }

__device__ void ph_mod(const P& p, float* lds) {
    const int tid = otid();
    const float* c = p.in[I_C]; const float* w = p.in[I_WADA]; const float* ba = p.in[I_BADA];
    float* mod = wsp<float>(p, WS_MOD);
    float* sc_ = lds + 2048;
    for (int i = tid; i < NB_ * DM; i += 512) sc_[i] = silu(c[i]);
    __syncthreads();
    for (int cb = blockIdx.x; cb < DIN / 24; cb += gridDim.x) {
        if (tid < 384) {
            const int col = cb * 24 + (tid % 24), ks = tid / 24;
            float a0 = 0.f, a1 = 0.f, a2 = 0.f, a3 = 0.f;
#pragma unroll 8
            for (int k = ks * 64; k < ks * 64 + 64; ++k) {
                const float wv = w[(size_t)k * DIN + col];
                a0 += sc_[k] * wv; a1 += sc_[DM + k] * wv; a2 += sc_[2 * DM + k] * wv; a3 += sc_[3 * DM + k] * wv;
            }
            float* r = lds + (ks * 24 + (tid % 24)) * 4; r[0] = a0; r[1] = a1; r[2] = a2; r[3] = a3;
        }
        __syncthreads();
        if (tid < 96) {
            const int cl = tid % 24, b = tid / 24; float s = 0.f;
            for (int ks = 0; ks < 16; ++ks) s += lds[(ks * 24 + cl) * 4 + b];
            mod[b * DIN + cb * 24 + cl] = s + ba[cb * 24 + cl];
        }
        __syncthreads();
    }
    int done = 0; for (int cb = blockIdx.x; cb < DIN / 24; cb += gridDim.x) ++done;
    asm volatile("s_waitcnt vmcnt(0)" ::: "memory"); __syncthreads();
    if (tid == 0) { __builtin_amdgcn_fence(__ATOMIC_RELEASE, "agent"); asm volatile("s_waitcnt vmcnt(0)" ::: "memory");
        __hip_atomic_fetch_add(wsp<int>(p, WS_MODCNT), done, __ATOMIC_RELAXED, __HIP_MEMORY_SCOPE_AGENT); }
}
__device__ void mod_wait(const P& p) {
    if (otid() == 0) { const int* c = wsp<int>(p, WS_MODCNT); unsigned spins = 0;
        while (ld_agent(c) < DIN / 24 && ++spins < (1u << 22)) __builtin_amdgcn_s_sleep(2);
        __builtin_amdgcn_fence(__ATOMIC_ACQUIRE, "agent"); asm volatile("s_waitcnt vmcnt(0)" ::: "memory"); }
    __syncthreads();
}
__device__ __forceinline__ int glu_row(int n, int half) { const int ch = n % half, isg = n / half; return (ch >> 7) * 256 + isg * 128 + (ch & 127); }
__device__ __forceinline__ void transpose_item(const float* W, int K, int N, bf16* WT, int drow0, float* scr, int kb, int nb, int lane) {
    const int k0 = 64 * kb, n0 = 32 * nb;
#pragma unroll 8
    for (int i = 0; i < 32; ++i) { const int kk = 2 * i + (lane >> 5); scr[kk * 33 + (lane & 31)] = W[(size_t)(k0 + kk) * N + n0 + (lane & 31)]; }
    __builtin_amdgcn_s_waitcnt(0xc07f); asm volatile("" ::: "memory");
    const int c = lane & 7;
#pragma unroll
    for (int j = 0; j < 4; ++j) { const int n = (lane >> 3) + 8 * j; const float* s = scr + (8 * c) * 33 + n;
        u32x4 o; o.x = pk2(s[0 * 33], s[1 * 33]); o.y = pk2(s[2 * 33], s[3 * 33]); o.z = pk2(s[4 * 33], s[5 * 33]); o.w = pk2(s[6 * 33], s[7 * 33]);
        *(u32x4*)(WT + (size_t)(drow0 + n) * K + k0 + 8 * c) = o; }
    __builtin_amdgcn_s_waitcnt(0xc07f); asm volatile("" ::: "memory");
}
__device__ __forceinline__ void transpose_item8(const float* W, int pitch, int N, unsigned char* WT, int drow0, float* scr, int kb, int nb, int lane) {
    const int k0 = 128 * kb, n0 = 32 * nb;
#pragma unroll 8
    for (int i = 0; i < 64; ++i) { const int kk = 2 * i + (lane >> 5); scr[kk * 33 + (lane & 31)] = W[(size_t)(k0 + kk) * N + n0 + (lane & 31)]; }
    __builtin_amdgcn_s_waitcnt(0xc07f); asm volatile("" ::: "memory");
    const int c = lane & 7;
#pragma unroll
    for (int j = 0; j < 4; ++j) { const int n = (lane >> 3) + 8 * j; const float* q = scr + (16 * c) * 33 + n;
        u32x4 o; o.x = pk4_fp8(q[0] * S_W, q[33] * S_W, q[66] * S_W, q[99] * S_W); o.y = pk4_fp8(q[132] * S_W, q[165] * S_W, q[198] * S_W, q[231] * S_W);
        o.z = pk4_fp8(q[264] * S_W, q[297] * S_W, q[330] * S_W, q[363] * S_W); o.w = pk4_fp8(q[396] * S_W, q[429] * S_W, q[462] * S_W, q[495] * S_W);
        *(u32x4*)(WT + (size_t)(drow0 + n) * pitch + k0 + 16 * c) = o; }
    __builtin_amdgcn_s_waitcnt(0xc07f); asm volatile("" ::: "memory");
}
__device__ void ph_wconv(const P& p, float* lds) {
    const int tid = otid(), lane = tid & 63, wave = tid >> 6;
    float* scr = lds + wave * (128 * 33);
    const int gw = blockIdx.x * 8 + wave, NGW = gridDim.x * 8;
    constexpr int I_IN = 16 * 192, I_SQ = 16 * 32, I_GU = 8 * 64, I_DN = 8 * 32;
    constexpr int NITEMS = I_IN + 3 * I_SQ + NE * I_GU + NE * I_DN;
    for (int it = gw; it < NITEMS; it += NGW) {
        int r = it;
        if (r < I_IN) { const int kb = r / 192, nb = r % 192, n0 = nb * 32; const int d = n0 < 2048 ? glu_row(n0, 1024) : n0;
            transpose_item(p.in[I_WIN], DM, DIN, wsp<bf16>(p, WS_WIN), d, scr, kb, nb, lane); continue; } r -= I_IN;
        if (r < I_SQ) { transpose_item(p.in[I_WPW], DM, DM, wsp<bf16>(p, WS_WPW), (r % 32) * 32, scr, r / 32, r % 32, lane); continue; } r -= I_SQ;
        if (r < I_SQ) { transpose_item(p.in[I_WMO], DM, DM, wsp<bf16>(p, WS_WMO), (r % 32) * 32, scr, r / 32, r % 32, lane); continue; } r -= I_SQ;
        if (r < I_SQ) { transpose_item(p.in[I_WOUT], DM, DM, wsp<bf16>(p, WS_WOUT), (r % 32) * 32, scr, r / 32, r % 32, lane); continue; } r -= I_SQ;
        if (r < NE * I_GU) { const int e = r / I_GU, q = r % I_GU, kb = q / 64, nb = q % 64;
            transpose_item8(p.in[I_WGU] + (size_t)e * DM * 2048, KP8, 2048, wsp<unsigned char>(p, WS_WGU) + (size_t)e * 2048 * KP8, glu_row(nb * 32, 1024), scr, kb, nb, lane); continue; } r -= NE * I_GU;
        { const int e = r / I_DN, q = r % I_DN, kb = q / 32, nb = q % 32;
            transpose_item8(p.in[I_WDN] + (size_t)e * DM * DM, KP8, DM, wsp<unsigned char>(p, WS_WDN) + (size_t)e * DM * KP8, nb * 32, scr, kb, nb, lane); }
    }
}
__device__ __forceinline__ void adanorm_row(const float* xrow, const float* g, const float* sc, const float* sh, bf16* orow, int lane) {
    f32x4 v[4]; float s = 0.f;
#pragma unroll
    for (int j = 0; j < 4; ++j) { v[j] = ((const f32x4*)xrow)[lane + 64 * j]; s += (v[j].x * v[j].x + v[j].y * v[j].y) + (v[j].z * v[j].z + v[j].w * v[j].w); }
    const float r = rsqrtf(wave_sum(s) * (1.f / DM) + EPS);
#pragma unroll
    for (int j = 0; j < 4; ++j) { const f32x4 gg = ((const f32x4*)g)[lane + 64 * j], ss = ((const f32x4*)sc)[lane + 64 * j], hh = ((const f32x4*)sh)[lane + 64 * j];
        const f32x4 o = v[j] * r * gg * (1.f + ss) + hh;
        u32x2 w; w.x = pk2(o.x, o.y); w.y = pk2(o.z, o.w); ((u32x2*)orow)[lane + 64 * j] = w; }
}
__device__ void ph_norm1(const P& p) {
    const int tid = otid(), lane = tid & 63, gw = blockIdx.x * 8 + (tid >> 6), NGW = gridDim.x * 8;
    const float* mod = wsp<float>(p, WS_MOD); bf16* HA = wsp<bf16>(p, O_HA); const float* X = p.in[I_X];
    const int per = (T + NGW - 1) / NGW;
    for (int m0 = gw * per; m0 < T && m0 < (gw + 1) * per; ) {
        const int b = m0 / SEQ; int m1 = (gw + 1) * per; if (m1 > T) m1 = T; if (m1 > (b + 1) * SEQ) m1 = (b + 1) * SEQ;
        f32x4 gs[4], hh[4];
#pragma unroll
        for (int j = 0; j < 4; ++j) { gs[j] = ((const f32x4*)p.in[I_GMIX])[lane + 64 * j] * (1.f + ((const f32x4*)(mod + b * DIN + 1024))[lane + 64 * j]); hh[j] = ((const f32x4*)(mod + b * DIN))[lane + 64 * j]; }
        int m = m0;
        for (; m + 4 <= m1; m += 4) {
            f32x4 v[4][4]; float ss[4];
#pragma unroll
            for (int r = 0; r < 4; ++r)
#pragma unroll
                for (int j = 0; j < 4; ++j) v[r][j] = ((const f32x4*)(X + (size_t)(m + r) * DM))[lane + 64 * j];
#pragma unroll
            for (int r = 0; r < 4; ++r) { float q = 0.f;
#pragma unroll
                for (int j = 0; j < 4; ++j) q += (v[r][j].x * v[r][j].x + v[r][j].y * v[r][j].y) + (v[r][j].z * v[r][j].z + v[r][j].w * v[r][j].w);
                ss[r] = rsqrtf(wave_sum(q) * (1.f / DM) + EPS); }
#pragma unroll
            for (int r = 0; r < 4; ++r)
#pragma unroll
                for (int j = 0; j < 4; ++j) { const f32x4 o = v[r][j] * ss[r] * gs[j] + hh[j]; u32x2 w; w.x = pk2(o.x, o.y); w.y = pk2(o.z, o.w); ((u32x2*)(HA + (size_t)(m + r) * DM))[lane + 64 * j] = w; }
        }
        for (; m < m1; ++m) adanorm_row(X + (size_t)m * DM, p.in[I_GMIX], mod + b * DIN + 1024, mod + b * DIN, HA + (size_t)m * DM, lane);
        m0 = m1;
    }
}
__device__ void ph_conv(const P& p, float* lds) {
    const int tid = otid(), lane = tid & 63, wave = tid >> 6, c2 = tid * 2;
    const bf16* U1 = wsp<bf16>(p, O_U1); bf16* YA = wsp<bf16>(p, O_YAPRE);
    bf16* tin = (bf16*)(lds + 256);
    bf16* tout = tin + 2 * 8192;
    const float* wd = p.in[I_WDW];
    float w0[31], w1[31];
#pragma unroll
    for (int j = 0; j < 31; ++j) { w0[j] = wd[j * DM + c2]; w1[j] = wd[j * DM + c2 + 1]; }
    const float b0 = p.in[I_BDW][c2], b1 = p.in[I_BDW][c2 + 1];
    const float g0 = p.in[I_LNG][c2], g1 = p.in[I_LNG][c2 + 1], lb0 = p.in[I_LNB][c2], lb1 = p.in[I_LNB][c2 + 1];
    const int crow = tid >> 7, ccol = (tid & 127) * 8;
    for (int blk = blockIdx.x; blk < T / 128; blk += gridDim.x) {
        const int tb = blk * 128, sb = tb % SEQ;
        unsigned win[38];
#pragma unroll
        for (int j = 0; j < 30; ++j) win[j] = (sb - 30 + j >= 0) ? *(const unsigned*)(U1 + (size_t)(tb - 30 + j) * DM + c2) : 0u;
        u32x4 r0 = *(const u32x4*)(U1 + (size_t)(tb + crow) * DM + ccol), r1 = *(const u32x4*)(U1 + (size_t)(tb + crow + 4) * DM + ccol);
        for (int grp = 0; grp < 16; ++grp) {
            const int t0 = tb + grp * 8;
            bf16* ti = tin + (grp & 1) * 8192;
            *(u32x4*)(ti + crow * 1024 + ccol) = r0; *(u32x4*)(ti + (crow + 4) * 1024 + ccol) = r1;
            if (grp < 15) { r0 = *(const u32x4*)(U1 + (size_t)(t0 + 8 + crow) * DM + ccol); r1 = *(const u32x4*)(U1 + (size_t)(t0 + 12 + crow) * DM + ccol); }
            __syncthreads();
            if (grp > 0) { const bf16* to = tout + ((grp - 1) & 1) * 8192;
                *(u32x4*)(YA + (size_t)(t0 - 8 + crow) * DM + ccol) = *(const u32x4*)(to + crow * 1024 + ccol);
                *(u32x4*)(YA + (size_t)(t0 - 4 + crow) * DM + ccol) = *(const u32x4*)(to + (crow + 4) * 1024 + ccol); }
#pragma unroll
            for (int j = 0; j < 8; ++j) win[30 + j] = *(const unsigned*)(ti + j * 1024 + c2);
            float a0[8], a1[8];
#pragma unroll
            for (int i = 0; i < 8; ++i) { a0[i] = b0; a1[i] = b1; }
#pragma unroll
            for (int j = 0; j < 38; ++j) { const float u0 = bflo(win[j]), u1 = bfhi(win[j]);
#pragma unroll
                for (int i = 0; i < 8; ++i) { const int tap = j - i; if (tap >= 0 && tap <= 30) { a0[i] += u0 * w0[tap]; a1[i] += u1 * w1[tap]; } } }
#pragma unroll
            for (int j = 0; j < 30; ++j) win[j] = win[j + 8];
            float st[16];
#pragma unroll
            for (int i = 0; i < 8; ++i) { st[2 * i] = a0[i] + a1[i]; st[2 * i + 1] = a0[i] * a0[i] + a1[i] * a1[i]; }
            float s8[8], s4[4], s2[2], s1;
            { const bool hi = lane & 32;
#pragma unroll
              for (int i = 0; i < 8; ++i) { const float keep = hi ? st[2 * i + 1] : st[2 * i], send = hi ? st[2 * i] : st[2 * i + 1]; s8[i] = keep + __shfl_xor(send, 32); } }
            { const bool hi = lane & 16;
#pragma unroll
              for (int i = 0; i < 4; ++i) { const float keep = hi ? s8[2 * i + 1] : s8[2 * i], send = hi ? s8[2 * i] : s8[2 * i + 1]; s4[i] = keep + __shfl_xor(send, 16); } }
            { const bool hi = lane & 8;
#pragma unroll
              for (int i = 0; i < 2; ++i) { const float keep = hi ? s4[2 * i + 1] : s4[2 * i], send = hi ? s4[2 * i] : s4[2 * i + 1]; s2[i] = keep + __shfl_xor(send, 8); } }
            { const bool hi = lane & 4; const float keep = hi ? s2[1] : s2[0], send = hi ? s2[0] : s2[1]; s1 = keep + __shfl_xor(send, 4); }
            s1 += __shfl_xor(s1, 2); s1 += __shfl_xor(s1, 1);
            float* red = lds + (grp & 1) * 128;
            if ((lane & 3) == 0) { const int idx = ((lane >> 2) & 1) * 8 + ((lane >> 3) & 1) * 4 + ((lane >> 4) & 1) * 2 + ((lane >> 5) & 1); red[idx * 8 + wave] = s1; }
            __syncthreads();
            float* fin = lds + 16640 + (grp & 1) * 16;
            if (tid < 8) { const f32x4 s0 = *(const f32x4*)(red + tid * 16), s1 = *(const f32x4*)(red + tid * 16 + 4), q0 = *(const f32x4*)(red + tid * 16 + 8), q1 = *(const f32x4*)(red + tid * 16 + 12);
                const float s = ((s0.x + s0.y) + (s0.z + s0.w)) + ((s1.x + s1.y) + (s1.z + s1.w)), q = ((q0.x + q0.y) + (q0.z + q0.w)) + ((q1.x + q1.y) + (q1.z + q1.w));
                const float mu = s * (1.f / DM), var = fmaxf(q * (1.f / DM) - mu * mu, 0.f); fin[tid * 2] = mu; fin[tid * 2 + 1] = rsqrtf(var + EPS); }
            __syncthreads();
            bf16* to = tout + (grp & 1) * 8192;
            const f32x4 f0 = *(const f32x4*)fin, f1 = *(const f32x4*)(fin + 4), f2 = *(const f32x4*)(fin + 8), f3 = *(const f32x4*)(fin + 12);
            const float mus[8] = {f0.x, f0.z, f1.x, f1.z, f2.x, f2.z, f3.x, f3.z}, rss[8] = {f0.y, f0.w, f1.y, f1.w, f2.y, f2.w, f3.y, f3.w};
#pragma unroll
            for (int i = 0; i < 8; ++i) {
                const float mu = mus[i], rs = rss[i];
                const float y0 = (a0[i] - mu) * rs * g0 + lb0, y1 = (a1[i] - mu) * rs * g1 + lb1;
                *(unsigned*)(to + i * 1024 + c2) = pk2(silu(y0), silu(y1));
            }
        }
        __syncthreads();
        { const bf16* to = tout + 8192;
            *(u32x4*)(YA + (size_t)(tb + 120 + crow) * DM + ccol) = *(const u32x4*)(to + crow * 1024 + ccol);
            *(u32x4*)(YA + (size_t)(tb + 124 + crow) * DM + ccol) = *(const u32x4*)(to + (crow + 4) * 1024 + ccol); }
        __syncthreads();
    }
}
typedef short bf16x8v __attribute__((ext_vector_type(8)));
__device__ __forceinline__ unsigned cvtpk(float lo, float hi) { unsigned r; asm volatile("v_cvt_pk_bf16_f32 %0, %1, %2" : "=v"(r) : "v"(lo), "v"(hi)); return r; }
__device__ __forceinline__ bf16x8v pack_frag(const float* v) { u32x4 w; w.x = cvtpk(v[0], v[1]); w.y = cvtpk(v[2], v[3]); w.z = cvtpk(v[4], v[5]); w.w = cvtpk(v[6], v[7]); return __builtin_bit_cast(bf16x8v, w); }
__device__ void ph_m1(const P& p, float* lds) {
    const int tid = otid(), lane = tid & 63, wave = tid >> 6, tok = lane & 15, kg = lane >> 4;
    const bf16* XM = wsp<bf16>(p, O_XM);
    bf16* Q = wsp<bf16>(p, O_Q); bf16* K = wsp<bf16>(p, O_K); bf16* XC = wsp<bf16>(p, O_XC);
    float* GP = wsp<float>(p, WS_GP);
    for (int item = blockIdx.x; item < 256; item += gridDim.x) {
        const int cb = item & 3, range = item >> 2, c8 = cb * 256 + wave * 32 + kg * 8;
        float wsc[4][8], bsc[8];
        float* bd = lds + 4096 + (wave * 4 + kg) * 96;
#pragma unroll
        for (int j = 0; j < 4; ++j) { const f32x4 a = *(const f32x4*)(p.in[I_WSC] + j * DM + c8), b = *(const f32x4*)(p.in[I_WSC] + j * DM + c8 + 4);
            wsc[j][0] = a.x; wsc[j][1] = a.y; wsc[j][2] = a.z; wsc[j][3] = a.w; wsc[j][4] = b.x; wsc[j][5] = b.y; wsc[j][6] = b.z; wsc[j][7] = b.w; }
        { const f32x4 a = *(const f32x4*)(p.in[I_BSC] + c8), b = *(const f32x4*)(p.in[I_BSC] + c8 + 4); bsc[0] = a.x; bsc[1] = a.y; bsc[2] = a.z; bsc[3] = a.w; bsc[4] = b.x; bsc[5] = b.y; bsc[6] = b.z; bsc[7] = b.w; }
#pragma unroll
        for (int g = 0; g < 2; ++g)
#pragma unroll
            for (int i = 0; i < 16; ++i) { const int o = (c8 / 4 + g) * 16 + i; if (tok == 0) { bd[(g * 3 + 0) * 16 + i] = p.in[I_WQ][o]; bd[(g * 3 + 1) * 16 + i] = p.in[I_WK][o]; bd[(g * 3 + 2) * 16 + i] = p.in[I_WV][o]; } }
        __syncthreads();
        bf16x8v bq, bk, bv;
        { float t0[8], t1[8], t2[8];
#pragma unroll
            for (int j = 0; j < 8; ++j) { const bool on = tok < 8; const int gi = tok & 7;
                t0[j] = on ? p.in[I_WIF][(size_t)(c8 + j) * 8 + gi] : 0.f; t1[j] = on ? p.in[I_WIF][(size_t)(DM + c8 + j) * 8 + gi] : 0.f; t2[j] = on ? p.in[I_WIF][(size_t)(2 * DM + c8 + j) * 8 + gi] : 0.f; }
            bq = pack_frag(t0); bk = pack_frag(t1); bv = pack_frag(t2); }
        u32x4 nx[4];
#pragma unroll
        for (int j = 0; j < 4; ++j) { const int t_ = range * 512 + tok, s_ = t_ % SEQ; nx[j] = (u32x4){0u, 0u, 0u, 0u}; if (s_ - 3 + j >= 0) nx[j] = *(const u32x4*)(XM + (size_t)(t_ - 3 + j) * DM + c8); }
        for (int tt = 0; tt < 32; ++tt) {
            const int t = range * 512 + tt * 16 + tok;
            float xm[4][8];
#pragma unroll
            for (int j = 0; j < 4; ++j) { const u32x4 u = nx[j];
                xm[j][0] = bflo(u.x); xm[j][1] = bfhi(u.x); xm[j][2] = bflo(u.y); xm[j][3] = bfhi(u.y); xm[j][4] = bflo(u.z); xm[j][5] = bfhi(u.z); xm[j][6] = bflo(u.w); xm[j][7] = bfhi(u.w); }
            if (tt < 31) {
#pragma unroll
                for (int j = 0; j < 4; ++j) nx[j] = *(const u32x4*)(XM + (size_t)(t + 16 - 3 + j) * DM + c8); }
            float xc[8], q[8], k[8], v[8];
#pragma unroll
            for (int c = 0; c < 8; ++c) { float a = bsc[c];
#pragma unroll
                for (int j = 0; j < 4; ++j) a += xm[j][c] * wsc[j][c];
                xc[c] = silu(a); }
#pragma unroll
            for (int g = 0; g < 2; ++g)
                {   f32x4 aq = {0.f, 0.f, 0.f, 0.f}, ak = aq, av = aq;
#pragma unroll
                    for (int ii = 0; ii < 4; ++ii) { const f32x4 w_q = *(const f32x4*)(bd + (g * 3 + 0) * 16 + ii * 4), w_k = *(const f32x4*)(bd + (g * 3 + 1) * 16 + ii * 4), w_v = *(const f32x4*)(bd + (g * 3 + 2) * 16 + ii * 4);
                        aq += w_q * xc[g * 4 + ii]; ak += w_k * xc[g * 4 + ii]; av += w_v * xm[3][g * 4 + ii]; }
#pragma unroll
                    for (int o = 0; o < 4; ++o) { q[g * 4 + o] = aq[o]; k[g * 4 + o] = ak[o]; v[g * 4 + o] = av[o]; } }
            const bf16x8v fq_ = pack_frag(q), fk_ = pack_frag(k), fv_ = pack_frag(v), fx_ = pack_frag(xc);
            f32x4 acc = {0.f, 0.f, 0.f, 0.f};
            acc = __builtin_amdgcn_mfma_f32_16x16x32_bf16(fq_, bq, acc, 0, 0, 0);
            acc = __builtin_amdgcn_mfma_f32_16x16x32_bf16(fk_, bk, acc, 0, 0, 0);
            acc = __builtin_amdgcn_mfma_f32_16x16x32_bf16(fv_, bv, acc, 0, 0, 0);
            float* red = lds + (tt & 3) * 1024 + wave * 128;
            if (tok < 8) {
#pragma unroll
                for (int r = 0; r < 4; ++r) red[(kg * 4 + r) * 8 + tok] = acc[r]; }
            *(bf16x8v*)(Q + (size_t)t * DM + c8) = fq_; *(bf16x8v*)(K + (size_t)t * DM + c8) = fk_; *(bf16x8v*)(XC + (size_t)t * DM + c8) = fx_;
            if (tt & 1) {
                __syncthreads();
                if (tid < 256) { const int tl = tt - 1 + (tid >> 7), e = tid & 127; const float* rr = lds + (tl & 3) * 1024 + e; float sum = 0.f;
#pragma unroll
                    for (int w = 0; w < 8; ++w) sum += rr[w * 128];
                    GP[(size_t)cb * T * 8 + (size_t)(range * 512 + tl * 16) * 8 + e] = sum; }
            }
        }
        __syncthreads();
    }
}
constexpr int TP = 258;
__device__ void ph_m2(const P& p, float* ldsf) {
    const int tid = otid(), lane = tid & 63, wave = tid >> 6;
    bf16* tile = (bf16*)ldsf;
    float* wts = ldsf + 33024;
    float* red = ldsf + 33024 + 256;
    const bf16* Kb = wsp<bf16>(p, O_K); const bf16* Vb = wsp<bf16>(p, O_XM);
    bf16* KWT = wsp<bf16>(p, O_KWT); bf16* VT = wsp<bf16>(p, O_VT);
    const float* GP = wsp<float>(p, WS_GP); const float* bif = p.in[I_BIF];
    float* CW = wsp<float>(p, WS_CW); float* FL = wsp<float>(p, WS_FLOOR); float* UN = wsp<float>(p, WS_UNITS); float* NLOC = wsp<float>(p, WS_NLOC);
    for (int unit = blockIdx.x; unit < NUNIT; unit += gridDim.x) {
        const int b = unit >> 7, h = (unit >> 5) & 3, c = unit & 31, tok0 = b * SEQ + c * CH;
        float bc = 0.f, a = 0.f, igv = 0.f;
        if (tid < 256) {
            float gi_ = bif[h], gf_ = bif[4 + h];
#pragma unroll
            for (int cb = 0; cb < 4; ++cb) { const float* g8 = GP + (size_t)cb * T * 8 + (size_t)(tok0 + tid) * 8; gi_ += g8[h]; gf_ += g8[4 + h]; }
            igv = gi_;
            float lf = fminf(gf_, 0.f) - log1pf(__expf(-fabsf(gf_)));
#pragma unroll
            for (int o = 1; o < 64; o <<= 1) { const float n = __shfl_up(lf, o); if (lane >= o) lf += n; }
            if (lane == 63) red[wave] = lf;
            bc = lf;
        }
        __syncthreads();
        if (tid < 256) {
            for (int w = 0; w < wave; ++w) bc += red[w];
            a = igv - bc;
            const float m = wave_max(a);
            if (lane == 0) red[8 + wave] = m;
        }
        __syncthreads();
        if (tid < 256) {
            const float amax = fmaxf(fmaxf(red[8], red[9]), fmaxf(red[10], red[11]));
            const float w = __expf(a - amax) * 0.0625f;
            wts[tid] = w; CW[unit * 256 + tid] = w; FL[unit * 256 + tid] = __expf(-bc - amax);
            if (tid == 255) { UN[unit * 2] = amax; UN[unit * 2 + 1] = bc; }
        }
        float wvb[2][16];
#pragma unroll
        for (int g = 0; g < 2; ++g)
#pragma unroll
            for (int i = 0; i < 16; ++i) wvb[g][i] = p.in[I_WV][(h * 64 + (tid & 31) * 2 + g) * 16 + i];
        for (int which = 0; which < 2; ++which) {
            const bf16* src = which ? Vb : Kb; bf16* dst = (which ? VT : KWT) + (size_t)unit * 65536;
            __syncthreads();
            u32x4 ld[16];
#pragma unroll
            for (int i = 0; i < 16; ++i) { const int ch = tid + i * 512, row = ch >> 5, cc = ch & 31; ld[i] = *(const u32x4*)(src + (size_t)(tok0 + row) * DM + h * 256 + cc * 8); }
#pragma unroll
            for (int i = 0; i < 16; ++i) { const int ch = tid + i * 512, row = ch >> 5, cc = ch & 31;
                u32x4 v = ld[i];
                if (which) { const float x[8] = {bflo(v.x), bfhi(v.x), bflo(v.y), bfhi(v.y), bflo(v.z), bfhi(v.z), bflo(v.w), bfhi(v.w)}; float o[8];
#pragma unroll
                    for (int g = 0; g < 2; ++g)
#pragma unroll
                        for (int oo = 0; oo < 4; ++oo) { float a = 0.f;
#pragma unroll
                            for (int ii = 0; ii < 4; ++ii) a += x[g * 4 + ii] * wvb[g][ii * 4 + oo];
                            o[g * 4 + oo] = a; }
                    v.x = pk2(o[0], o[1]); v.y = pk2(o[2], o[3]); v.z = pk2(o[4], o[5]); v.w = pk2(o[6], o[7]); }
                unsigned* d = (unsigned*)(tile + row * TP + cc * 8); d[0] = v.x; d[1] = v.y; d[2] = v.z; d[3] = v.w; }
            __syncthreads();
            if (which == 0 && tid < 256) { float s = 0.f; for (int r = 0; r < 256; ++r) s += bf2f(tile[r * TP + tid]) * wts[r]; NLOC[unit * 256 + tid] = s; }
            for (int i = 0; i < 8; ++i) {
                const int blk = wave + i * 8;
                const int d = (blk >> 2) * 16 + 2 * (lane >> 3), sc = (blk & 3) * 8 + (lane & 7);
                float e0[8], e1[8];
#pragma unroll
                for (int j = 0; j < 8; ++j) { const unsigned w2 = *(const unsigned*)(tile + (sc * 8 + j) * TP + d); e0[j] = bflo(w2); e1[j] = bfhi(w2); }
                if (which == 0) { const f32x4 wa = *(const f32x4*)(wts + sc * 8), wb = *(const f32x4*)(wts + sc * 8 + 4); const float ww[8] = {wa.x, wa.y, wa.z, wa.w, wb.x, wb.y, wb.z, wb.w};
#pragma unroll
                    for (int j = 0; j < 8; ++j) { e0[j] *= ww[j]; e1[j] *= ww[j]; } }
                u32x4 o; o.x = pk2(e0[0], e0[1]); o.y = pk2(e0[2], e0[3]); o.z = pk2(e0[4], e0[5]); o.w = pk2(e0[6], e0[7]);
                *(u32x4*)(dst + (size_t)d * 256 + sc * 8) = o;
                o.x = pk2(e1[0], e1[1]); o.y = pk2(e1[2], e1[3]); o.z = pk2(e1[4], e1[5]); o.w = pk2(e1[6], e1[7]);
                *(u32x4*)(dst + (size_t)(d + 1) * 256 + sc * 8) = o;
            }
        }
        __syncthreads();
    }
}
__device__ void ph_scan(const P& p) {
    const bf16* UT = wsp<bf16>(p, O_UT); bf16* CT = wsp<bf16>(p, O_CT);
    const float* UN = wsp<float>(p, WS_UNITS); const float* NLOC = wsp<float>(p, WS_NLOC); float* NS = wsp<float>(p, WS_NS);
    const int tid = otid(), nth = gridDim.x * blockDim.x;
    if (tid < 16) for (int e = blockIdx.x * 16 + tid; e < 16 * 256; e += gridDim.x * 16) {
        const int bh = e >> 8, d = e & 255; float n = 0.f, m = 0.f;
        for (int c0 = 0; c0 < NCH; c0 += 8) {
            float nl[8], am[8], bl[8];
#pragma unroll
            for (int q = 0; q < 8; ++q) { const int unit = bh * 32 + c0 + q; nl[q] = NLOC[unit * 256 + d]; am[q] = UN[unit * 2]; bl[q] = UN[unit * 2 + 1]; }
#pragma unroll
            for (int q = 0; q < 8; ++q) { const int unit = bh * 32 + c0 + q; const float amax = am[q], blast = bl[q];
                NS[unit * 256 + d] = n * __expf(m - amax);
                const float mnew = blast + fmaxf(m, amax); n = __expf(blast + m - mnew) * n + __expf(blast + amax - mnew) * nl[q]; m = mnew; }
        }
    }
    for (int e8 = blockIdx.x * blockDim.x + tid; e8 < 16 * 8192; e8 += nth) {
        const int bh = e8 >> 13, idx = e8 & 8191; const size_t off = (size_t)idx * 8;
        float C[8]; float m = 0.f;
#pragma unroll
        for (int j = 0; j < 8; ++j) C[j] = 0.f;
        for (int c0 = 0; c0 < NCH; c0 += 8) {
            u32x4 uu[8]; float am[8], bl[8];
#pragma unroll
            for (int q = 0; q < 8; ++q) { const int unit = bh * 32 + c0 + q; uu[q] = *(const u32x4*)(UT + (size_t)unit * 65536 + off); am[q] = UN[unit * 2]; bl[q] = UN[unit * 2 + 1]; }
#pragma unroll
            for (int q = 0; q < 8; ++q) {
                const int unit = bh * 32 + c0 + q; const float amax = am[q], blast = bl[q]; const u32x4 u = uu[q];
                const float f1 = __expf(m - amax);
                u32x4 o; o.x = pk2(C[0] * f1, C[1] * f1); o.y = pk2(C[2] * f1, C[3] * f1); o.z = pk2(C[4] * f1, C[5] * f1); o.w = pk2(C[6] * f1, C[7] * f1);
                *(u32x4*)(CT + (size_t)unit * 65536 + off) = o;
                const float mnew = blast + fmaxf(m, amax), d1 = __expf(blast + m - mnew), d2 = __expf(blast + amax - mnew);
                C[0] = d1 * C[0] + d2 * bflo(u.x); C[1] = d1 * C[1] + d2 * bfhi(u.x); C[2] = d1 * C[2] + d2 * bflo(u.y); C[3] = d1 * C[3] + d2 * bfhi(u.y);
                C[4] = d1 * C[4] + d2 * bflo(u.z); C[5] = d1 * C[5] + d2 * bfhi(u.z); C[6] = d1 * C[6] + d2 * bflo(u.w); C[7] = d1 * C[7] + d2 * bfhi(u.w);
                m = mnew;
            }
        }
    }
}
constexpr int RP = 1032;
__device__ void ph_wprime(const P& p, float* lds) {
    const int tid = otid();
    const float* mod = wsp<float>(p, WS_MOD); const float* wr = p.in[I_WR]; const float* gm = p.in[I_GMOE];
    bf16* img = wsp<bf16>(p, WS_WPR); float* cstg = (float*)(img + 4 * 2 * 32 * RP);
    for (int it = blockIdx.x; it < 128; it += gridDim.x) {
        const int b = it >> 5, e = it & 31; const float* sc = mod + b * DIN + 4096; const float* sh = mod + b * DIN + 3072;
        float a = 0.f;
#pragma unroll
        for (int q = 0; q < 2; ++q) { const int k = tid + q * 512; const float w = wr[k * 32 + e]; const float v = w * gm[k] * (1.f + sc[k]); const unsigned h = f2bf(v);
            img[((size_t)(b * 2 + 0) * 32 + e) * RP + k] = (bf16)h; img[((size_t)(b * 2 + 1) * 32 + e) * RP + k] = (bf16)f2bf(v - bf2f(h)); a += sh[k] * w; }
        a = wave_sum(a);
        if ((tid & 63) == 0) lds[tid >> 6] = a;
        __syncthreads();
        if (tid == 0) { float t = p.in[I_BR][e];
#pragma unroll
            for (int w = 0; w < 8; ++w) t += lds[w];
            cstg[b * 32 + e] = t; }
        __syncthreads();
    }
}
__device__ void ph_router(const P& p, float* lds) {
    const int tid = otid(), lane = tid & 63, wave = tid >> 6, tok = lane & 15, kg = lane >> 4;
    bf16* Wh = (bf16*)lds; bf16* Wl = Wh + 32 * RP;
    float* lg = lds + 33024 + wave * 512;
    float* cst = lds + 33024 + 4096;
    int* cnt = (int*)(cst + 32);
    float* rinv = cst + 64 + wave * 16;
    float* red = cst + 64 + 128;
    const float* X1 = wsp<float>(p, O_X1); const float* mod = wsp<float>(p, WS_MOD); unsigned char* HM = wsp<unsigned char>(p, O_HM);
    int* TOPI = wsp<int>(p, WS_TOPI); float* TOPW = wsp<float>(p, WS_TOPW); int* CNT = wsp<int>(p, WS_CNT);
    const float* wr = p.in[I_WR]; const float* gm = p.in[I_GMOE];
    for (int blk = blockIdx.x; blk < T / 128; blk += gridDim.x) {
        const int b = (blk * 128) / SEQ; const float* sc = mod + b * DIN + 4096; const float* sh = mod + b * DIN + 3072;
        { const u32x4* src = (const u32x4*)(wsp<bf16>(p, WS_WPR) + (size_t)b * 2 * 32 * RP); u32x4* dst = (u32x4*)Wh;
#pragma unroll
            for (int i = 0; i < 17; ++i) { const int idx = tid + i * 512; if (idx < 8256) dst[idx] = src[idx]; }
            if (tid < 32) { cst[tid] = ((const float*)(wsp<bf16>(p, WS_WPR) + 4 * 2 * 32 * RP))[b * 32 + tid]; cnt[tid] = 0; } }
        __syncthreads();
        const int tb = blk * 128 + wave * 16;
        {
            const float* xr = X1 + (size_t)(tb + tok) * DM + kg * 8;
            float rr;
            { const f32x4* sp = (const f32x4*)(wsp<float>(p, WS_SSQ) + (size_t)(tb + tok) * 16); const f32x4 a = sp[0], b4 = sp[1], c4 = sp[2], d4 = sp[3];
              const float ss = ((a.x + a.y) + (a.z + a.w)) + ((b4.x + b4.y) + (b4.z + b4.w)) + ((c4.x + c4.y) + (c4.z + c4.w)) + ((d4.x + d4.y) + (d4.z + d4.w));
              rr = rsqrtf(ss * (1.f / DM) + EPS); }
            if (kg == 0) rinv[tok] = rr;
            const float rs = rr * S_HM;
            unsigned char* ho = HM + (size_t)(tb + tok) * DM + kg * 8;
            f32x4 acc0 = {0.f, 0.f, 0.f, 0.f}, acc1 = {0.f, 0.f, 0.f, 0.f};
            const bf16* wh0 = Wh + tok * RP + kg * 8; const bf16* wl0 = Wl + tok * RP + kg * 8;
#pragma unroll 4
            for (int ks = 0; ks < 32; ++ks) {
                const f32x4 x0 = *(const f32x4*)(xr + ks * 32), x1 = *(const f32x4*)(xr + ks * 32 + 4);
                { const int k0 = ks * 32 + kg * 8;
                  const f32x4 g0 = *(const f32x4*)(gm + k0) * (1.f + *(const f32x4*)(sc + k0)), g1 = *(const f32x4*)(gm + k0 + 4) * (1.f + *(const f32x4*)(sc + k0 + 4));
                  const f32x4 h0 = x0 * rs * g0 + *(const f32x4*)(sh + k0) * S_HM, h1 = x1 * rs * g1 + *(const f32x4*)(sh + k0 + 4) * S_HM;
                  u32x2 w8; w8.x = pk4_fp8(h0.x, h0.y, h0.z, h0.w); w8.y = pk4_fp8(h1.x, h1.y, h1.z, h1.w); *(u32x2*)(ho + ks * 32) = w8; }
                u32x4 hw; hw.x = cvtpk(x0.x, x0.y); hw.y = cvtpk(x0.z, x0.w); hw.z = cvtpk(x1.x, x1.y); hw.w = cvtpk(x1.z, x1.w);
                u32x4 lw; lw.x = cvtpk(x0.x - bflo(hw.x), x0.y - bfhi(hw.x)); lw.y = cvtpk(x0.z - bflo(hw.y), x0.w - bfhi(hw.y));
                lw.z = cvtpk(x1.x - bflo(hw.z), x1.y - bfhi(hw.z)); lw.w = cvtpk(x1.z - bflo(hw.w), x1.w - bfhi(hw.w));
                const bf16x8v ah = __builtin_bit_cast(bf16x8v, hw), al = __builtin_bit_cast(bf16x8v, lw);
                const bf16x8v bh0 = *(const bf16x8v*)(wh0 + ks * 32), bl0 = *(const bf16x8v*)(wl0 + ks * 32);
                const bf16x8v bh1 = *(const bf16x8v*)(wh0 + 16 * RP + ks * 32), bl1 = *(const bf16x8v*)(wl0 + 16 * RP + ks * 32);
                acc0 = __builtin_amdgcn_mfma_f32_16x16x32_bf16(ah, bh0, acc0, 0, 0, 0); acc1 = __builtin_amdgcn_mfma_f32_16x16x32_bf16(ah, bh1, acc1, 0, 0, 0);
                acc0 = __builtin_amdgcn_mfma_f32_16x16x32_bf16(ah, bl0, acc0, 0, 0, 0); acc1 = __builtin_amdgcn_mfma_f32_16x16x32_bf16(ah, bl1, acc1, 0, 0, 0);
                acc0 = __builtin_amdgcn_mfma_f32_16x16x32_bf16(al, bh0, acc0, 0, 0, 0); acc1 = __builtin_amdgcn_mfma_f32_16x16x32_bf16(al, bh1, acc1, 0, 0, 0);
            }
#pragma unroll
            for (int r = 0; r < 4; ++r) { lg[(kg * 4 + r) * 32 + tok] = acc0[r]; lg[(kg * 4 + r) * 32 + 16 + tok] = acc1[r]; }
        }
        __builtin_amdgcn_s_waitcnt(0xc07f); asm volatile("" ::: "memory");
        if (lane < 16) {
            const float rr = rinv[lane]; float v[32];
#pragma unroll
            for (int e4 = 0; e4 < 8; ++e4) { const f32x4 t4 = *(const f32x4*)(lg + lane * 32 + e4 * 4), c4 = *(const f32x4*)(cst + e4 * 4);
                v[e4 * 4] = rr * t4.x + c4.x; v[e4 * 4 + 1] = rr * t4.y + c4.y; v[e4 * 4 + 2] = rr * t4.z + c4.z; v[e4 * 4 + 3] = rr * t4.w + c4.w; }
            float tv[4]; int ti[4];
#pragma unroll
            for (int k = 0; k < 4; ++k) { float m = v[0]; int idx = 0;
#pragma unroll
                for (int e = 1; e < 32; ++e) { if (v[e] > m) { m = v[e]; idx = e; } }
                tv[k] = m; ti[k] = idx;
#pragma unroll
                for (int e = 0; e < 32; ++e) if (e == idx) v[e] = -INFINITY; }
            const float e1 = __expf(tv[1] - tv[0]), e2 = __expf(tv[2] - tv[0]), e3 = __expf(tv[3] - tv[0]), inv = 1.f / (1.f + e1 + e2 + e3);
            const int t = tb + lane;
            *(int4*)(TOPI + t * 4) = make_int4(ti[0], ti[1], ti[2], ti[3]);
            *(f32x4*)(TOPW + t * 4) = (f32x4){inv, e1 * inv, e2 * inv, e3 * inv};
            atomicAdd(&cnt[ti[0]], 1); atomicAdd(&cnt[ti[1]], 1); atomicAdd(&cnt[ti[2]], 1); atomicAdd(&cnt[ti[3]], 1);
        }
        __syncthreads();
        if (tid < 32) CNT[blk * 32 + tid] = cnt[tid];
        __syncthreads();
    }
}
__device__ void ph_scatter(const P& p, float* lds) {
    const int tid = otid(), lane = tid & 63, wave = tid >> 6;
    int* tot = (int*)lds; int* pre = tot + 32; int* startp = tot + 64; int* wc = tot + 128;
    const int* CNT = wsp<int>(p, WS_CNT); const int* TOPI = wsp<int>(p, WS_TOPI);
    float* ROWW = wsp<float>(p, WS_ROWSLOT); int* TILEE = wsp<int>(p, WS_TILEE);
    int* ROWTOK = wsp<int>(p, WS_ROWTOK); int* POS = wsp<int>(p, WS_DEN); const float* TOPW = wsp<float>(p, WS_TOPW);
    for (int blk = blockIdx.x; blk < T / 128; blk += gridDim.x) {
        { const int e = tid & 31, g = tid >> 5; int a = 0, b = 0;
#pragma unroll
            for (int q = 0; q < 16; ++q) { const int j = g + 16 * q; const int c = CNT[j * 32 + e]; a += c; if (j < blk) b += c; }
            wc[g * 32 + e] = a; wc[512 + g * 32 + e] = b; }
        __syncthreads();
        if (tid < 32) { int a = 0, b = 0;
#pragma unroll
            for (int g = 0; g < 16; ++g) { a += wc[g * 32 + tid]; b += wc[512 + g * 32 + tid]; }
            tot[tid] = a; pre[tid] = b; }
        __syncthreads();
        if (tid == 0) { int s = 0; for (int e = 0; e < 32; ++e) { startp[e] = s; s += (tot[e] + 255) & ~255; } startp[32] = s; }
        __syncthreads();
        if (blk < 32) {
            const int e = blk, s0 = startp[e], s1 = startp[e + 1];
            if (blk == 0 && tid == 0) TILEE[MAXTILES] = startp[32] >> 8;
            for (int tl = (s0 >> 8) + tid; tl < (s1 >> 8); tl += 512) TILEE[tl] = e;
            for (int r = s0 + tot[e] + tid; r < s1; r += 512) { ROWW[r] = 0.f; ROWTOK[r] = 0; }
        }
        const int slot = blk * 512 + tid, e = TOPI[slot]; const float wgt = TOPW[slot];
        int lrank = 0;
        for (int ee = 0; ee < 32; ++ee) { const unsigned long long m = __ballot(e == ee);
            if (e == ee) lrank = __popcll(m & ((1ull << lane) - 1ull));
            if (lane == 0) wc[wave * 32 + ee] = __popcll(m); }
        __syncthreads();
        int base = startp[e] + pre[e] + lrank;
        for (int w = 0; w < wave; ++w) base += wc[w * 32 + e];
        __syncthreads();
        ROWW[base] = wgt; ROWTOK[base] = slot >> 2; POS[slot] = base;
        __syncthreads();
    }
}
__device__ void ph_final(const P& p) {
    const int tid = otid(), lane = tid & 63, gw = blockIdx.x * 8 + (tid >> 6), NGW = gridDim.x * 8;
    const float* X1 = wsp<float>(p, O_X1); const bf16* Y = wsp<bf16>(p, O_Y); const float* mod = wsp<float>(p, WS_MOD); const float* gf = p.in[I_GFIN];
    for (int t = gw; t < T; t += NGW) {
        const int b = t / SEQ; const float* gt2 = mod + b * DIN + 5120;
        const int4 p4 = *(const int4*)(wsp<int>(p, WS_DEN) + t * 4); const int pos[4] = {p4.x, p4.y, p4.z, p4.w};
        f32x4 v[2][2]; float s = 0.f;
#pragma unroll
        for (int j = 0; j < 2; ++j) {
            f32x4 a0 = {0.f, 0.f, 0.f, 0.f}, a1 = {0.f, 0.f, 0.f, 0.f};
#pragma unroll
            for (int k = 0; k < 4; ++k) { const u32x4 u = ((const u32x4*)(Y + (size_t)pos[k] * DM))[lane + 64 * j];
                a0.x += bflo(u.x); a0.y += bfhi(u.x); a0.z += bflo(u.y); a0.w += bfhi(u.y); a1.x += bflo(u.z); a1.y += bfhi(u.z); a1.z += bflo(u.w); a1.w += bfhi(u.w); }
            const f32x4* xr = (const f32x4*)(X1 + (size_t)t * DM) + 2 * lane + 128 * j; const f32x4* gr = (const f32x4*)gt2 + 2 * lane + 128 * j;
            v[j][0] = xr[0] + gr[0] * a0; v[j][1] = xr[1] + gr[1] * a1;
#pragma unroll
            for (int h = 0; h < 2; ++h) s += (v[j][h].x * v[j][h].x + v[j][h].y * v[j][h].y) + (v[j][h].z * v[j][h].z + v[j][h].w * v[j][h].w);
        }
        const float r = rsqrtf(wave_sum(s) * (1.f / DM) + EPS);
#pragma unroll
        for (int j = 0; j < 2; ++j)
#pragma unroll
            for (int h = 0; h < 2; ++h) ((f32x4*)(p.out + (size_t)t * DM))[2 * lane + 128 * j + h] = v[j][h] * r * ((const f32x4*)gf)[2 * lane + 128 * j + h];
    }
}
__device__ __forceinline__ void unit_dec(int unit, int& tok0, int& h) { const int b = unit >> 7; h = (unit >> 5) & 3; tok0 = b * SEQ + (unit & 31) * CH; }

namespace pg8 {
typedef short bf16x8 __attribute__((ext_vector_type(8)));
constexpr int BM = 256, BK = 64, HALF = 128, HTB = HALF * BK * 2, STAGE_BYTES = 8 * HTB, NXCD = 8, WGM = 8;
__host__ __device__ __forceinline__ int lds_byte(int r, int c) { const int st = (r >> 4) * 2 + (c >> 5), rr = r & 15, cc = c & 31, ob = rr * 64 + cc * 2; return st * 1024 + (ob ^ (((ob >> 9) & 1) << 5)); }
__host__ __device__ __forceinline__ void stage_rc(int b, int& R, int& C) { const int st = b / 1024, sb = b % 1024, swz = sb ^ (((sb >> 9) & 1) << 5); R = (st >> 1) * 16 + swz / 64; C = (st & 1) * 32 + (swz % 64) / 2; }
__host__ __device__ __forceinline__ int perm32(int rho) { const int n = rho >> 4, i = rho & 15; return 8 * (i >> 2) + 4 * n + (i & 3); }
struct Unit { const char* a0; const char* a1; const char* b0; const char* b1; int pm, pn; };
struct Gemm { int lda, ldb, nt, nth; const int* rowtok; };
__device__ __forceinline__ unsigned cvt_pk_bf16(float lo, float hi) { unsigned r; asm volatile("v_cvt_pk_bf16_f32 %0, %1, %2" : "=v"(r) : "v"(lo), "v"(hi)); return r; }
__device__ __forceinline__ u32x4 pack8(const f32x4 v0, const f32x4 v1) { u32x4 w; w.x = cvt_pk_bf16(v0[0], v0[1]); w.y = cvt_pk_bf16(v0[2], v0[3]); w.z = cvt_pk_bf16(v1[0], v1[1]); w.w = cvt_pk_bf16(v1[2], v1[3]); return w; }

typedef int v4i_t __attribute__((ext_vector_type(4))); typedef int v8i_t __attribute__((ext_vector_type(8)));
__device__ __forceinline__ v8i_t cat8(const bf16x8 a, const bf16x8 b) { return __builtin_shufflevector(__builtin_bit_cast(v4i_t, a), __builtin_bit_cast(v4i_t, b), 0, 1, 2, 3, 4, 5, 6, 7); }
template <class Epi, class Sched, bool ALIGN_EPI, bool SPLITK = false, bool GATHER = false, bool FP8 = false>
__device__ __forceinline__ void gemm_phase(LAS unsigned char* lds, const Gemm g, const Sched& S, const Epi& E) {
    const int tid = otid(), wid = __builtin_amdgcn_readfirstlane(tid >> 6), lane = tid & 63, wr = wid >> 2, wc = wid & 3, fr = lane & 15, fq = lane >> 4;
    const int nt = g.nt, nth = g.nth;
    unsigned voffA[2], voffB[2];
#pragma unroll
    for (int i = 0; i < 2; ++i) { int R, C; stage_rc(tid * 16 + i * 8192, R, C); const int Rb = Epi::PERM ? ((R & ~31) + perm32(R & 31)) : R;
        voffA[i] = (unsigned)(R * g.lda + C) * 2u; voffB[i] = (unsigned)(Rb * g.ldb + C) * 2u; }
    LAS int* rt = (LAS int*)(lds + 131072); unsigned vC[2][2], vP[2][2];
    if constexpr (GATHER) { Unit uu; for (int i = 0; S.next(i, uu); ++i) if (tid < 256) rt[i * 256 + tid] = g.rowtok[uu.pm * 256 + tid];
        asm volatile("s_waitcnt vmcnt(0) lgkmcnt(0)" ::: "memory"); __builtin_amdgcn_s_barrier(); asm volatile("" ::: "memory"); }
#define PG8_ROWS(dst, iu) do { const int _t = otid(); _Pragma("unroll") for (int _i = 0; _i < 2; ++_i) { int _R, _C; stage_rc(_t * 16 + _i * 8192, _R, _C); _Pragma("unroll") for (int _h = 0; _h < 2; ++_h) dst[_h][_i] = (unsigned)rt[(iu) * 256 + _h * 128 + _R] * (unsigned)(g.lda * 2) + (unsigned)_C * 2u; } } while (0)
#define PG8_STAGE_A(bufoff, gbase, h, V) do { if constexpr (GATHER) { PG8_STAGE(bufoff, gbase, V[h]); } else { PG8_STAGE(bufoff, (gbase) + (h) * hstepA, voffA); } } while (0)
#define PG8_STAGE_A2(bufoff, gbase, h) do { if constexpr (GATHER) { if (last) { PG8_STAGE(bufoff, gbase, vP[h]); } else { PG8_STAGE(bufoff, gbase, vC[h]); } } else { PG8_STAGE(bufoff, (gbase) + (h) * hstepA, voffA); } } while (0)
    const size_t kstep = (size_t)(BK * 2);
    const size_t hstepA = (size_t)HALF * g.lda * 2, hstepB = (size_t)HALF * g.ldb * 2;
    const unsigned ldsw = (unsigned)wid * 1024u;
    const int aoff = lds_byte(wr * 64 + fr, fq * 8), boff = lds_byte(wc * 32 + fr, fq * 8);
    const int one8 = 0x7f7f7f7f;
    constexpr int F2 = 1024;
#define PG8_SA(b, h) (((b) * 2 + (h)) * HTB)
#define PG8_SB(b, h) ((4 + (b) * 2 + (h)) * HTB)
#define PG8_STAGE(bufoff, gbase, voff) do { _Pragma("unroll") for (int _i = 0; _i < 2; ++_i) \
        __builtin_amdgcn_global_load_lds((const unsigned*)((const char*)(gbase) + (voff)[_i]), (LAS unsigned*)(lds + (bufoff) + ldsw + _i * 8192), 16, 0, 0); } while (0)
#define PG8_LDA(dst, b, h) do { _Pragma("unroll") for (int m = 0; m < 4; ++m) { dst[m][0] = *(const LAS bf16x8*)(lds + PG8_SA(b, h) + aoff + m * 2048); dst[m][1] = *(const LAS bf16x8*)(lds + PG8_SA(b, h) + aoff + F2 + m * 2048); } } while (0)
#define PG8_LDB(dst, b, h) do { _Pragma("unroll") for (int n = 0; n < 2; ++n) { dst[n][0] = *(const LAS bf16x8*)(lds + PG8_SB(b, h) + boff + n * 2048); dst[n][1] = *(const LAS bf16x8*)(lds + PG8_SB(b, h) + boff + F2 + n * 2048); } } while (0)
#define PG8_MMA(ai, bj, At, Bt) do { __builtin_amdgcn_s_setprio(1); _Pragma("unroll") for (int m = 0; m < 4; ++m) _Pragma("unroll") for (int n = 0; n < 2; ++n) { \
        if constexpr (FP8) { const v8i_t b8_ = cat8(Bt[n][0], Bt[n][1]), a8_ = cat8(At[m][0], At[m][1]); asm volatile("v_mfma_scale_f32_16x16x128_f8f6f4 %0, %1, %2, %0, %3, %3 op_sel_hi:[0,0,0]" : "+v"(acc[ai][bj][m][n]) : "v"(b8_), "v"(a8_), "v"(one8)); } \
        else { _Pragma("unroll") for (int k = 0; k < 2; ++k) acc[ai][bj][m][n] = __builtin_amdgcn_mfma_f32_16x16x32_bf16(Bt[n][k], At[m][k], acc[ai][bj][m][n], 0, 0, 0); } } __builtin_amdgcn_s_setprio(0); } while (0)
#define PG8_WAIT_V(n) asm volatile("s_waitcnt vmcnt(" #n ")" ::: "memory")
#define PG8_WAIT_L(n) asm volatile("s_waitcnt lgkmcnt(" #n ")" ::: "memory")
#define PG8_BAR __builtin_amdgcn_s_barrier()
#define PG8_SCHED __builtin_amdgcn_sched_barrier(0)
    Unit cur, nxt; int ui = 0;
    if (!S.next(0, cur)) return;
    f32x4 acc[2][2][4][2];
#pragma unroll
    for (int a = 0; a < 2; ++a)
#pragma unroll
        for (int b = 0; b < 2; ++b)
#pragma unroll
            for (int m = 0; m < 4; ++m)
#pragma unroll
                for (int n = 0; n < 2; ++n) acc[a][b][m][n] = (f32x4){0.f, 0.f, 0.f, 0.f};
    bf16x8 At[4][2], B0[2][2], B1[2][2];
    {
        const char* cA = cur.a0; const char* cB = cur.b0;
        if constexpr (GATHER) { PG8_ROWS(vC, 0); }
        PG8_STAGE(PG8_SB(0, 0), cB, voffB); PG8_STAGE(PG8_SB(0, 1), cB + hstepB, voffB); PG8_STAGE_A(PG8_SA(0, 0), cA, 0, vC); PG8_STAGE_A(PG8_SA(0, 1), cA, 1, vC);
        if (wr == 1) PG8_BAR;
        PG8_WAIT_V(2); PG8_BAR;
        PG8_STAGE(PG8_SB(1, 0), cB + kstep, voffB); PG8_STAGE_A(PG8_SA(1, 0), cA + kstep, 0, vC); PG8_STAGE(PG8_SB(1, 1), cB + hstepB + kstep, voffB);
        PG8_WAIT_V(6); PG8_BAR;
    }
    for (;;) {
        const bool has_next = S.next(ui + 1, nxt);
        const char* nA = has_next ? nxt.a0 : cur.a0; const char* nB = has_next ? nxt.b0 : cur.b0;
        if constexpr (GATHER) { PG8_ROWS(vP, has_next ? ui + 1 : ui); }
#pragma unroll 1
        for (int t = 0; t < nt; t += 2) {
            const bool last = (t == nt - 2);
            const char *a1, *a2, *b2;
            if constexpr (SPLITK) {
                a1 = (t + 1 < nth) ? cur.a0 + (size_t)(t + 1) * kstep : cur.a1 + (size_t)(t + 1 - nth) * kstep;
                a2 = last ? nA : ((t + 2 < nth) ? cur.a0 + (size_t)(t + 2) * kstep : cur.a1 + (size_t)(t + 2 - nth) * kstep);
                b2 = last ? nB : ((t + 2 < nth) ? cur.b0 + (size_t)(t + 2) * kstep : cur.b1 + (size_t)(t + 2 - nth) * kstep);
            } else {
                a1 = cur.a0 + (size_t)(t + 1) * kstep; a2 = last ? nA : cur.a0 + (size_t)(t + 2) * kstep; b2 = last ? nB : cur.b0 + (size_t)(t + 2) * kstep;
            }
            const char* a3 = a2 + kstep; const char* b3 = b2 + kstep;
            PG8_LDB(B0, 0, 0); PG8_LDB(B1, 0, 1); PG8_SCHED; PG8_LDA(At, 0, 0); PG8_STAGE_A(PG8_SA(1, 1), a1, 1, vC);
            if constexpr (GATHER) { if (last) { _Pragma("unroll") for (int _h = 0; _h < 2; ++_h) _Pragma("unroll") for (int _i = 0; _i < 2; ++_i) vC[_h][_i] = vP[_h][_i]; } }
            PG8_WAIT_V(8); PG8_WAIT_L(0); PG8_BAR; PG8_MMA(0, 0, At, B0); PG8_MMA(0, 1, At, B1); PG8_BAR; PG8_SCHED;
            PG8_LDA(At, 0, 1); PG8_STAGE(PG8_SB(0, 0), b2, voffB); PG8_STAGE(PG8_SB(0, 1), b2 + hstepB, voffB); PG8_STAGE_A(PG8_SA(0, 0), a2, 0, vC);
            PG8_WAIT_V(8); PG8_WAIT_L(0); PG8_BAR; PG8_MMA(1, 0, At, B0); PG8_MMA(1, 1, At, B1); PG8_BAR; PG8_SCHED;
            PG8_LDB(B0, 1, 0); PG8_LDB(B1, 1, 1); PG8_SCHED; PG8_LDA(At, 1, 0); PG8_STAGE_A(PG8_SA(0, 1), a2, 1, vC);
            PG8_WAIT_V(8); PG8_WAIT_L(0); PG8_BAR; PG8_MMA(0, 0, At, B0); PG8_MMA(0, 1, At, B1); PG8_BAR; PG8_SCHED;
            PG8_LDA(At, 1, 1); PG8_STAGE(PG8_SB(1, 0), b3, voffB); PG8_STAGE(PG8_SB(1, 1), b3 + hstepB, voffB); PG8_STAGE_A(PG8_SA(1, 0), a3, 0, vC);
            PG8_WAIT_V(8); PG8_WAIT_L(0); PG8_BAR; PG8_MMA(1, 0, At, B0); PG8_MMA(1, 1, At, B1); PG8_BAR; PG8_SCHED;
        }
        if constexpr (FP8) asm volatile("s_nop 15\n\ts_nop 15" ::: "memory");
        if constexpr (ALIGN_EPI) { if (wr == 0) PG8_BAR; }
        { int fr_ = fr, fq_ = fq; asm volatile("" : "+v"(fr_), "+v"(fq_)); E(acc, cur, wr, wc, fr_, fq_, lds); }
        if (!has_next) break;
#pragma unroll
        for (int a = 0; a < 2; ++a)
#pragma unroll
            for (int b = 0; b < 2; ++b)
#pragma unroll
                for (int m = 0; m < 4; ++m)
#pragma unroll
                    for (int n = 0; n < 2; ++n) acc[a][b][m][n] = (f32x4){0.f, 0.f, 0.f, 0.f};
        cur = nxt; ++ui;
        if constexpr (GATHER) {
#pragma unroll
            for (int _h = 0; _h < 2; ++_h)
#pragma unroll
                for (int _i = 0; _i < 2; ++_i) vC[_h][_i] = vP[_h][_i]; }
        if constexpr (ALIGN_EPI) { if (wr == 1) PG8_BAR; }
    }
    PG8_WAIT_V(0);
    if constexpr (!ALIGN_EPI) { if (wr == 0) PG8_BAR; }
    PG8_BAR;
#undef PG8_SA
#undef PG8_SB
#undef PG8_STAGE
#undef PG8_STAGE_A
#undef PG8_STAGE_A2
#undef PG8_ROWS
#undef PG8_LDA
#undef PG8_LDB
#undef PG8_MMA
#undef PG8_WAIT_V
#undef PG8_WAIT_L
#undef PG8_BAR
#undef PG8_SCHED
}
struct DenseOrder {
    int nM, nN, nwg, G, c; const char* A; const char* B; size_t tA, tB;
    __device__ void init(int nM_, int nN_, int G_, int c_, const void* A_, int lda, const void* B_, int ldb) { nM = nM_; nN = nN_; nwg = nM * nN; G = G_; c = c_; A = (const char*)A_; B = (const char*)B_; tA = (size_t)BM * lda * 2; tB = (size_t)BM * ldb * 2; }
    __device__ __forceinline__ bool tile(int i, int& pm, int& pn) const {
        const long L = (long)i * G + c; if (L >= nwg) return false;
        int wgid = (int)L; { const int q = nwg / NXCD, r = nwg % NXCD, xcd = wgid % NXCD, off = wgid / NXCD; wgid = (xcd < r ? xcd * (q + 1) : r * (q + 1) + (xcd - r) * q) + off; }
        const int nig = WGM * nN, gid = wgid / nig, fm = gid * WGM, gsz = (nM - fm) < WGM ? (nM - fm) : WGM;
        pm = fm + ((wgid % nig) % gsz); pn = (wgid % nig) / gsz; return true;
    }
    __device__ __forceinline__ bool next(int i, Unit& u) const { int pm, pn; if (!tile(i, pm, pn)) return false; u.pm = pm; u.pn = pn; u.a0 = A + pm * tA; u.b0 = B + pn * tB; u.a1 = u.a0; u.b1 = u.b0; return true; }
};
struct MoeOrder : DenseOrder {
    const int* tile_e; bool gather;
    __device__ __forceinline__ bool next(int i, Unit& u) const { int pm, pn; if (!tile(i, pm, pn)) return false; const int e = tile_e[pm];
        u.pm = pm; u.pn = pn; u.a0 = gather ? A : A + pm * tA; u.b0 = B + ((size_t)e * nN + pn) * tB; u.a1 = u.a0; u.b1 = u.b0; return true; }
};
template <int KIND> struct BatchOrder {
    int G, c; const char* ws;
    __device__ __forceinline__ bool next(int i, Unit& u) const {
        const int unit = i * G + c; if (unit >= NUNIT) return false;
        int t0, h; unit_dec(unit, t0, h); const size_t rowoff = ((size_t)t0 * DM + h * 256) * 2, uoff = (size_t)unit * 131072;
        u.pm = unit; u.pn = 0;
        if (KIND == 0) { u.a0 = ws + O_VT + uoff; u.b0 = ws + O_KWT + uoff; u.a1 = u.a0; u.b1 = u.b0; }
        else if (KIND == 1) { u.a0 = ws + O_Q + rowoff; u.b0 = ws + O_K + rowoff; u.a1 = u.a0; u.b1 = u.b0; }
        else { u.a0 = ws + O_SP + rowoff; u.a1 = ws + O_Q + rowoff; u.b0 = ws + O_VT + uoff; u.b1 = ws + O_CT + uoff; }
        return true;
    }
};
__device__ __forceinline__ f32x4 sig4(const f32x4 v) { f32x4 r; r[0] = sigm(v[0]); r[1] = sigm(v[1]); r[2] = sigm(v[2]); r[3] = sigm(v[3]); return r; }
__device__ __forceinline__ f32x4 lo4(const u32x4 w) { return (f32x4){bflo(w.x), bfhi(w.x), bflo(w.y), bfhi(w.y)}; }
__device__ __forceinline__ f32x4 hi4(const u32x4 w) { return (f32x4){bflo(w.z), bfhi(w.z), bflo(w.w), bfhi(w.w)}; }
typedef f32x4 Acc[2][2][4][2];
struct EpiIn {
    static constexpr bool PERM = true; unsigned char* ws;
    __device__ __forceinline__ void operator()(const Acc& acc, const Unit& u, int wr, int wc, int fr, int fq, LAS unsigned char*) const {
        const int row0 = u.pm * BM + wr * 64 + fr;
        if (u.pn < 8) {
            bf16* O = (bf16*)(ws + O_U1) + u.pn * 128 + wc * 32 + 8 * fq;
#pragma unroll
            for (int ai = 0; ai < 2; ++ai)
#pragma unroll
                for (int m = 0; m < 4; ++m) { const f32x4 v0 = acc[ai][0][m][0] * sig4(acc[ai][1][m][0]), v1 = acc[ai][0][m][1] * sig4(acc[ai][1][m][1]);
                    *(u32x4*)(O + (size_t)(row0 + ai * HALF + m * 16) * DM) = pack8(v0, v1); }
        } else {
            const int t = (u.pn - 8) >> 2; const size_t so = t == 0 ? O_XM : t == 1 ? O_SO : t == 2 ? O_SZA : O_SZB;
            bf16* O = (bf16*)(ws + so) + ((u.pn - 8) & 3) * 256 + wc * 32 + 8 * fq;
#pragma unroll
            for (int ai = 0; ai < 2; ++ai)
#pragma unroll
                for (int m = 0; m < 4; ++m)
#pragma unroll
                    for (int bj = 0; bj < 2; ++bj) { f32x4 v0 = acc[ai][bj][m][0], v1 = acc[ai][bj][m][1]; if (t > 0) { v0 = sig4(v0); v1 = sig4(v1); }
                        *(u32x4*)(O + (size_t)(row0 + ai * HALF + m * 16) * DM + bj * HALF) = pack8(v0, v1); }
        }
    }
};
struct EpiPw {
    static constexpr bool PERM = true; unsigned char* ws; const float* bias;
    __device__ __forceinline__ void operator()(const Acc& acc, const Unit& u, int wr, int wc, int fr, int fq, LAS unsigned char*) const {
        const int row0 = u.pm * BM + wr * 64 + fr, col0 = u.pn * BM + wc * 32 + 8 * fq;
        f32x4 bb[2][2];
#pragma unroll
        for (int bj = 0; bj < 2; ++bj) { bb[bj][0] = *(const f32x4*)(bias + col0 + bj * HALF); bb[bj][1] = *(const f32x4*)(bias + col0 + bj * HALF + 4); }
#pragma unroll
        for (int ai = 0; ai < 2; ++ai) {
            u32x4 z[4][2];
#pragma unroll
            for (int m = 0; m < 4; ++m)
#pragma unroll
                for (int bj = 0; bj < 2; ++bj) z[m][bj] = *(const u32x4*)((const bf16*)(ws + O_SZA) + (size_t)(row0 + ai * HALF + m * 16) * DM + col0 + bj * HALF);
            asm volatile("" ::: "memory");
#pragma unroll
            for (int m = 0; m < 4; ++m)
#pragma unroll
                for (int bj = 0; bj < 2; ++bj) { const size_t o = (size_t)(row0 + ai * HALF + m * 16) * DM + col0 + bj * HALF;
                    *(u32x4*)((bf16*)(ws + O_YAG) + o) = pack8(lo4(z[m][bj]) * (acc[ai][bj][m][0] + bb[bj][0]), hi4(z[m][bj]) * (acc[ai][bj][m][1] + bb[bj][1])); }
            asm volatile("" ::: "memory");
        }
    }
};
struct EpiMo {
    static constexpr bool PERM = true; unsigned char* ws;
    __device__ __forceinline__ void operator()(const Acc& acc, const Unit& u, int wr, int wc, int fr, int fq, LAS unsigned char*) const {
        const int row0 = u.pm * BM + wr * 64 + fr, col0 = u.pn * BM + wc * 32 + 8 * fq;
#pragma unroll
        for (int am = 0; am < 4; ++am) {
            const int ai = am >> 1;
            u32x4 z[2][2], y[2][2];
#pragma unroll
            for (int mm = 0; mm < 2; ++mm)
#pragma unroll
                for (int bj = 0; bj < 2; ++bj) { const size_t o = (size_t)(row0 + ai * HALF + ((am & 1) * 2 + mm) * 16) * DM + col0 + bj * HALF;
                    z[mm][bj] = *(const u32x4*)((const bf16*)(ws + O_SZB) + o); y[mm][bj] = *(const u32x4*)((const bf16*)(ws + O_YAG) + o); }
            asm volatile("" ::: "memory");
#pragma unroll
            for (int mm = 0; mm < 2; ++mm)
#pragma unroll
                for (int bj = 0; bj < 2; ++bj) { const int m = (am & 1) * 2 + mm; const size_t o = (size_t)(row0 + ai * HALF + m * 16) * DM + col0 + bj * HALF;
                    *(u32x4*)((bf16*)(ws + O_MERGED) + o) = pack8(lo4(y[mm][bj]) + lo4(z[mm][bj]) * acc[ai][bj][m][0], hi4(y[mm][bj]) + hi4(z[mm][bj]) * acc[ai][bj][m][1]); }
            asm volatile("" ::: "memory");
        }
    }
};
struct EpiOut {
    static constexpr bool PERM = false; unsigned char* ws; const float* x;
    __device__ __forceinline__ void operator()(const Acc& acc, const Unit& u, int wr, int wc, int fr, int fq, LAS unsigned char*) const {
        const int row0 = u.pm * BM + wr * 64 + fr, col0 = u.pn * BM + wc * 32 + 4 * fq, b = (u.pm * BM) / SEQ;
        const float* gt = (const float*)(ws + WS_MOD) + b * DIN + 2048; float* X1 = (float*)(ws + O_X1); float* ssq = (float*)(ws + WS_SSQ);
        f32x4 gv[2][2];
#pragma unroll
        for (int bj = 0; bj < 2; ++bj)
#pragma unroll
            for (int n = 0; n < 2; ++n) gv[bj][n] = *(const f32x4*)(gt + col0 + bj * HALF + n * 16);
#pragma unroll
        for (int am = 0; am < 4; ++am) {
            const int ai = am >> 1;
            f32x4 xr[2][2][2]; float sq[2] = {0.f, 0.f};
#pragma unroll
            for (int mm = 0; mm < 2; ++mm)
#pragma unroll
                for (int bj = 0; bj < 2; ++bj)
#pragma unroll
                    for (int n = 0; n < 2; ++n) xr[mm][bj][n] = *(const f32x4*)(x + (size_t)(row0 + ai * HALF + ((am & 1) * 2 + mm) * 16) * DM + col0 + bj * HALF + n * 16);
            asm volatile("" ::: "memory");
#pragma unroll
            for (int mm = 0; mm < 2; ++mm)
#pragma unroll
                for (int bj = 0; bj < 2; ++bj)
#pragma unroll
                    for (int n = 0; n < 2; ++n) { const int m = (am & 1) * 2 + mm; const f32x4 v = xr[mm][bj][n] + gv[bj][n] * acc[ai][bj][m][n];
                        *(f32x4*)(X1 + (size_t)(row0 + ai * HALF + m * 16) * DM + col0 + bj * HALF + n * 16) = v; sq[mm] += (v[0] * v[0] + v[1] * v[1]) + (v[2] * v[2] + v[3] * v[3]); }
#pragma unroll
            for (int mm = 0; mm < 2; ++mm) { float q = sq[mm]; q += __shfl_xor(q, 16); q += __shfl_xor(q, 32);
                if (fq == 0) ssq[(size_t)(row0 + ai * HALF + ((am & 1) * 2 + mm) * 16) * 16 + u.pn * 4 + wc] = q; }
            asm volatile("" ::: "memory");
        }
    }
};
struct EpiU {
    static constexpr bool PERM = true; unsigned char* ws;
    __device__ __forceinline__ void operator()(const Acc& acc, const Unit& u, int wr, int wc, int fr, int fq, LAS unsigned char*) const {
        bf16* O = (bf16*)(ws + O_UT) + (size_t)u.pm * 65536 + (wr * 64 + fr) * 256 + wc * 32 + 8 * fq;
#pragma unroll
        for (int ai = 0; ai < 2; ++ai)
#pragma unroll
            for (int m = 0; m < 4; ++m)
#pragma unroll
                for (int bj = 0; bj < 2; ++bj) *(u32x4*)(O + (ai * HALF + m * 16) * 256 + bj * HALF) = pack8(acc[ai][bj][m][0], acc[ai][bj][m][1]);
    }
};
struct EpiS {
    static constexpr bool PERM = true; unsigned char* ws;
    __device__ __forceinline__ void operator()(const Acc& acc, const Unit& u, int wr, int wc, int fr, int fq, LAS unsigned char*) const {
        int t0, h; unit_dec(u.pm, t0, h);
        const int r0 = wr * 64 + fr, c0 = wc * 32 + 8 * fq;
        const float* cw = (const float*)(ws + WS_CW) + u.pm * 256 + c0; float* denp = (float*)(ws + WS_DENP) + (size_t)u.pm * 1024;
        bf16* O = (bf16*)(ws + O_SP) + (size_t)t0 * DM + h * 256 + c0;
        f32x4 w[2][2];
#pragma unroll
        for (int bj = 0; bj < 2; ++bj)
#pragma unroll
            for (int n = 0; n < 2; ++n) w[bj][n] = *(const f32x4*)(cw + bj * HALF + 4 * n);
#pragma unroll
        for (int ai = 0; ai < 2; ++ai)
#pragma unroll
            for (int m = 0; m < 4; ++m) { const int r = r0 + ai * HALF + m * 16; float rs = 0.f;
#pragma unroll
                for (int bj = 0; bj < 2; ++bj) { f32x4 v[2];
#pragma unroll
                    for (int n = 0; n < 2; ++n) { v[n] = acc[ai][bj][m][n] * w[bj][n]; const int c = c0 + bj * HALF + 4 * n;
#pragma unroll
                        for (int j = 0; j < 4; ++j) { if (c + j > r) v[n][j] = 0.f; rs += v[n][j]; } }
                    *(u32x4*)(O + (size_t)r * DM + bj * HALF) = pack8(v[0], v[1]); }
                rs += __shfl_xor(rs, 16); rs += __shfl_xor(rs, 32);
                if (fq == 0) denp[r * 4 + wc] = rs;
                asm volatile("" ::: "memory"); }
    }
};
struct EpiO {
    static constexpr bool PERM = true; unsigned char* ws; const float* hng; const float* skip;
    __device__ __forceinline__ void operator()(Acc& acc, const Unit& u, int wr, int wc, int fr, int fq, LAS unsigned char* lds) const {
        int t0, h; unit_dec(u.pm, t0, h);
        LAS float* inv = (LAS float*)(lds + 131072);
        LAS float* PS = inv + 256;
        LAS float* nsl = PS + 2048;
        const int tid = otid();
        const int r0 = wr * 64 + fr, c0 = wc * 32 + 8 * fq;
        if (tid < 256) {
            const f32x4 dp = *(const f32x4*)((const float*)(ws + WS_DENP) + (size_t)u.pm * 1024 + tid * 4); const float fl = ((const float*)(ws + WS_FLOOR))[u.pm * 256 + tid];
            const float den = nsl[((u.pm - (int)blockIdx.x) / (int)gridDim.x) * 256 + tid] + (dp[0] + dp[1]) + (dp[2] + dp[3]);
            inv[tid] = __builtin_amdgcn_rcpf(fmaxf(fabsf(den), fl)); }
        u32x4 gin[4][2];
        asm volatile("s_waitcnt lgkmcnt(0)" ::: "memory"); __builtin_amdgcn_s_barrier(); asm volatile("" ::: "memory");
#pragma unroll
        for (int ai = 0; ai < 2; ++ai) {
#pragma unroll
            for (int m = 0; m < 4; ++m)
#pragma unroll
                for (int bj = 0; bj < 2; ++bj) gin[m][bj] = *(const u32x4*)((const bf16*)(ws + O_SO) + (size_t)(t0 + r0 + ai * HALF + m * 16) * DM + h * 256 + c0 + bj * HALF);
            asm volatile("" ::: "memory");
#pragma unroll
            for (int m = 0; m < 4; ++m) { const int r = r0 + ai * HALF + m * 16; const float iv = inv[r]; float s = 0.f, q = 0.f;
#pragma unroll
                for (int bj = 0; bj < 2; ++bj) { const u32x4 so = gin[m][bj];
                    const f32x4 v0 = acc[ai][bj][m][0] * iv * lo4(so), v1 = acc[ai][bj][m][1] * iv * hi4(so); acc[ai][bj][m][0] = v0; acc[ai][bj][m][1] = v1;
                    s += (v0[0] + v0[1]) + (v0[2] + v0[3]) + (v1[0] + v1[1]) + (v1[2] + v1[3]);
                    q += (v0[0] * v0[0] + v0[1] * v0[1]) + (v0[2] * v0[2] + v0[3] * v0[3]) + (v1[0] * v1[0] + v1[1] * v1[1]) + (v1[2] * v1[2] + v1[3] * v1[3]); }
                s += __shfl_xor(s, 16); s += __shfl_xor(s, 32); q += __shfl_xor(q, 16); q += __shfl_xor(q, 32);
                if (fq == 0) { PS[(r * 4 + wc) * 2] = s; PS[(r * 4 + wc) * 2 + 1] = q; } }
            asm volatile("" ::: "memory");
        }
        asm volatile("s_waitcnt lgkmcnt(0)" ::: "memory"); __builtin_amdgcn_s_barrier(); asm volatile("" ::: "memory");
#pragma unroll
        for (int ai = 0; ai < 2; ++ai) {
#pragma unroll
            for (int m = 0; m < 4; ++m)
#pragma unroll
                for (int bj = 0; bj < 2; ++bj) gin[m][bj] = *(const u32x4*)((const bf16*)(ws + O_XC) + (size_t)(t0 + r0 + ai * HALF + m * 16) * DM + h * 256 + c0 + bj * HALF);
            asm volatile("" ::: "memory");
#pragma unroll
            for (int m = 0; m < 4; ++m) { const int r = r0 + ai * HALF + m * 16;
                const f32x4 p0 = *(const LAS f32x4*)(PS + r * 8), p1 = *(const LAS f32x4*)(PS + r * 8 + 4);
                const float mu = ((p0[0] + p0[2]) + (p1[0] + p1[2])) * (1.f / 256.f), ex2 = ((p0[1] + p0[3]) + (p1[1] + p1[3])) * (1.f / 256.f), rs = rsqrtf(fmaxf(ex2 - mu * mu, 0.f) + EPS);
#pragma unroll
                for (int bj = 0; bj < 2; ++bj) { const size_t o = (size_t)(t0 + r) * DM + h * 256 + c0 + bj * HALF; const u32x4 xc = gin[m][bj];
                    const float* gp = hng + h * 256 + c0 + bj * HALF; const float* sp_ = skip + h * 256 + c0 + bj * HALF;
                    const f32x4 v0 = (acc[ai][bj][m][0] - mu) * rs * *(const f32x4*)gp + *(const f32x4*)sp_ * lo4(xc), v1 = (acc[ai][bj][m][1] - mu) * rs * *(const f32x4*)(gp + 4) + *(const f32x4*)(sp_ + 4) * hi4(xc);
                    *(u32x4*)((bf16*)(ws + O_MOIN) + o) = pack8(v0, v1); } }
            asm volatile("" ::: "memory");
        }
        asm volatile("s_waitcnt lgkmcnt(0)" ::: "memory"); __builtin_amdgcn_s_barrier(); asm volatile("" ::: "memory");
    }
};
struct EpiGu {
    static constexpr bool PERM = true; unsigned char* ws; const float* bgu;
    __device__ __forceinline__ void operator()(const Acc& acc, const Unit& u, int wr, int wc, int fr, int fq, LAS unsigned char*) const {
        const int e = ((const int*)(ws + WS_TILEE))[u.pm]; const int ch0 = u.pn * 128 + wc * 32 + 8 * fq;
        const float* bb = bgu + e * 2048 + ch0;
        const f32x4 bg0 = *(const f32x4*)(bb), bg1 = *(const f32x4*)(bb + 4), bu0 = *(const f32x4*)(bb + 1024), bu1 = *(const f32x4*)(bb + 1028);
        unsigned char* O = ws + O_ACT + (size_t)(u.pm * BM + wr * 64 + fr) * KP8 + ch0;
        constexpr float ds = 1.f / (S_HM * S_W);
#pragma unroll
        for (int ai = 0; ai < 2; ++ai)
#pragma unroll
            for (int m = 0; m < 4; ++m) { f32x4 v[2];
#pragma unroll
                for (int n = 0; n < 2; ++n) { const f32x4 gt = acc[ai][0][m][n] * ds + (n ? bg1 : bg0), up = acc[ai][1][m][n] * ds + (n ? bu1 : bu0);
#pragma unroll
                    for (int j = 0; j < 4; ++j) { const float gg = fminf(gt[j], 7.f), uu = __builtin_amdgcn_fmed3f(up[j], -7.f, 7.f);
                        const float sg = __builtin_amdgcn_rcpf(1.f + __builtin_amdgcn_exp2f(gg * (-1.702f * 1.4426950408889634f)));
                        v[n][j] = (uu * S_ACT + S_ACT) * (gg * sg); } }
                u32x2 w8; w8.x = pk4_fp8_nc(v[0][0], v[0][1], v[0][2], v[0][3]); w8.y = pk4_fp8_nc(v[1][0], v[1][1], v[1][2], v[1][3]);
                *(u32x2*)(O + (size_t)(ai * HALF + m * 16) * KP8) = w8; }
    }
};
struct EpiDn {
    static constexpr bool PERM = true; unsigned char* ws; const float* bdn;
    __device__ __forceinline__ void operator()(const Acc& acc, const Unit& u, int wr, int wc, int fr, int fq, LAS unsigned char*) const {
        const int e = ((const int*)(ws + WS_TILEE))[u.pm]; const int col0 = u.pn * BM + wc * 32 + 8 * fq, row0 = u.pm * BM + wr * 64 + fr;
        const float* roww = (const float*)(ws + WS_ROWSLOT); bf16* Y = (bf16*)(ws + O_Y);
        float w[2][4];
#pragma unroll
        for (int ai = 0; ai < 2; ++ai)
#pragma unroll
            for (int m = 0; m < 4; ++m) w[ai][m] = roww[row0 + ai * HALF + m * 16];
        f32x4 b[2][2];
#pragma unroll
        for (int bj = 0; bj < 2; ++bj)
#pragma unroll
            for (int n = 0; n < 2; ++n) b[bj][n] = *(const f32x4*)(bdn + e * DM + col0 + bj * HALF + 4 * n);
        asm volatile("" ::: "memory");
#pragma unroll
        for (int ai = 0; ai < 2; ++ai)
#pragma unroll
            for (int m = 0; m < 4; ++m)
#pragma unroll
                for (int bj = 0; bj < 2; ++bj) *(u32x4*)(Y + (size_t)(row0 + ai * HALF + m * 16) * DM + col0 + bj * HALF) = pack8((acc[ai][bj][m][0] * (1.f / (S_ACT * S_W)) + b[bj][0]) * w[ai][m], (acc[ai][bj][m][1] * (1.f / (S_ACT * S_W)) + b[bj][1]) * w[ai][m]);
    }
};
}


__device__ __forceinline__ void ph_g_in(const P& p, LAS unsigned char* lds) {
    pg8::Gemm g{DM, DM, 16, 16, nullptr}; pg8::DenseOrder S; S.init(T / 256, DIN / 256, gridDim.x, blockIdx.x, p.ws + O_HA, DM, p.ws + WS_WIN, DM);
    pg8::EpiIn E{p.ws}; pg8::gemm_phase<pg8::EpiIn, pg8::DenseOrder, true>(lds, g, S, E);
}
__device__ __forceinline__ void ph_g_pw(const P& p, LAS unsigned char* lds) {
    pg8::Gemm g{DM, DM, 16, 16, nullptr}; pg8::DenseOrder S; S.init(T / 256, 4, gridDim.x, blockIdx.x, p.ws + O_YAPRE, DM, p.ws + WS_WPW, DM);
    pg8::EpiPw E{p.ws, p.in[I_BPW]}; pg8::gemm_phase<pg8::EpiPw, pg8::DenseOrder, true>(lds, g, S, E);
}
__device__ __forceinline__ void ph_g_mo(const P& p, LAS unsigned char* lds) {
    pg8::Gemm g{DM, DM, 16, 16, nullptr}; pg8::DenseOrder S; S.init(T / 256, 4, gridDim.x, blockIdx.x, p.ws + O_MOIN, DM, p.ws + WS_WMO, DM);
    pg8::EpiMo E{p.ws}; pg8::gemm_phase<pg8::EpiMo, pg8::DenseOrder, true>(lds, g, S, E);
}
__device__ __forceinline__ void ph_g_out(const P& p, LAS unsigned char* lds) {
    pg8::Gemm g{DM, DM, 16, 16, nullptr}; pg8::DenseOrder S; S.init(T / 256, 4, gridDim.x, blockIdx.x, p.ws + O_MERGED, DM, p.ws + WS_WOUT, DM);
    pg8::EpiOut E{p.ws, p.in[I_X]}; pg8::gemm_phase<pg8::EpiOut, pg8::DenseOrder, true>(lds, g, S, E);
}
__device__ __forceinline__ void ph_g_u(const P& p, LAS unsigned char* lds) {
    pg8::Gemm g{256, 256, 4, 4, nullptr}; pg8::BatchOrder<0> S{(int)gridDim.x, (int)blockIdx.x, (const char*)p.ws};
    pg8::EpiU E{p.ws}; pg8::gemm_phase<pg8::EpiU, pg8::BatchOrder<0>, true>(lds, g, S, E);
}
__device__ __forceinline__ void ph_g_s(const P& p, LAS unsigned char* lds) {
    pg8::Gemm g{DM, DM, 4, 4, nullptr}; pg8::BatchOrder<1> S{(int)gridDim.x, (int)blockIdx.x, (const char*)p.ws};
    pg8::EpiS E{p.ws}; pg8::gemm_phase<pg8::EpiS, pg8::BatchOrder<1>, true>(lds, g, S, E);
}
__device__ __forceinline__ void g_o_qn(const P& p, LAS unsigned char* lds) {
    const int tid = otid(), lane = tid & 63, wave = tid >> 6;
    LAS float* qn = (LAS float*)(lds + 131072) + 256 + 2048;
    int ui = 0;
    for (int unit = blockIdx.x; unit < NUNIT; unit += gridDim.x, ++ui) {
        int t0, h; unit_dec(unit, t0, h);
        const f32x4 n4 = ((const f32x4*)(wsp<float>(p, WS_NS) + unit * 256))[lane];
        const bf16* q = wsp<bf16>(p, O_Q) + (size_t)(t0 + wave * 32) * DM + h * 256 + 4 * lane;
        float v[32];
#pragma unroll
        for (int r = 0; r < 32; ++r) { const u32x2 w2 = *(const u32x2*)(q + (size_t)r * DM); v[r] = (bflo(w2.x) * n4.x + bfhi(w2.x) * n4.y) + (bflo(w2.y) * n4.z + bfhi(w2.y) * n4.w); }
        float a16[16], a8[8], a4[4], a2[2], a1;
        { const bool hi = lane & 32;
#pragma unroll
          for (int i = 0; i < 16; ++i) { const float keep = hi ? v[2 * i + 1] : v[2 * i], send = hi ? v[2 * i] : v[2 * i + 1]; a16[i] = keep + __shfl_xor(send, 32); } }
        { const bool hi = lane & 16;
#pragma unroll
          for (int i = 0; i < 8; ++i) { const float keep = hi ? a16[2 * i + 1] : a16[2 * i], send = hi ? a16[2 * i] : a16[2 * i + 1]; a8[i] = keep + __shfl_xor(send, 16); } }
        { const bool hi = lane & 8;
#pragma unroll
          for (int i = 0; i < 4; ++i) { const float keep = hi ? a8[2 * i + 1] : a8[2 * i], send = hi ? a8[2 * i] : a8[2 * i + 1]; a4[i] = keep + __shfl_xor(send, 8); } }
        { const bool hi = lane & 4;
#pragma unroll
          for (int i = 0; i < 2; ++i) { const float keep = hi ? a4[2 * i + 1] : a4[2 * i], send = hi ? a4[2 * i] : a4[2 * i + 1]; a2[i] = keep + __shfl_xor(send, 4); } }
        { const bool hi = lane & 2; const float keep = hi ? a2[1] : a2[0], send = hi ? a2[0] : a2[1]; a1 = keep + __shfl_xor(send, 2); }
        a1 += __shfl_xor(a1, 1);
        if ((lane & 1) == 0) { const int r = ((lane >> 1) & 1) * 16 + ((lane >> 2) & 1) * 8 + ((lane >> 3) & 1) * 4 + ((lane >> 4) & 1) * 2 + ((lane >> 5) & 1); qn[ui * 256 + wave * 32 + r] = a1; }
    }
    asm volatile("s_waitcnt lgkmcnt(0)" ::: "memory"); __syncthreads();
}
__device__ __forceinline__ void ph_g_o(const P& p, LAS unsigned char* lds) {
    g_o_qn(p, lds);
    pg8::Gemm g{DM, 256, 8, 4, nullptr}; pg8::BatchOrder<2> S{(int)gridDim.x, (int)blockIdx.x, (const char*)p.ws};
    pg8::EpiO E{p.ws, p.in[I_HNG], p.in[I_SKIP]}; pg8::gemm_phase<pg8::EpiO, pg8::BatchOrder<2>, true, true>(lds, g, S, E);
}
__device__ __forceinline__ void ph_g_gu(const P& p, LAS unsigned char* lds) {
    const int nt_ = __builtin_amdgcn_readfirstlane(wsp<int>(p, WS_TILEE)[MAXTILES]);
    pg8::Gemm g{512, KP8 / 2, 8, 8, wsp<int>(p, WS_ROWTOK)}; pg8::MoeOrder S; S.init(nt_, 8, gridDim.x, blockIdx.x, p.ws + O_HM, 512, p.ws + WS_WGU, KP8 / 2); S.tile_e = wsp<int>(p, WS_TILEE); S.gather = true;
    pg8::EpiGu E{p.ws, p.in[I_BGU]}; pg8::gemm_phase<pg8::EpiGu, pg8::MoeOrder, true, false, true, true>(lds, g, S, E);
}
__device__ __forceinline__ void ph_g_dn(const P& p, LAS unsigned char* lds) {
    const int nt_ = __builtin_amdgcn_readfirstlane(wsp<int>(p, WS_TILEE)[MAXTILES]);
    pg8::Gemm g{KP8 / 2, KP8 / 2, 8, 8, nullptr}; pg8::MoeOrder S; S.init(nt_, 4, gridDim.x, blockIdx.x, p.ws + O_ACT, KP8 / 2, p.ws + WS_WDN, KP8 / 2); S.tile_e = wsp<int>(p, WS_TILEE); S.gather = false;
    pg8::EpiDn E{p.ws, p.in[I_BDN]}; pg8::gemm_phase<pg8::EpiDn, pg8::MoeOrder, true, false, false, true>(lds, g, S, E);
}

#define XB_TMO      128
#define XB_XCNT(j)  (256  + 64 * (j))
#define XB_XSUB(j)  (1280 + 64 * (j))
#define XB_XGEN(j)  (2304 + 64 * (j))
#define XB_TOP      3328
#define XB_TOPGEN   3392
#define XCD_BAR_WORDS 3456
#define XB_SPIN_CAP (1u << 18)
__device__ __forceinline__ unsigned xb_ld(unsigned* p)              { return __hip_atomic_load(p, __ATOMIC_RELAXED, __HIP_MEMORY_SCOPE_AGENT); }
__device__ __forceinline__ unsigned xb_add(unsigned* p, unsigned v) { return __hip_atomic_fetch_add(p, v, __ATOMIC_RELAXED, __HIP_MEMORY_SCOPE_AGENT); }
__device__ __forceinline__ unsigned xb_xcc_id() { return (unsigned)__builtin_amdgcn_s_getreg((3 << 11) | 20) & 0xFu; }
#define XB_SPIN(cond, bar) do { unsigned _sp = 0; while (cond) { __builtin_amdgcn_s_sleep(1); \
    if ((++_sp & 255u) == 0u) { if (xb_ld(&(bar)[XB_TMO])) break; if (_sp > XB_SPIN_CAP) { atomicAdd(&(bar)[XB_TMO], 1u); break; } } } } while (0)
struct XcdBarrier { unsigned* bar; unsigned x; volatile LAS unsigned* st; };
__device__ __forceinline__ XcdBarrier xcd_barrier_post(unsigned* bar, volatile LAS unsigned* st) {
    XcdBarrier b; b.bar = bar; b.x = xb_xcc_id(); b.st = st;
    if (threadIdx.x == 0) (void)xb_add(&bar[XB_XCNT(b.x)], 1u);
    return b;
}
__device__ __forceinline__ void xcd_barrier_complete(unsigned* bar, unsigned x, unsigned& nloc, unsigned& nx) {
    const unsigned G = gridDim.x * gridDim.y * gridDim.z;
    unsigned sum, cnt, mine, sp = 0u;
    for (;;) {
        sum = 0u; cnt = 0u; mine = 0u;
#pragma unroll
        for (unsigned j = 0; j < 16; ++j) { const unsigned c = xb_ld(&bar[XB_XCNT(j)]); sum += c; cnt += (c > 0u) ? 1u : 0u; mine = (j == x) ? c : mine; }
        if (sum == G) break;
        __builtin_amdgcn_s_sleep(1);
        if ((++sp & 255u) == 0u) { if (xb_ld(&bar[XB_TMO])) break; if (sp > XB_SPIN_CAP) { atomicAdd(&bar[XB_TMO], 1u); break; } }
    }
    nloc = mine > 0u ? mine : 1u; nx = cnt > 0u ? cnt : 1u;
}
__device__ __forceinline__ void xcd_barrier(const XcdBarrier& b) {
    asm volatile("s_waitcnt vmcnt(0)" ::: "memory");
    __syncthreads();
    if (threadIdx.x == 0) {
        unsigned* bar = b.bar;
        __builtin_amdgcn_s_waitcnt(0);
        unsigned nloc = b.st[0], nx = b.st[1];
        if (nloc == 0u) { xcd_barrier_complete(bar, b.x, nloc, nx); b.st[0] = nloc; b.st[1] = nx; }
        const unsigned old = xb_add(&bar[XB_XSUB(b.x)], 1u);
        const unsigned gen = old / nloc;
        if (old + 1u == (gen + 1u) * nloc) {
            __builtin_amdgcn_fence(__ATOMIC_RELEASE, "agent");
            asm volatile("s_waitcnt vmcnt(0)" ::: "memory");
            const unsigned og = xb_add(&bar[XB_TOP], 1u);
            const unsigned tg = og / nx;
            if (og + 1u == (tg + 1u) * nx) xb_add(&bar[XB_TOPGEN], 1u);
            else XB_SPIN(xb_ld(&bar[XB_TOPGEN]) == tg, bar);
            __builtin_amdgcn_fence(__ATOMIC_ACQUIRE, "agent");
            xb_add(&bar[XB_XGEN(b.x)], 1u);
            asm volatile("s_waitcnt vmcnt(0)" ::: "memory");
        } else {
            XB_SPIN(xb_ld(&bar[XB_XGEN(b.x)]) == gen, bar);
            __builtin_amdgcn_fence(__ATOMIC_ACQUIRE, "agent");
            asm volatile("s_waitcnt vmcnt(0)" ::: "memory");
        }
    }
    __syncthreads();
}

constexpr int LDS_BYTES = 155648, MISC_OFF = LDS_BYTES - 64;
constexpr int NPHASE = 13;
#ifndef DUP
#define DUP 0
#endif
#ifndef SPINMASK
#define SPINMASK 0
#endif
#define RUN(id, call) do { call; if ((DUP >> (id)) & 1) { __syncthreads(); call; } } while (0)
__global__ void __launch_bounds__(512, 2) mega(P p, int lo, int hi) {
    extern __shared__ __attribute__((aligned(16))) unsigned char lds_raw[];
    float* lds = (float*)lds_raw; LAS unsigned char* l3 = (LAS unsigned char*)lds_raw;
    volatile LAS unsigned* misc = (volatile LAS unsigned*)(l3 + MISC_OFF);
    if (threadIdx.x < 16) misc[threadIdx.x] = 0u;
    __syncthreads();
    XcdBarrier bar; bar.bar = wsp<unsigned>(p, WS_CTL); bar.x = 0; bar.st = misc;
    if (hi - lo > 1) bar = xcd_barrier_post(wsp<unsigned>(p, WS_CTL), misc);
    for (int ph = lo; ph < hi; ++ph) {
        const unsigned long long t0_ = SPINMASK ? __builtin_amdgcn_s_memrealtime() : 0ull;
        switch (ph) {
            case 0: ph_mod(p, lds); RUN(1, ph_wconv(p, lds)); mod_wait(p); RUN(2, ph_norm1(p)); break;
            case 1: RUN(3, ph_g_in(p, l3)); break;
            case 2: ph_wprime(p, lds); RUN(4, ph_conv(p, lds)); RUN(5, ph_m1(p, lds)); break;
            case 3: RUN(6, ph_m2(p, lds));
                    asm volatile("s_waitcnt vmcnt(0)" ::: "memory"); __syncthreads();
                    RUN(8, ph_g_u(p, l3)); RUN(7, ph_g_pw(p, l3)); break;
            case 4: RUN(10, ph_scan(p)); break;
            case 5: RUN(9, ph_g_s(p, l3));
                    asm volatile("s_waitcnt vmcnt(0)" ::: "memory"); __syncthreads();
                    RUN(11, ph_g_o(p, l3)); break;
            case 6: RUN(12, ph_g_mo(p, l3)); break;
            case 7: RUN(13, ph_g_out(p, l3)); break;
            case 8: RUN(14, ph_router(p, lds)); break;
            case 9: RUN(15, ph_scatter(p, lds)); break;
            case 10: RUN(16, ph_g_gu(p, l3)); break;
            case 11: RUN(17, ph_g_dn(p, l3)); break;
            case 12: RUN(18, ph_final(p)); break;
        }
        if (ph + 1 < hi || (SPINMASK >> ph) & 1) xcd_barrier(bar);
        if ((SPINMASK >> ph) & 1) { const unsigned long long t1_ = __builtin_amdgcn_s_memrealtime(), d_ = t1_ - t0_; while (__builtin_amdgcn_s_memrealtime() - t1_ < d_) __builtin_amdgcn_s_sleep(8); }
    }
}

#ifndef N_LAUNCHES
#define N_LAUNCHES 1
#endif
extern "C" void kernel_launch(void* const* d_in, const int* in_sizes, int n_in, void* d_out, int out_size, void* d_ws, size_t ws_size, hipStream_t stream) {
    static int grid = 0;
    if (grid == 0) {
        if (n_in != 31 || ws_size < WS_NEED || out_size != T * DM) { fprintf(stderr, "kernel_launch: unexpected shapes: n_in %d ws %zu out %d\n", n_in, ws_size, out_size); grid = -1; return; }
        int dev = 0, cus = 0, per_cu = 0;
        if (hipGetDevice(&dev) != hipSuccess || hipDeviceGetAttribute(&cus, hipDeviceAttributeMultiprocessorCount, dev) != hipSuccess) { fprintf(stderr, "kernel_launch: device query failed\n"); grid = -1; return; }
        if (hipFuncSetAttribute((const void*)mega, hipFuncAttributeMaxDynamicSharedMemorySize, LDS_BYTES) != hipSuccess) { fprintf(stderr, "kernel_launch: hipFuncSetAttribute failed\n"); grid = -1; return; }
        if (hipOccupancyMaxActiveBlocksPerMultiprocessor(&per_cu, (const void*)mega, 512, LDS_BYTES) != hipSuccess || per_cu < 1) { fprintf(stderr, "kernel_launch: occupancy query says %d blocks per CU\n", per_cu); (void)hipGetLastError(); grid = -1; return; }
        grid = cus;
    }
    if (grid < 0) return;
    P p{};
    for (int i = 0; i < 31; ++i) p.in[i] = (const float*)d_in[i];
    p.out = (float*)d_out; p.ws = (unsigned char*)d_ws;
    (void)hipMemsetAsync((char*)d_ws + WS_CTL, 0, 65536, stream);
    if (N_LAUNCHES == 1) hipLaunchKernelGGL(mega, dim3(grid), dim3(512), LDS_BYTES, stream, p, 0, NPHASE);
    else for (int ph = 0; ph < NPHASE; ++ph) hipLaunchKernelGGL(mega, dim3(grid), dim3(512), LDS_BYTES, stream, p, ph, ph + 1);
}
```

```cpp
#include <hip/hip_runtime.h>
#include <cstdio>
#include <cstdint>

constexpr int DM = 1024, NB_ = 4, SEQ = 8192, T = NB_ * SEQ, NE = 32, TOPK = 4, DIN = 6144;
constexpr int CH = 256;
constexpr int NCH = SEQ / CH;
constexpr int NUNIT = NB_ * 4 * NCH;
constexpr int MAXTILES = 544;
constexpr float EPS = 1e-6f;

typedef unsigned short bf16;
typedef float f32x4 __attribute__((ext_vector_type(4)));
typedef unsigned u32x4 __attribute__((ext_vector_type(4)));
typedef unsigned u32x2 __attribute__((ext_vector_type(2)));

constexpr size_t MB = 1u << 20;
constexpr size_t WS_WGU = 0, WS_WDN = 76 * MB;
constexpr size_t SLAB0 = 192 * MB, SLABSZ = 64 * MB;
#define SLAB(i) (SLAB0 + (size_t)(i) * SLABSZ)
constexpr size_t WS_WIN = 960 * MB, WS_WPW = 972 * MB, WS_WMO = 974 * MB, WS_WOUT = 976 * MB;
constexpr size_t WS_CTL = 978 * MB, WS_MOD = 979 * MB, WS_IG = 980 * MB, WS_LOGF = 980 * MB + 512 * 1024;
constexpr size_t WS_CW = 981 * MB, WS_FLOOR = 981 * MB + 512 * 1024, WS_UNITS = 982 * MB, WS_NLOC = 983 * MB, WS_NS = 984 * MB;
constexpr size_t WS_DENP = 985 * MB, WS_DEN = 987 * MB, WS_TOPI = 988 * MB, WS_TOPW = 989 * MB, WS_CNT = 990 * MB, WS_ROWSLOT = 991 * MB, WS_TILEE = 992 * MB;
constexpr size_t WS_ROWTOK = 997 * MB;
constexpr size_t WS_SSQ = WS_DENP;
constexpr size_t WS_MODCNT = WS_CTL + 40960;
constexpr size_t WS_WPR = 998 * MB;
constexpr size_t WS_GP = 993 * MB;
constexpr size_t WS_NEED = 1024 * MB;
constexpr size_t O_HA = SLAB(0), O_YAPRE = SLAB(0), O_MOIN = SLAB(0);
constexpr size_t O_UT = SLAB(11);
constexpr size_t O_SP = 116 * MB;
constexpr size_t O_U1 = SLAB(1), O_KWT = SLAB(1), O_CT = SLAB(1);
constexpr size_t O_XM = SLAB(2), O_VT = SLAB(8);
constexpr size_t O_SO = SLAB(3);
constexpr size_t O_SZA = SLAB(4);
constexpr size_t O_SZB = SLAB(5);
constexpr size_t O_Q = SLAB(6), O_K = SLAB(7), O_V = SLAB(8), O_XC = SLAB(9), O_YAG = SLAB(10), O_MERGED = SLAB(11);
constexpr size_t O_HG = SLAB(7);
constexpr size_t O_X1 = SLAB(0);
constexpr size_t O_HM = SLAB(2);
constexpr size_t O_XS = SLAB(3), O_Y = SLAB(3);
constexpr size_t O_ACT = SLAB(8);

struct P { const float* in[31]; float* out; unsigned char* ws; };
enum { I_X = 0, I_C, I_WADA, I_BADA, I_GMIX, I_WIN, I_WDW, I_BDW, I_LNG, I_LNB, I_WPW, I_BPW, I_WSC, I_BSC, I_WQ, I_WK, I_WV, I_WIF, I_BIF, I_HNG, I_SKIP,
       I_WMO, I_WOUT, I_GMOE, I_WR, I_BR, I_WGU, I_BGU, I_WDN, I_BDN, I_GFIN };

#define LAS __attribute__((address_space(3)))
__device__ __forceinline__ unsigned f2bf(float f) { unsigned u = __float_as_uint(f); return (u + 0x7fffu + ((u >> 16) & 1u)) >> 16; }
__device__ __forceinline__ float bf2f(unsigned h) { return __uint_as_float(h << 16); }
__device__ __forceinline__ unsigned pk2(float lo, float hi) { unsigned r; asm volatile("v_cvt_pk_bf16_f32 %0, %1, %2" : "=v"(r) : "v"(lo), "v"(hi)); return r; }
__device__ __forceinline__ float bflo(unsigned w) { return __uint_as_float(w << 16); }
__device__ __forceinline__ float bfhi(unsigned w) { return __uint_as_float(w & 0xffff0000u); }
__device__ __forceinline__ unsigned pk4_fp8(float a, float b, float c, float d) {
    a = fminf(fmaxf(a, -448.f), 448.f); b = fminf(fmaxf(b, -448.f), 448.f); c = fminf(fmaxf(c, -448.f), 448.f); d = fminf(fmaxf(d, -448.f), 448.f);
    int w = 0; w = __builtin_amdgcn_cvt_pk_fp8_f32(a, b, w, false); w = __builtin_amdgcn_cvt_pk_fp8_f32(c, d, w, true); return (unsigned)w; }
__device__ __forceinline__ unsigned pk4_fp8_nc(float a, float b, float c, float d) { int w = 0; w = __builtin_amdgcn_cvt_pk_fp8_f32(a, b, w, false); w = __builtin_amdgcn_cvt_pk_fp8_f32(c, d, w, true); return (unsigned)w; }
typedef float f32x2_ __attribute__((ext_vector_type(2)));
constexpr int KP8 = 1152;
constexpr float S_HM = 32.f, S_W = 1024.f, S_ACT = 4.f, S_Y = 32.f;
__device__ __forceinline__ float sigm(float x) { return __builtin_amdgcn_rcpf(1.f + __expf(-x)); }
__device__ __forceinline__ float silu(float x) { return x * __builtin_amdgcn_rcpf(1.f + __expf(-x)); }
__device__ __forceinline__ float wave_sum(float v) {
#pragma unroll
    for (int o = 1; o < 64; o <<= 1) v += __shfl_xor(v, o);
    return v;
}
__device__ __forceinline__ float wave_max(float v) {
#pragma unroll
    for (int o = 1; o < 64; o <<= 1) v = fmaxf(v, __shfl_xor(v, o));
    return v;
}
__device__ __forceinline__ int ld_agent(const int* p) { return __hip_atomic_load(p, __ATOMIC_RELAXED, __HIP_MEMORY_SCOPE_AGENT); }
__device__ __forceinline__ int otid() { int t = threadIdx.x; asm volatile("" : "+v"(t)); return t; }
template <class Tp> __device__ __forceinline__ Tp* wsp(const P& p, size_t off) { return (Tp*)(p.ws + off); }

__device__ void ph_mod(const P& p, float* lds) {
    const int tid = otid();
    const float* c = p.in[I_C]; const float* w = p.in[I_WADA]; const float* ba = p.in[I_BADA];
    float* mod = wsp<float>(p, WS_MOD);
    float* sc_ = lds + 2048;
    for (int i = tid; i < NB_ * DM; i += 512) sc_[i] = silu(c[i]);
    __syncthreads();
    for (int cb = blockIdx.x; cb < DIN / 24; cb += gridDim.x) {
        if (tid < 384) {
            const int col = cb * 24 + (tid % 24), ks = tid / 24;
            float a0 = 0.f, a1 = 0.f, a2 = 0.f, a3 = 0.f;
#pragma unroll 8
            for (int k = ks * 64; k < ks * 64 + 64; ++k) {
                const float wv = w[(size_t)k * DIN + col];
                a0 += sc_[k] * wv; a1 += sc_[DM + k] * wv; a2 += sc_[2 * DM + k] * wv; a3 += sc_[3 * DM + k] * wv;
            }
            float* r = lds + (ks * 24 + (tid % 24)) * 4; r[0] = a0; r[1] = a1; r[2] = a2; r[3] = a3;
        }
        __syncthreads();
        if (tid < 96) {
            const int cl = tid % 24, b = tid / 24; float s = 0.f;
            for (int ks = 0; ks < 16; ++ks) s += lds[(ks * 24 + cl) * 4 + b];
            mod[b * DIN + cb * 24 + cl] = s + ba[cb * 24 + cl];
        }
        __syncthreads();
    }
    int done = 0; for (int cb = blockIdx.x; cb < DIN / 24; cb += gridDim.x) ++done;
    asm volatile("s_waitcnt vmcnt(0)" ::: "memory"); __syncthreads();
    if (tid == 0) { __builtin_amdgcn_fence(__ATOMIC_RELEASE, "agent"); asm volatile("s_waitcnt vmcnt(0)" ::: "memory");
        __hip_atomic_fetch_add(wsp<int>(p, WS_MODCNT), done, __ATOMIC_RELAXED, __HIP_MEMORY_SCOPE_AGENT); }
}
__device__ void mod_wait(const P& p) {
    if (otid() == 0) { const int* c = wsp<int>(p, WS_MODCNT); unsigned spins = 0;
        while (ld_agent(c) < DIN / 24 && ++spins < (1u << 22)) __builtin_amdgcn_s_sleep(2);
        __builtin_amdgcn_fence(__ATOMIC_ACQUIRE, "agent"); asm volatile("s_waitcnt vmcnt(0)" ::: "memory"); }
    __syncthreads();
}
__device__ __forceinline__ int glu_row(int n, int half) { const int ch = n % half, isg = n / half; return (ch >> 7) * 256 + isg * 128 + (ch & 127); }
__device__ __forceinline__ void transpose_item(const float* W, int K, int N, bf16* WT, int drow0, float* scr, int kb, int nb, int lane) {
    const int k0 = 64 * kb, n0 = 32 * nb;
#pragma unroll 8
    for (int i = 0; i < 32; ++i) { const int kk = 2 * i + (lane >> 5); scr[kk * 33 + (lane & 31)] = W[(size_t)(k0 + kk) * N + n0 + (lane & 31)]; }
    __builtin_amdgcn_s_waitcnt(0xc07f); asm volatile("" ::: "memory");
    const int c = lane & 7;
#pragma unroll
    for (int j = 0; j < 4; ++j) { const int n = (lane >> 3) + 8 * j; const float* s = scr + (8 * c) * 33 + n;
        u32x4 o; o.x = pk2(s[0 * 33], s[1 * 33]); o.y = pk2(s[2 * 33], s[3 * 33]); o.z = pk2(s[4 * 33], s[5 * 33]); o.w = pk2(s[6 * 33], s[7 * 33]);
        *(u32x4*)(WT + (size_t)(drow0 + n) * K + k0 + 8 * c) = o; }
    __builtin_amdgcn_s_waitcnt(0xc07f); asm volatile("" ::: "memory");
}
__device__ __forceinline__ void transpose_item8(const float* W, int pitch, int N, unsigned char* WT, int drow0, float* scr, int kb, int nb, int lane) {
    const int k0 = 128 * kb, n0 = 32 * nb;
#pragma unroll 8
    for (int i = 0; i < 64; ++i) { const int kk = 2 * i + (lane >> 5); scr[kk * 33 + (lane & 31)] = W[(size_t)(k0 + kk) * N + n0 + (lane & 31)]; }
    __builtin_amdgcn_s_waitcnt(0xc07f); asm volatile("" ::: "memory");
    const int c = lane & 7;
#pragma unroll
    for (int j = 0; j < 4; ++j) { const int n = (lane >> 3) + 8 * j; const float* q = scr + (16 * c) * 33 + n;
        u32x4 o; o.x = pk4_fp8(q[0] * S_W, q[33] * S_W, q[66] * S_W, q[99] * S_W); o.y = pk4_fp8(q[132] * S_W, q[165] * S_W, q[198] * S_W, q[231] * S_W);
        o.z = pk4_fp8(q[264] * S_W, q[297] * S_W, q[330] * S_W, q[363] * S_W); o.w = pk4_fp8(q[396] * S_W, q[429] * S_W, q[462] * S_W, q[495] * S_W);
        *(u32x4*)(WT + (size_t)(drow0 + n) * pitch + k0 + 16 * c) = o; }
    __builtin_amdgcn_s_waitcnt(0xc07f); asm volatile("" ::: "memory");
}
__device__ void ph_wconv(const P& p, float* lds) {
    const int tid = otid(), lane = tid & 63, wave = tid >> 6;
    float* scr = lds + wave * (128 * 33);
    const int gw = blockIdx.x * 8 + wave, NGW = gridDim.x * 8;
    constexpr int I_IN = 16 * 192, I_SQ = 16 * 32, I_GU = 8 * 64, I_DN = 8 * 32;
    constexpr int NITEMS = I_IN + 3 * I_SQ + NE * I_GU + NE * I_DN;
    for (int it = gw; it < NITEMS; it += NGW) {
        int r = it;
        if (r < I_IN) { const int kb = r / 192, nb = r % 192, n0 = nb * 32; const int d = n0 < 2048 ? glu_row(n0, 1024) : n0;
            transpose_item(p.in[I_WIN], DM, DIN, wsp<bf16>(p, WS_WIN), d, scr, kb, nb, lane); continue; } r -= I_IN;
        if (r < I_SQ) { transpose_item(p.in[I_WPW], DM, DM, wsp<bf16>(p, WS_WPW), (r % 32) * 32, scr, r / 32, r % 32, lane); continue; } r -= I_SQ;
        if (r < I_SQ) { transpose_item(p.in[I_WMO], DM, DM, wsp<bf16>(p, WS_WMO), (r % 32) * 32, scr, r / 32, r % 32, lane); continue; } r -= I_SQ;
        if (r < I_SQ) { transpose_item(p.in[I_WOUT], DM, DM, wsp<bf16>(p, WS_WOUT), (r % 32) * 32, scr, r / 32, r % 32, lane); continue; } r -= I_SQ;
        if (r < NE * I_GU) { const int e = r / I_GU, q = r % I_GU, kb = q / 64, nb = q % 64;
            transpose_item8(p.in[I_WGU] + (size_t)e * DM * 2048, KP8, 2048, wsp<unsigned char>(p, WS_WGU) + (size_t)e * 2048 * KP8, glu_row(nb * 32, 1024), scr, kb, nb, lane); continue; } r -= NE * I_GU;
        { const int e = r / I_DN, q = r % I_DN, kb = q / 32, nb = q % 32;
            transpose_item8(p.in[I_WDN] + (size_t)e * DM * DM, KP8, DM, wsp<unsigned char>(p, WS_WDN) + (size_t)e * DM * KP8, nb * 32, scr, kb, nb, lane); }
    }
}
__device__ __forceinline__ void adanorm_row(const float* xrow, const float* g, const float* sc, const float* sh, bf16* orow, int lane) {
    f32x4 v[4]; float s = 0.f;
#pragma unroll
    for (int j = 0; j < 4; ++j) { v[j] = ((const f32x4*)xrow)[lane + 64 * j]; s += (v[j].x * v[j].x + v[j].y * v[j].y) + (v[j].z * v[j].z + v[j].w * v[j].w); }
    const float r = rsqrtf(wave_sum(s) * (1.f / DM) + EPS);
#pragma unroll
    for (int j = 0; j < 4; ++j) { const f32x4 gg = ((const f32x4*)g)[lane + 64 * j], ss = ((const f32x4*)sc)[lane + 64 * j], hh = ((const f32x4*)sh)[lane + 64 * j];
        const f32x4 o = v[j] * r * gg * (1.f + ss) + hh;
        u32x2 w; w.x = pk2(o.x, o.y); w.y = pk2(o.z, o.w); ((u32x2*)orow)[lane + 64 * j] = w; }
}
__device__ void ph_norm1(const P& p) {
    const int tid = otid(), lane = tid & 63, gw = blockIdx.x * 8 + (tid >> 6), NGW = gridDim.x * 8;
    const float* mod = wsp<float>(p, WS_MOD); bf16* HA = wsp<bf16>(p, O_HA); const float* X = p.in[I_X];
    const int per = (T + NGW - 1) / NGW;
    for (int m0 = gw * per; m0 < T && m0 < (gw + 1) * per; ) {
        const int b = m0 / SEQ; int m1 = (gw + 1) * per; if (m1 > T) m1 = T; if (m1 > (b + 1) * SEQ) m1 = (b + 1) * SEQ;
        f32x4 gs[4], hh[4];
#pragma unroll
        for (int j = 0; j < 4; ++j) { gs[j] = ((const f32x4*)p.in[I_GMIX])[lane + 64 * j] * (1.f + ((const f32x4*)(mod + b * DIN + 1024))[lane + 64 * j]); hh[j] = ((const f32x4*)(mod + b * DIN))[lane + 64 * j]; }
        int m = m0;
        for (; m + 4 <= m1; m += 4) {
            f32x4 v[4][4]; float ss[4];
#pragma unroll
            for (int r = 0; r < 4; ++r)
#pragma unroll
                for (int j = 0; j < 4; ++j) v[r][j] = ((const f32x4*)(X + (size_t)(m + r) * DM))[lane + 64 * j];
#pragma unroll
            for (int r = 0; r < 4; ++r) { float q = 0.f;
#pragma unroll
                for (int j = 0; j < 4; ++j) q += (v[r][j].x * v[r][j].x + v[r][j].y * v[r][j].y) + (v[r][j].z * v[r][j].z + v[r][j].w * v[r][j].w);
                ss[r] = rsqrtf(wave_sum(q) * (1.f / DM) + EPS); }
#pragma unroll
            for (int r = 0; r < 4; ++r)
#pragma unroll
                for (int j = 0; j < 4; ++j) { const f32x4 o = v[r][j] * ss[r] * gs[j] + hh[j]; u32x2 w; w.x = pk2(o.x, o.y); w.y = pk2(o.z, o.w); ((u32x2*)(HA + (size_t)(m + r) * DM))[lane + 64 * j] = w; }
        }
        for (; m < m1; ++m) adanorm_row(X + (size_t)m * DM, p.in[I_GMIX], mod + b * DIN + 1024, mod + b * DIN, HA + (size_t)m * DM, lane);
        m0 = m1;
    }
}
__device__ void ph_conv(const P& p, float* lds) {
    const int tid = otid(), lane = tid & 63, wave = tid >> 6, c2 = tid * 2;
    const bf16* U1 = wsp<bf16>(p, O_U1); bf16* YA = wsp<bf16>(p, O_YAPRE);
    bf16* tin = (bf16*)(lds + 256);
    bf16* tout = tin + 2 * 8192;
    const float* wd = p.in[I_WDW];
    float w0[31], w1[31];
#pragma unroll
    for (int j = 0; j < 31; ++j) { w0[j] = wd[j * DM + c2]; w1[j] = wd[j * DM + c2 + 1]; }
    const float b0 = p.in[I_BDW][c2], b1 = p.in[I_BDW][c2 + 1];
    const float g0 = p.in[I_LNG][c2], g1 = p.in[I_LNG][c2 + 1], lb0 = p.in[I_LNB][c2], lb1 = p.in[I_LNB][c2 + 1];
    const int crow = tid >> 7, ccol = (tid & 127) * 8;
    for (int blk = blockIdx.x; blk < T / 128; blk += gridDim.x) {
        const int tb = blk * 128, sb = tb % SEQ;
        unsigned win[38];
#pragma unroll
        for (int j = 0; j < 30; ++j) win[j] = (sb - 30 + j >= 0) ? *(const unsigned*)(U1 + (size_t)(tb - 30 + j) * DM + c2) : 0u;
        u32x4 r0 = *(const u32x4*)(U1 + (size_t)(tb + crow) * DM + ccol), r1 = *(const u32x4*)(U1 + (size_t)(tb + crow + 4) * DM + ccol);
        for (int grp = 0; grp < 16; ++grp) {
            const int t0 = tb + grp * 8;
            bf16* ti = tin + (grp & 1) * 8192;
            *(u32x4*)(ti + crow * 1024 + ccol) = r0; *(u32x4*)(ti + (crow + 4) * 1024 + ccol) = r1;
            if (grp < 15) { r0 = *(const u32x4*)(U1 + (size_t)(t0 + 8 + crow) * DM + ccol); r1 = *(const u32x4*)(U1 + (size_t)(t0 + 12 + crow) * DM + ccol); }
            __syncthreads();
            if (grp > 0) { const bf16* to = tout + ((grp - 1) & 1) * 8192;
                *(u32x4*)(YA + (size_t)(t0 - 8 + crow) * DM + ccol) = *(const u32x4*)(to + crow * 1024 + ccol);
                *(u32x4*)(YA + (size_t)(t0 - 4 + crow) * DM + ccol) = *(const u32x4*)(to + (crow + 4) * 1024 + ccol); }
#pragma unroll
            for (int j = 0; j < 8; ++j) win[30 + j] = *(const unsigned*)(ti + j * 1024 + c2);
            float a0[8], a1[8];
#pragma unroll
            for (int i = 0; i < 8; ++i) { a0[i] = b0; a1[i] = b1; }
#pragma unroll
            for (int j = 0; j < 38; ++j) { const float u0 = bflo(win[j]), u1 = bfhi(win[j]);
#pragma unroll
                for (int i = 0; i < 8; ++i) { const int tap = j - i; if (tap >= 0 && tap <= 30) { a0[i] += u0 * w0[tap]; a1[i] += u1 * w1[tap]; } } }
#pragma unroll
            for (int j = 0; j < 30; ++j) win[j] = win[j + 8];
            float st[16];
#pragma unroll
            for (int i = 0; i < 8; ++i) { st[2 * i] = a0[i] + a1[i]; st[2 * i + 1] = a0[i] * a0[i] + a1[i] * a1[i]; }
            float s8[8], s4[4], s2[2], s1;
            { const bool hi = lane & 32;
#pragma unroll
              for (int i = 0; i < 8; ++i) { const float keep = hi ? st[2 * i + 1] : st[2 * i], send = hi ? st[2 * i] : st[2 * i + 1]; s8[i] = keep + __shfl_xor(send, 32); } }
            { const bool hi = lane & 16;
#pragma unroll
              for (int i = 0; i < 4; ++i) { const float keep = hi ? s8[2 * i + 1] : s8[2 * i], send = hi ? s8[2 * i] : s8[2 * i + 1]; s4[i] = keep + __shfl_xor(send, 16); } }
            { const bool hi = lane & 8;
#pragma unroll
              for (int i = 0; i < 2; ++i) { const float keep = hi ? s4[2 * i + 1] : s4[2 * i], send = hi ? s4[2 * i] : s4[2 * i + 1]; s2[i] = keep + __shfl_xor(send, 8); } }
            { const bool hi = lane & 4; const float keep = hi ? s2[1] : s2[0], send = hi ? s2[0] : s2[1]; s1 = keep + __shfl_xor(send, 4); }
            s1 += __shfl_xor(s1, 2); s1 += __shfl_xor(s1, 1);
            float* red = lds + (grp & 1) * 128;
            if ((lane & 3) == 0) { const int idx = ((lane >> 2) & 1) * 8 + ((lane >> 3) & 1) * 4 + ((lane >> 4) & 1) * 2 + ((lane >> 5) & 1); red[idx * 8 + wave] = s1; }
            __syncthreads();
            float* fin = lds + 16640 + (grp & 1) * 16;
            if (tid < 8) { const f32x4 s0 = *(const f32x4*)(red + tid * 16), s1 = *(const f32x4*)(red + tid * 16 + 4), q0 = *(const f32x4*)(red + tid * 16 + 8), q1 = *(const f32x4*)(red + tid * 16 + 12);
                const float s = ((s0.x + s0.y) + (s0.z + s0.w)) + ((s1.x + s1.y) + (s1.z + s1.w)), q = ((q0.x + q0.y) + (q0.z + q0.w)) + ((q1.x + q1.y) + (q1.z + q1.w));
                const float mu = s * (1.f / DM), var = fmaxf(q * (1.f / DM) - mu * mu, 0.f); fin[tid * 2] = mu; fin[tid * 2 + 1] = rsqrtf(var + EPS); }
            __syncthreads();
            bf16* to = tout + (grp & 1) * 8192;
            const f32x4 f0 = *(const f32x4*)fin, f1 = *(const f32x4*)(fin + 4), f2 = *(const f32x4*)(fin + 8), f3 = *(const f32x4*)(fin + 12);
            const float mus[8] = {f0.x, f0.z, f1.x, f1.z, f2.x, f2.z, f3.x, f3.z}, rss[8] = {f0.y, f0.w, f1.y, f1.w, f2.y, f2.w, f3.y, f3.w};
#pragma unroll
            for (int i = 0; i < 8; ++i) {
                const float mu = mus[i], rs = rss[i];
                const float y0 = (a0[i] - mu) * rs * g0 + lb0, y1 = (a1[i] - mu) * rs * g1 + lb1;
                *(unsigned*)(to + i * 1024 + c2) = pk2(silu(y0), silu(y1));
            }
        }
        __syncthreads();
        { const bf16* to = tout + 8192;
            *(u32x4*)(YA + (size_t)(tb + 120 + crow) * DM + ccol) = *(const u32x4*)(to + crow * 1024 + ccol);
            *(u32x4*)(YA + (size_t)(tb + 124 + crow) * DM + ccol) = *(const u32x4*)(to + (crow + 4) * 1024 + ccol); }
        __syncthreads();
    }
}
typedef short bf16x8v __attribute__((ext_vector_type(8)));
__device__ __forceinline__ unsigned cvtpk(float lo, float hi) { unsigned r; asm volatile("v_cvt_pk_bf16_f32 %0, %1, %2" : "=v"(r) : "v"(lo), "v"(hi)); return r; }
__device__ __forceinline__ bf16x8v pack_frag(const float* v) { u32x4 w; w.x = cvtpk(v[0], v[1]); w.y = cvtpk(v[2], v[3]); w.z = cvtpk(v[4], v[5]); w.w = cvtpk(v[6], v[7]); return __builtin_bit_cast(bf16x8v, w); }
__device__ void ph_m1(const P& p, float* lds) {
    const int tid = otid(), lane = tid & 63, wave = tid >> 6, tok = lane & 15, kg = lane >> 4;
    const bf16* XM = wsp<bf16>(p, O_XM);
    bf16* Q = wsp<bf16>(p, O_Q); bf16* K = wsp<bf16>(p, O_K); bf16* XC = wsp<bf16>(p, O_XC);
    float* GP = wsp<float>(p, WS_GP);
    for (int item = blockIdx.x; item < 256; item += gridDim.x) {
        const int cb = item & 3, range = item >> 2, c8 = cb * 256 + wave * 32 + kg * 8;
        float wsc[4][8], bsc[8];
        float* bd = lds + 4096 + (wave * 4 + kg) * 96;
#pragma unroll
        for (int j = 0; j < 4; ++j) { const f32x4 a = *(const f32x4*)(p.in[I_WSC] + j * DM + c8), b = *(const f32x4*)(p.in[I_WSC] + j * DM + c8 + 4);
            wsc[j][0] = a.x; wsc[j][1] = a.y; wsc[j][2] = a.z; wsc[j][3] = a.w; wsc[j][4] = b.x; wsc[j][5] = b.y; wsc[j][6] = b.z; wsc[j][7] = b.w; }
        { const f32x4 a = *(const f32x4*)(p.in[I_BSC] + c8), b = *(const f32x4*)(p.in[I_BSC] + c8 + 4); bsc[0] = a.x; bsc[1] = a.y; bsc[2] = a.z; bsc[3] = a.w; bsc[4] = b.x; bsc[5] = b.y; bsc[6] = b.z; bsc[7] = b.w; }
#pragma unroll
        for (int g = 0; g < 2; ++g)
#pragma unroll
            for (int i = 0; i < 16; ++i) { const int o = (c8 / 4 + g) * 16 + i; if (tok == 0) { bd[(g * 3 + 0) * 16 + i] = p.in[I_WQ][o]; bd[(g * 3 + 1) * 16 + i] = p.in[I_WK][o]; bd[(g * 3 + 2) * 16 + i] = p.in[I_WV][o]; } }
        __syncthreads();
        bf16x8v bq, bk, bv;
        { float t0[8], t1[8], t2[8];
#pragma unroll
            for (int j = 0; j < 8; ++j) { const bool on = tok < 8; const int gi = tok & 7;
                t0[j] = on ? p.in[I_WIF][(size_t)(c8 + j) * 8 + gi] : 0.f; t1[j] = on ? p.in[I_WIF][(size_t)(DM + c8 + j) * 8 + gi] : 0.f; t2[j] = on ? p.in[I_WIF][(size_t)(2 * DM + c8 + j) * 8 + gi] : 0.f; }
            bq = pack_frag(t0); bk = pack_frag(t1); bv = pack_frag(t2); }
        u32x4 nx[4];
#pragma unroll
        for (int j = 0; j < 4; ++j) { const int t_ = range * 512 + tok, s_ = t_ % SEQ; nx[j] = (u32x4){0u, 0u, 0u, 0u}; if (s_ - 3 + j >= 0) nx[j] = *(const u32x4*)(XM + (size_t)(t_ - 3 + j) * DM + c8); }
        for (int tt = 0; tt < 32; ++tt) {
            const int t = range * 512 + tt * 16 + tok;
            float xm[4][8];
#pragma unroll
            for (int j = 0; j < 4; ++j) { const u32x4 u = nx[j];
                xm[j][0] = bflo(u.x); xm[j][1] = bfhi(u.x); xm[j][2] = bflo(u.y); xm[j][3] = bfhi(u.y); xm[j][4] = bflo(u.z); xm[j][5] = bfhi(u.z); xm[j][6] = bflo(u.w); xm[j][7] = bfhi(u.w); }
            if (tt < 31) {
#pragma unroll
                for (int j = 0; j < 4; ++j) nx[j] = *(const u32x4*)(XM + (size_t)(t + 16 - 3 + j) * DM + c8); }
            float xc[8], q[8], k[8], v[8];
#pragma unroll
            for (int c = 0; c < 8; ++c) { float a = bsc[c];
#pragma unroll
                for (int j = 0; j < 4; ++j) a += xm[j][c] * wsc[j][c];
                xc[c] = silu(a); }
#pragma unroll
            for (int g = 0; g < 2; ++g)
                {   f32x4 aq = {0.f, 0.f, 0.f, 0.f}, ak = aq, av = aq;
#pragma unroll
                    for (int ii = 0; ii < 4; ++ii) { const f32x4 w_q = *(const f32x4*)(bd + (g * 3 + 0) * 16 + ii * 4), w_k = *(const f32x4*)(bd + (g * 3 + 1) * 16 + ii * 4), w_v = *(const f32x4*)(bd + (g * 3 + 2) * 16 + ii * 4);
                        aq += w_q * xc[g * 4 + ii]; ak += w_k * xc[g * 4 + ii]; av += w_v * xm[3][g * 4 + ii]; }
#pragma unroll
                    for (int o = 0; o < 4; ++o) { q[g * 4 + o] = aq[o]; k[g * 4 + o] = ak[o]; v[g * 4 + o] = av[o]; } }
            const bf16x8v fq_ = pack_frag(q), fk_ = pack_frag(k), fv_ = pack_frag(v), fx_ = pack_frag(xc);
            f32x4 acc = {0.f, 0.f, 0.f, 0.f};
            acc = __builtin_amdgcn_mfma_f32_16x16x32_bf16(fq_, bq, acc, 0, 0, 0);
            acc = __builtin_amdgcn_mfma_f32_16x16x32_bf16(fk_, bk, acc, 0, 0, 0);
            acc = __builtin_amdgcn_mfma_f32_16x16x32_bf16(fv_, bv, acc, 0, 0, 0);
            float* red = lds + (tt & 3) * 1024 + wave * 128;
            if (tok < 8) {
#pragma unroll
                for (int r = 0; r < 4; ++r) red[(kg * 4 + r) * 8 + tok] = acc[r]; }
            *(bf16x8v*)(Q + (size_t)t * DM + c8) = fq_; *(bf16x8v*)(K + (size_t)t * DM + c8) = fk_; *(bf16x8v*)(XC + (size_t)t * DM + c8) = fx_;
            if (tt & 1) {
                __syncthreads();
                if (tid < 256) { const int tl = tt - 1 + (tid >> 7), e = tid & 127; const float* rr = lds + (tl & 3) * 1024 + e; float sum = 0.f;
#pragma unroll
                    for (int w = 0; w < 8; ++w) sum += rr[w * 128];
                    GP[(size_t)cb * T * 8 + (size_t)(range * 512 + tl * 16) * 8 + e] = sum; }
            }
        }
        __syncthreads();
    }
}
constexpr int TP = 258;
__device__ void ph_m2(const P& p, float* ldsf) {
    const int tid = otid(), lane = tid & 63, wave = tid >> 6;
    bf16* tile = (bf16*)ldsf;
    float* wts = ldsf + 33024;
    float* red = ldsf + 33024 + 256;
    const bf16* Kb = wsp<bf16>(p, O_K); const bf16* Vb = wsp<bf16>(p, O_XM);
    bf16* KWT = wsp<bf16>(p, O_KWT); bf16* VT = wsp<bf16>(p, O_VT);
    const float* GP = wsp<float>(p, WS_GP); const float* bif = p.in[I_BIF];
    float* CW = wsp<float>(p, WS_CW); float* FL = wsp<float>(p, WS_FLOOR); float* UN = wsp<float>(p, WS_UNITS); float* NLOC = wsp<float>(p, WS_NLOC);
    for (int unit = blockIdx.x; unit < NUNIT; unit += gridDim.x) {
        const int b = unit >> 7, h = (unit >> 5) & 3, c = unit & 31, tok0 = b * SEQ + c * CH;
        float bc = 0.f, a = 0.f, igv = 0.f;
        if (tid < 256) {
            float gi_ = bif[h], gf_ = bif[4 + h];
#pragma unroll
            for (int cb = 0; cb < 4; ++cb) { const float* g8 = GP + (size_t)cb * T * 8 + (size_t)(tok0 + tid) * 8; gi_ += g8[h]; gf_ += g8[4 + h]; }
            igv = gi_;
            float lf = fminf(gf_, 0.f) - log1pf(__expf(-fabsf(gf_)));
#pragma unroll
            for (int o = 1; o < 64; o <<= 1) { const float n = __shfl_up(lf, o); if (lane >= o) lf += n; }
            if (lane == 63) red[wave] = lf;
            bc = lf;
        }
        __syncthreads();
        if (tid < 256) {
            for (int w = 0; w < wave; ++w) bc += red[w];
            a = igv - bc;
            const float m = wave_max(a);
            if (lane == 0) red[8 + wave] = m;
        }
        __syncthreads();
        if (tid < 256) {
            const float amax = fmaxf(fmaxf(red[8], red[9]), fmaxf(red[10], red[11]));
            const float w = __expf(a - amax) * 0.0625f;
            wts[tid] = w; CW[unit * 256 + tid] = w; FL[unit * 256 + tid] = __expf(-bc - amax);
            if (tid == 255) { UN[unit * 2] = amax; UN[unit * 2 + 1] = bc; }
        }
        float wvb[2][16];
#pragma unroll
        for (int g = 0; g < 2; ++g)
#pragma unroll
            for (int i = 0; i < 16; ++i) wvb[g][i] = p.in[I_WV][(h * 64 + (tid & 31) * 2 + g) * 16 + i];
        for (int which = 0; which < 2; ++which) {
            const bf16* src = which ? Vb : Kb; bf16* dst = (which ? VT : KWT) + (size_t)unit * 65536;
            __syncthreads();
            if (which == 1 && tid < 256) NLOC[unit * 256 + tid] = red[16 + tid] + red[16 + 256 + tid];
            u32x4 ld[16];
#pragma unroll
            for (int i = 0; i < 16; ++i) { const int ch = tid + i * 512, row = ch >> 5, cc = ch & 31; ld[i] = *(const u32x4*)(src + (size_t)(tok0 + row) * DM + h * 256 + cc * 8); }
#pragma unroll
            for (int i = 0; i < 16; ++i) { const int ch = tid + i * 512, row = ch >> 5, cc = ch & 31;
                u32x4 v = ld[i];
                if (which) { const float x[8] = {bflo(v.x), bfhi(v.x), bflo(v.y), bfhi(v.y), bflo(v.z), bfhi(v.z), bflo(v.w), bfhi(v.w)}; float o[8];
#pragma unroll
                    for (int g = 0; g < 2; ++g)
#pragma unroll
                        for (int oo = 0; oo < 4; ++oo) { float a = 0.f;
#pragma unroll
                            for (int ii = 0; ii < 4; ++ii) a += x[g * 4 + ii] * wvb[g][ii * 4 + oo];
                            o[g * 4 + oo] = a; }
                    v.x = pk2(o[0], o[1]); v.y = pk2(o[2], o[3]); v.z = pk2(o[4], o[5]); v.w = pk2(o[6], o[7]); }
                unsigned* d = (unsigned*)(tile + row * TP + cc * 8); d[0] = v.x; d[1] = v.y; d[2] = v.z; d[3] = v.w; }
            __syncthreads();
            if (which == 0) { const int dd = tid & 255, hs = tid >> 8; float s0 = 0.f, s1 = 0.f;
#pragma unroll 8
                for (int r = hs * 128; r < hs * 128 + 128; r += 2) { s0 += bf2f(tile[r * TP + dd]) * wts[r]; s1 += bf2f(tile[(r + 1) * TP + dd]) * wts[r + 1]; }
                red[16 + hs * 256 + dd] = s0 + s1; }
            for (int i = 0; i < 8; ++i) {
                const int blk = wave + i * 8;
                const int d = (blk >> 2) * 16 + 2 * (lane >> 3), sc = (blk & 3) * 8 + (lane & 7);
                float e0[8], e1[8];
#pragma unroll
                for (int j = 0; j < 8; ++j) { const unsigned w2 = *(const unsigned*)(tile + (sc * 8 + j) * TP + d); e0[j] = bflo(w2); e1[j] = bfhi(w2); }
                if (which == 0) { const f32x4 wa = *(const f32x4*)(wts + sc * 8), wb = *(const f32x4*)(wts + sc * 8 + 4); const float ww[8] = {wa.x, wa.y, wa.z, wa.w, wb.x, wb.y, wb.z, wb.w};
#pragma unroll
                    for (int j = 0; j < 8; ++j) { e0[j] *= ww[j]; e1[j] *= ww[j]; } }
                u32x4 o; o.x = pk2(e0[0], e0[1]); o.y = pk2(e0[2], e0[3]); o.z = pk2(e0[4], e0[5]); o.w = pk2(e0[6], e0[7]);
                *(u32x4*)(dst + (size_t)d * 256 + sc * 8) = o;
                o.x = pk2(e1[0], e1[1]); o.y = pk2(e1[2], e1[3]); o.z = pk2(e1[4], e1[5]); o.w = pk2(e1[6], e1[7]);
                *(u32x4*)(dst + (size_t)(d + 1) * 256 + sc * 8) = o;
            }
        }
        __syncthreads();
    }
}
__device__ void ph_scan(const P& p) {
    const bf16* UT = wsp<bf16>(p, O_UT); bf16* CT = wsp<bf16>(p, O_CT);
    const float* UN = wsp<float>(p, WS_UNITS); const float* NLOC = wsp<float>(p, WS_NLOC); float* NS = wsp<float>(p, WS_NS);
    const int tid = otid(), nth = gridDim.x * blockDim.x;
    if (tid < 16) for (int e = blockIdx.x * 16 + tid; e < 16 * 256; e += gridDim.x * 16) {
        const int bh = e >> 8, d = e & 255; float n = 0.f, m = 0.f;
        for (int c0 = 0; c0 < NCH; c0 += 8) {
            float nl[8], am[8], bl[8];
#pragma unroll
            for (int q = 0; q < 8; ++q) { const int unit = bh * 32 + c0 + q; nl[q] = NLOC[unit * 256 + d]; am[q] = UN[unit * 2]; bl[q] = UN[unit * 2 + 1]; }
#pragma unroll
            for (int q = 0; q < 8; ++q) { const int unit = bh * 32 + c0 + q; const float amax = am[q], blast = bl[q];
                NS[unit * 256 + d] = n * __expf(m - amax);
                const float mnew = blast + fmaxf(m, amax); n = __expf(blast + m - mnew) * n + __expf(blast + amax - mnew) * nl[q]; m = mnew; }
        }
    }
    for (int e8 = blockIdx.x * blockDim.x + tid; e8 < 16 * 8192; e8 += nth) {
        const int bh = e8 >> 13, idx = e8 & 8191; const size_t off = (size_t)idx * 8;
        float C[8]; float m = 0.f;
#pragma unroll
        for (int j = 0; j < 8; ++j) C[j] = 0.f;
        for (int c0 = 0; c0 < NCH; c0 += 8) {
            u32x4 uu[8]; float am[8], bl[8];
#pragma unroll
            for (int q = 0; q < 8; ++q) { const int unit = bh * 32 + c0 + q; uu[q] = *(const u32x4*)(UT + (size_t)unit * 65536 + off); am[q] = UN[unit * 2]; bl[q] = UN[unit * 2 + 1]; }
#pragma unroll
            for (int q = 0; q < 8; ++q) {
                const int unit = bh * 32 + c0 + q; const float amax = am[q], blast = bl[q]; const u32x4 u = uu[q];
                const float f1 = __expf(m - amax);
                u32x4 o; o.x = pk2(C[0] * f1, C[1] * f1); o.y = pk2(C[2] * f1, C[3] * f1); o.z = pk2(C[4] * f1, C[5] * f1); o.w = pk2(C[6] * f1, C[7] * f1);
                *(u32x4*)(CT + (size_t)unit * 65536 + off) = o;
                const float mnew = blast + fmaxf(m, amax), d1 = __expf(blast + m - mnew), d2 = __expf(blast + amax - mnew);
                C[0] = d1 * C[0] + d2 * bflo(u.x); C[1] = d1 * C[1] + d2 * bfhi(u.x); C[2] = d1 * C[2] + d2 * bflo(u.y); C[3] = d1 * C[3] + d2 * bfhi(u.y);
                C[4] = d1 * C[4] + d2 * bflo(u.z); C[5] = d1 * C[5] + d2 * bfhi(u.z); C[6] = d1 * C[6] + d2 * bflo(u.w); C[7] = d1 * C[7] + d2 * bfhi(u.w);
                m = mnew;
            }
        }
    }
}
constexpr int RP = 1032;
__device__ void ph_wprime(const P& p, float* lds) {
    const int tid = otid();
    const float* mod = wsp<float>(p, WS_MOD); const float* wr = p.in[I_WR]; const float* gm = p.in[I_GMOE];
    bf16* img = wsp<bf16>(p, WS_WPR); float* cstg = (float*)(img + 4 * 2 * 32 * RP);
    for (int it = blockIdx.x; it < 128; it += gridDim.x) {
        const int b = it >> 5, e = it & 31; const float* sc = mod + b * DIN + 4096; const float* sh = mod + b * DIN + 3072;
        float a = 0.f;
#pragma unroll
        for (int q = 0; q < 2; ++q) { const int k = tid + q * 512; const float w = wr[k * 32 + e]; const float v = w * gm[k] * (1.f + sc[k]); const unsigned h = f2bf(v);
            img[((size_t)(b * 2 + 0) * 32 + e) * RP + k] = (bf16)h; img[((size_t)(b * 2 + 1) * 32 + e) * RP + k] = (bf16)f2bf(v - bf2f(h)); a += sh[k] * w; }
        a = wave_sum(a);
        if ((tid & 63) == 0) lds[tid >> 6] = a;
        __syncthreads();
        if (tid == 0) { float t = p.in[I_BR][e];
#pragma unroll
            for (int w = 0; w < 8; ++w) t += lds[w];
            cstg[b * 32 + e] = t; }
        __syncthreads();
    }
}
__device__ void ph_router(const P& p, float* lds) {
    const int tid = otid(), lane = tid & 63, wave = tid >> 6, tok = lane & 15, kg = lane >> 4;
    bf16* Wh = (bf16*)lds; bf16* Wl = Wh + 32 * RP;
    float* lg = lds + 33024 + wave * 512;
    float* cst = lds + 33024 + 4096;
    int* cnt = (int*)(cst + 32);
    float* rinv = cst + 64 + wave * 16;
    float* red = cst + 64 + 128;
    const float* X1 = wsp<float>(p, O_X1); const float* mod = wsp<float>(p, WS_MOD); unsigned char* HM = wsp<unsigned char>(p, O_HM);
    int* TOPI = wsp<int>(p, WS_TOPI); float* TOPW = wsp<float>(p, WS_TOPW); int* CNT = wsp<int>(p, WS_CNT);
    const float* wr = p.in[I_WR]; const float* gm = p.in[I_GMOE];
    for (int blk = blockIdx.x; blk < T / 128; blk += gridDim.x) {
        const int b = (blk * 128) / SEQ; const float* sc = mod + b * DIN + 4096; const float* sh = mod + b * DIN + 3072;
        { const u32x4* src = (const u32x4*)(wsp<bf16>(p, WS_WPR) + (size_t)b * 2 * 32 * RP); u32x4* dst = (u32x4*)Wh;
#pragma unroll
            for (int i = 0; i < 17; ++i) { const int idx = tid + i * 512; if (idx < 8256) dst[idx] = src[idx]; }
            if (tid < 32) { cst[tid] = ((const float*)(wsp<bf16>(p, WS_WPR) + 4 * 2 * 32 * RP))[b * 32 + tid]; cnt[tid] = 0; } }
        __syncthreads();
        const int tb = blk * 128 + wave * 16;
        {
            const float* xr = X1 + (size_t)(tb + tok) * DM + kg * 8;
            float rr;
            { const f32x4* sp = (const f32x4*)(wsp<float>(p, WS_SSQ) + (size_t)(tb + tok) * 16); const f32x4 a = sp[0], b4 = sp[1], c4 = sp[2], d4 = sp[3];
              const float ss = ((a.x + a.y) + (a.z + a.w)) + ((b4.x + b4.y) + (b4.z + b4.w)) + ((c4.x + c4.y) + (c4.z + c4.w)) + ((d4.x + d4.y) + (d4.z + d4.w));
              rr = rsqrtf(ss * (1.f / DM) + EPS); }
            if (kg == 0) rinv[tok] = rr;
            const float rs = rr * S_HM;
            unsigned char* ho = HM + (size_t)(tb + tok) * DM + kg * 8;
            f32x4 acc0 = {0.f, 0.f, 0.f, 0.f}, acc1 = {0.f, 0.f, 0.f, 0.f};
            const bf16* wh0 = Wh + tok * RP + kg * 8; const bf16* wl0 = Wl + tok * RP + kg * 8;
#pragma unroll 4
            for (int ks = 0; ks < 32; ++ks) {
                const f32x4 x0 = *(const f32x4*)(xr + ks * 32), x1 = *(const f32x4*)(xr + ks * 32 + 4);
                { const int k0 = ks * 32 + kg * 8;
                  const f32x4 g0 = *(const f32x4*)(gm + k0) * (1.f + *(const f32x4*)(sc + k0)), g1 = *(const f32x4*)(gm + k0 + 4) * (1.f + *(const f32x4*)(sc + k0 + 4));
                  const f32x4 h0 = x0 * rs * g0 + *(const f32x4*)(sh + k0) * S_HM, h1 = x1 * rs * g1 + *(const f32x4*)(sh + k0 + 4) * S_HM;
                  u32x2 w8; w8.x = pk4_fp8(h0.x, h0.y, h0.z, h0.w); w8.y = pk4_fp8(h1.x, h1.y, h1.z, h1.w); *(u32x2*)(ho + ks * 32) = w8; }
                u32x4 hw; hw.x = cvtpk(x0.x, x0.y); hw.y = cvtpk(x0.z, x0.w); hw.z = cvtpk(x1.x, x1.y); hw.w = cvtpk(x1.z, x1.w);
                u32x4 lw; lw.x = cvtpk(x0.x - bflo(hw.x), x0.y - bfhi(hw.x)); lw.y = cvtpk(x0.z - bflo(hw.y), x0.w - bfhi(hw.y));
                lw.z = cvtpk(x1.x - bflo(hw.z), x1.y - bfhi(hw.z)); lw.w = cvtpk(x1.z - bflo(hw.w), x1.w - bfhi(hw.w));
                const bf16x8v ah = __builtin_bit_cast(bf16x8v, hw), al = __builtin_bit_cast(bf16x8v, lw);
                const bf16x8v bh0 = *(const bf16x8v*)(wh0 + ks * 32), bl0 = *(const bf16x8v*)(wl0 + ks * 32);
                const bf16x8v bh1 = *(const bf16x8v*)(wh0 + 16 * RP + ks * 32), bl1 = *(const bf16x8v*)(wl0 + 16 * RP + ks * 32);
                acc0 = __builtin_amdgcn_mfma_f32_16x16x32_bf16(ah, bh0, acc0, 0, 0, 0); acc1 = __builtin_amdgcn_mfma_f32_16x16x32_bf16(ah, bh1, acc1, 0, 0, 0);
                acc0 = __builtin_amdgcn_mfma_f32_16x16x32_bf16(ah, bl0, acc0, 0, 0, 0); acc1 = __builtin_amdgcn_mfma_f32_16x16x32_bf16(ah, bl1, acc1, 0, 0, 0);
                acc0 = __builtin_amdgcn_mfma_f32_16x16x32_bf16(al, bh0, acc0, 0, 0, 0); acc1 = __builtin_amdgcn_mfma_f32_16x16x32_bf16(al, bh1, acc1, 0, 0, 0);
            }
#pragma unroll
            for (int r = 0; r < 4; ++r) { lg[(kg * 4 + r) * 32 + tok] = acc0[r]; lg[(kg * 4 + r) * 32 + 16 + tok] = acc1[r]; }
        }
        __builtin_amdgcn_s_waitcnt(0xc07f); asm volatile("" ::: "memory");
        if (lane < 16) {
            const float rr = rinv[lane]; float v[32];
#pragma unroll
            for (int e4 = 0; e4 < 8; ++e4) { const f32x4 t4 = *(const f32x4*)(lg + lane * 32 + e4 * 4), c4 = *(const f32x4*)(cst + e4 * 4);
                v[e4 * 4] = rr * t4.x + c4.x; v[e4 * 4 + 1] = rr * t4.y + c4.y; v[e4 * 4 + 2] = rr * t4.z + c4.z; v[e4 * 4 + 3] = rr * t4.w + c4.w; }
            float tv[4]; int ti[4];
#pragma unroll
            for (int k = 0; k < 4; ++k) { float m = v[0]; int idx = 0;
#pragma unroll
                for (int e = 1; e < 32; ++e) { if (v[e] > m) { m = v[e]; idx = e; } }
                tv[k] = m; ti[k] = idx;
#pragma unroll
                for (int e = 0; e < 32; ++e) if (e == idx) v[e] = -INFINITY; }
            const float e1 = __expf(tv[1] - tv[0]), e2 = __expf(tv[2] - tv[0]), e3 = __expf(tv[3] - tv[0]), inv = 1.f / (1.f + e1 + e2 + e3);
            const int t = tb + lane;
            *(int4*)(TOPI + t * 4) = make_int4(ti[0], ti[1], ti[2], ti[3]);
            *(f32x4*)(TOPW + t * 4) = (f32x4){inv, e1 * inv, e2 * inv, e3 * inv};
            atomicAdd(&cnt[ti[0]], 1); atomicAdd(&cnt[ti[1]], 1); atomicAdd(&cnt[ti[2]], 1); atomicAdd(&cnt[ti[3]], 1);
        }
        __syncthreads();
        if (tid < 32) CNT[blk * 32 + tid] = cnt[tid];
        __syncthreads();
    }
}
__device__ void ph_scatter(const P& p, float* lds) {
    const int tid = otid(), lane = tid & 63, wave = tid >> 6;
    int* tot = (int*)lds; int* pre = tot + 32; int* startp = tot + 64; int* wc = tot + 128;
    const int* CNT = wsp<int>(p, WS_CNT); const int* TOPI = wsp<int>(p, WS_TOPI);
    float* ROWW = wsp<float>(p, WS_ROWSLOT); int* TILEE = wsp<int>(p, WS_TILEE);
    int* ROWTOK = wsp<int>(p, WS_ROWTOK); int* POS = wsp<int>(p, WS_DEN); const float* TOPW = wsp<float>(p, WS_TOPW);
    for (int blk = blockIdx.x; blk < T / 128; blk += gridDim.x) {
        { const int e = tid & 31, g = tid >> 5; int a = 0, b = 0;
#pragma unroll
            for (int q = 0; q < 16; ++q) { const int j = g + 16 * q; const int c = CNT[j * 32 + e]; a += c; if (j < blk) b += c; }
            wc[g * 32 + e] = a; wc[512 + g * 32 + e] = b; }
        __syncthreads();
        if (tid < 32) { int a = 0, b = 0;
#pragma unroll
            for (int g = 0; g < 16; ++g) { a += wc[g * 32 + tid]; b += wc[512 + g * 32 + tid]; }
            tot[tid] = a; pre[tid] = b; }
        __syncthreads();
        if (tid == 0) { int s = 0; for (int e = 0; e < 32; ++e) { startp[e] = s; s += (tot[e] + 255) & ~255; } startp[32] = s; }
        __syncthreads();
        if (blk < 32) {
            const int e = blk, s0 = startp[e], s1 = startp[e + 1];
            if (blk == 0 && tid == 0) TILEE[MAXTILES] = startp[32] >> 8;
            for (int tl = (s0 >> 8) + tid; tl < (s1 >> 8); tl += 512) TILEE[tl] = e;
            for (int r = s0 + tot[e] + tid; r < s1; r += 512) { ROWW[r] = 0.f; ROWTOK[r] = 0; }
        }
        const int slot = blk * 512 + tid, e = TOPI[slot]; const float wgt = TOPW[slot];
        int lrank = 0;
        for (int ee = 0; ee < 32; ++ee) { const unsigned long long m = __ballot(e == ee);
            if (e == ee) lrank = __popcll(m & ((1ull << lane) - 1ull));
            if (lane == 0) wc[wave * 32 + ee] = __popcll(m); }
        __syncthreads();
        int base = startp[e] + pre[e] + lrank;
        for (int w = 0; w < wave; ++w) base += wc[w * 32 + e];
        __syncthreads();
        ROWW[base] = wgt; ROWTOK[base] = slot >> 2; POS[slot] = base;
        __syncthreads();
    }
}
__device__ void ph_final(const P& p) {
    const int tid = otid(), lane = tid & 63, gw = blockIdx.x * 8 + (tid >> 6), NGW = gridDim.x * 8;
    const float* X1 = wsp<float>(p, O_X1); const bf16* Y = wsp<bf16>(p, O_Y); const float* mod = wsp<float>(p, WS_MOD); const float* gf = p.in[I_GFIN];
    for (int t = gw; t < T; t += NGW) {
        const int b = t / SEQ; const float* gt2 = mod + b * DIN + 5120;
        const int4 p4 = *(const int4*)(wsp<int>(p, WS_DEN) + t * 4); const int pos[4] = {p4.x, p4.y, p4.z, p4.w};
        f32x4 v[2][2]; float s = 0.f;
#pragma unroll
        for (int j = 0; j < 2; ++j) {
            f32x4 a0 = {0.f, 0.f, 0.f, 0.f}, a1 = {0.f, 0.f, 0.f, 0.f};
#pragma unroll
            for (int k = 0; k < 4; ++k) { const u32x4 u = ((const u32x4*)(Y + (size_t)pos[k] * DM))[lane + 64 * j];
                a0.x += bflo(u.x); a0.y += bfhi(u.x); a0.z += bflo(u.y); a0.w += bfhi(u.y); a1.x += bflo(u.z); a1.y += bfhi(u.z); a1.z += bflo(u.w); a1.w += bfhi(u.w); }
            const f32x4* xr = (const f32x4*)(X1 + (size_t)t * DM) + 2 * lane + 128 * j; const f32x4* gr = (const f32x4*)gt2 + 2 * lane + 128 * j;
            v[j][0] = xr[0] + gr[0] * a0; v[j][1] = xr[1] + gr[1] * a1;
#pragma unroll
            for (int h = 0; h < 2; ++h) s += (v[j][h].x * v[j][h].x + v[j][h].y * v[j][h].y) + (v[j][h].z * v[j][h].z + v[j][h].w * v[j][h].w);
        }
        const float r = rsqrtf(wave_sum(s) * (1.f / DM) + EPS);
#pragma unroll
        for (int j = 0; j < 2; ++j)
#pragma unroll
            for (int h = 0; h < 2; ++h) ((f32x4*)(p.out + (size_t)t * DM))[2 * lane + 128 * j + h] = v[j][h] * r * ((const f32x4*)gf)[2 * lane + 128 * j + h];
    }
}
__device__ __forceinline__ void unit_dec(int unit, int& tok0, int& h) { const int b = unit >> 7; h = (unit >> 5) & 3; tok0 = b * SEQ + (unit & 31) * CH; }

namespace pg8 {
typedef short bf16x8 __attribute__((ext_vector_type(8)));
constexpr int BM = 256, BK = 64, HALF = 128, HTB = HALF * BK * 2, STAGE_BYTES = 8 * HTB, NXCD = 8, WGM = 8;
__host__ __device__ __forceinline__ int lds_byte(int r, int c) { const int st = (r >> 4) * 2 + (c >> 5), rr = r & 15, cc = c & 31, ob = rr * 64 + cc * 2; return st * 1024 + (ob ^ (((ob >> 9) & 1) << 5)); }
__host__ __device__ __forceinline__ void stage_rc(int b, int& R, int& C) { const int st = b / 1024, sb = b % 1024, swz = sb ^ (((sb >> 9) & 1) << 5); R = (st >> 1) * 16 + swz / 64; C = (st & 1) * 32 + (swz % 64) / 2; }
__host__ __device__ __forceinline__ int perm32(int rho) { const int n = rho >> 4, i = rho & 15; return 8 * (i >> 2) + 4 * n + (i & 3); }
struct Unit { const char* a0; const char* a1; const char* b0; const char* b1; int pm, pn; };
struct Gemm { int lda, ldb, nt, nth; const int* rowtok; };
__device__ __forceinline__ unsigned cvt_pk_bf16(float lo, float hi) { unsigned r; asm volatile("v_cvt_pk_bf16_f32 %0, %1, %2" : "=v"(r) : "v"(lo), "v"(hi)); return r; }
__device__ __forceinline__ u32x4 pack8(const f32x4 v0, const f32x4 v1) { u32x4 w; w.x = cvt_pk_bf16(v0[0], v0[1]); w.y = cvt_pk_bf16(v0[2], v0[3]); w.z = cvt_pk_bf16(v1[0], v1[1]); w.w = cvt_pk_bf16(v1[2], v1[3]); return w; }

typedef int v4i_t __attribute__((ext_vector_type(4))); typedef int v8i_t __attribute__((ext_vector_type(8)));
__device__ __forceinline__ v8i_t cat8(const bf16x8 a, const bf16x8 b) { return __builtin_shufflevector(__builtin_bit_cast(v4i_t, a), __builtin_bit_cast(v4i_t, b), 0, 1, 2, 3, 4, 5, 6, 7); }
template <class Epi, class Sched, bool ALIGN_EPI, bool SPLITK = false, bool GATHER = false, bool FP8 = false>
__device__ __forceinline__ void gemm_phase(LAS unsigned char* lds, const Gemm g, const Sched& S, const Epi& E) {
    const int tid = otid(), wid = __builtin_amdgcn_readfirstlane(tid >> 6), lane = tid & 63, wr = wid >> 2, wc = wid & 3, fr = lane & 15, fq = lane >> 4;
    const int nt = g.nt, nth = g.nth;
    unsigned voffA[2], voffB[2];
#pragma unroll
    for (int i = 0; i < 2; ++i) { int R, C; stage_rc(tid * 16 + i * 8192, R, C); const int Rb = Epi::PERM ? ((R & ~31) + perm32(R & 31)) : R;
        voffA[i] = (unsigned)(R * g.lda + C) * 2u; voffB[i] = (unsigned)(Rb * g.ldb + C) * 2u; }
    LAS int* rt = (LAS int*)(lds + 131072); unsigned vC[2][2], vP[2][2];
    if constexpr (GATHER) { Unit uu; for (int i = 0; S.next(i, uu); ++i) if (tid < 256) rt[i * 256 + tid] = g.rowtok[uu.pm * 256 + tid];
        asm volatile("s_waitcnt vmcnt(0) lgkmcnt(0)" ::: "memory"); __builtin_amdgcn_s_barrier(); asm volatile("" ::: "memory"); }
#define PG8_ROWS(dst, iu) do { const int _t = otid(); _Pragma("unroll") for (int _i = 0; _i < 2; ++_i) { int _R, _C; stage_rc(_t * 16 + _i * 8192, _R, _C); _Pragma("unroll") for (int _h = 0; _h < 2; ++_h) dst[_h][_i] = (unsigned)rt[(iu) * 256 + _h * 128 + _R] * (unsigned)(g.lda * 2) + (unsigned)_C * 2u; } } while (0)
#define PG8_STAGE_A(bufoff, gbase, h, V) do { if constexpr (GATHER) { PG8_STAGE(bufoff, gbase, V[h]); } else { PG8_STAGE(bufoff, (gbase) + (h) * hstepA, voffA); } } while (0)
#define PG8_STAGE_A2(bufoff, gbase, h) do { if constexpr (GATHER) { if (last) { PG8_STAGE(bufoff, gbase, vP[h]); } else { PG8_STAGE(bufoff, gbase, vC[h]); } } else { PG8_STAGE(bufoff, (gbase) + (h) * hstepA, voffA); } } while (0)
    const size_t kstep = (size_t)(BK * 2);
    const size_t hstepA = (size_t)HALF * g.lda * 2, hstepB = (size_t)HALF * g.ldb * 2;
    const unsigned ldsw = (unsigned)wid * 1024u;
    const int aoff = lds_byte(wr * 64 + fr, fq * 8), boff = lds_byte(wc * 32 + fr, fq * 8);
    const int one8 = 0x7f7f7f7f;
    constexpr int F2 = 1024;
#define PG8_SA(b, h) (((b) * 2 + (h)) * HTB)
#define PG8_SB(b, h) ((4 + (b) * 2 + (h)) * HTB)
#define PG8_STAGE(bufoff, gbase, voff) do { _Pragma("unroll") for (int _i = 0; _i < 2; ++_i) \
        __builtin_amdgcn_global_load_lds((const unsigned*)((const char*)(gbase) + (voff)[_i]), (LAS unsigned*)(lds + (bufoff) + ldsw + _i * 8192), 16, 0, 0); } while (0)
#define PG8_LDA(dst, b, h) do { _Pragma("unroll") for (int m = 0; m < 4; ++m) { dst[m][0] = *(const LAS bf16x8*)(lds + PG8_SA(b, h) + aoff + m * 2048); dst[m][1] = *(const LAS bf16x8*)(lds + PG8_SA(b, h) + aoff + F2 + m * 2048); } } while (0)
#define PG8_LDB(dst, b, h) do { _Pragma("unroll") for (int n = 0; n < 2; ++n) { dst[n][0] = *(const LAS bf16x8*)(lds + PG8_SB(b, h) + boff + n * 2048); dst[n][1] = *(const LAS bf16x8*)(lds + PG8_SB(b, h) + boff + F2 + n * 2048); } } while (0)
#define PG8_MMA(ai, bj, At, Bt) do { __builtin_amdgcn_s_setprio(1); _Pragma("unroll") for (int m = 0; m < 4; ++m) _Pragma("unroll") for (int n = 0; n < 2; ++n) { \
        if constexpr (FP8) { const v8i_t b8_ = cat8(Bt[n][0], Bt[n][1]), a8_ = cat8(At[m][0], At[m][1]); asm volatile("v_mfma_scale_f32_16x16x128_f8f6f4 %0, %1, %2, %0, %3, %3 op_sel_hi:[0,0,0]" : "+v"(acc[ai][bj][m][n]) : "v"(b8_), "v"(a8_), "v"(one8)); } \
        else { _Pragma("unroll") for (int k = 0; k < 2; ++k) acc[ai][bj][m][n] = __builtin_amdgcn_mfma_f32_16x16x32_bf16(Bt[n][k], At[m][k], acc[ai][bj][m][n], 0, 0, 0); } } __builtin_amdgcn_s_setprio(0); } while (0)
#define PG8_WAIT_V(n) asm volatile("s_waitcnt vmcnt(" #n ")" ::: "memory")
#define PG8_WAIT_L(n) asm volatile("s_waitcnt lgkmcnt(" #n ")" ::: "memory")
#define PG8_BAR __builtin_amdgcn_s_barrier()
#define PG8_SCHED __builtin_amdgcn_sched_barrier(0)
    Unit cur, nxt; int ui = 0;
    if (!S.next(0, cur)) return;
    f32x4 acc[2][2][4][2];
#pragma unroll
    for (int a = 0; a < 2; ++a)
#pragma unroll
        for (int b = 0; b < 2; ++b)
#pragma unroll
            for (int m = 0; m < 4; ++m)
#pragma unroll
                for (int n = 0; n < 2; ++n) acc[a][b][m][n] = (f32x4){0.f, 0.f, 0.f, 0.f};
    bf16x8 At[4][2], B0[2][2], B1[2][2];
    {
        const char* cA = cur.a0; const char* cB = cur.b0;
        if constexpr (GATHER) { PG8_ROWS(vC, 0); }
        PG8_STAGE(PG8_SB(0, 0), cB, voffB); PG8_STAGE(PG8_SB(0, 1), cB + hstepB, voffB); PG8_STAGE_A(PG8_SA(0, 0), cA, 0, vC); PG8_STAGE_A(PG8_SA(0, 1), cA, 1, vC);
        if (wr == 1) PG8_BAR;
        PG8_WAIT_V(2); PG8_BAR;
        PG8_STAGE(PG8_SB(1, 0), cB + kstep, voffB); PG8_STAGE_A(PG8_SA(1, 0), cA + kstep, 0, vC); PG8_STAGE(PG8_SB(1, 1), cB + hstepB + kstep, voffB);
        PG8_WAIT_V(6); PG8_BAR;
    }
    for (;;) {
        const bool has_next = S.next(ui + 1, nxt);
        const char* nA = has_next ? nxt.a0 : cur.a0; const char* nB = has_next ? nxt.b0 : cur.b0;
        if constexpr (GATHER) { PG8_ROWS(vP, has_next ? ui + 1 : ui); }
#pragma unroll 1
        for (int t = 0; t < nt; t += 2) {
            const bool last = (t == nt - 2);
            const char *a1, *a2, *b2;
            if constexpr (SPLITK) {
                a1 = (t + 1 < nth) ? cur.a0 + (size_t)(t + 1) * kstep : cur.a1 + (size_t)(t + 1 - nth) * kstep;
                a2 = last ? nA : ((t + 2 < nth) ? cur.a0 + (size_t)(t + 2) * kstep : cur.a1 + (size_t)(t + 2 - nth) * kstep);
                b2 = last ? nB : ((t + 2 < nth) ? cur.b0 + (size_t)(t + 2) * kstep : cur.b1 + (size_t)(t + 2 - nth) * kstep);
            } else {
                a1 = cur.a0 + (size_t)(t + 1) * kstep; a2 = last ? nA : cur.a0 + (size_t)(t + 2) * kstep; b2 = last ? nB : cur.b0 + (size_t)(t + 2) * kstep;
            }
            const char* a3 = a2 + kstep; const char* b3 = b2 + kstep;
            PG8_LDB(B0, 0, 0); PG8_LDB(B1, 0, 1); PG8_SCHED; PG8_LDA(At, 0, 0); PG8_STAGE_A(PG8_SA(1, 1), a1, 1, vC);
            if constexpr (GATHER) { if (last) { _Pragma("unroll") for (int _h = 0; _h < 2; ++_h) _Pragma("unroll") for (int _i = 0; _i < 2; ++_i) vC[_h][_i] = vP[_h][_i]; } }
            PG8_WAIT_V(8); PG8_WAIT_L(0); PG8_BAR; PG8_MMA(0, 0, At, B0); PG8_MMA(0, 1, At, B1); PG8_BAR; PG8_SCHED;
            PG8_LDA(At, 0, 1); PG8_STAGE(PG8_SB(0, 0), b2, voffB); PG8_STAGE(PG8_SB(0, 1), b2 + hstepB, voffB); PG8_STAGE_A(PG8_SA(0, 0), a2, 0, vC);
            PG8_WAIT_V(8); PG8_WAIT_L(0); PG8_BAR; PG8_MMA(1, 0, At, B0); PG8_MMA(1, 1, At, B1); PG8_BAR; PG8_SCHED;
            PG8_LDB(B0, 1, 0); PG8_LDB(B1, 1, 1); PG8_SCHED; PG8_LDA(At, 1, 0); PG8_STAGE_A(PG8_SA(0, 1), a2, 1, vC);
            PG8_WAIT_V(8); PG8_WAIT_L(0); PG8_BAR; PG8_MMA(0, 0, At, B0); PG8_MMA(0, 1, At, B1); PG8_BAR; PG8_SCHED;
            PG8_LDA(At, 1, 1); PG8_STAGE(PG8_SB(1, 0), b3, voffB); PG8_STAGE(PG8_SB(1, 1), b3 + hstepB, voffB); PG8_STAGE_A(PG8_SA(1, 0), a3, 0, vC);
            PG8_WAIT_V(8); PG8_WAIT_L(0); PG8_BAR; PG8_MMA(1, 0, At, B0); PG8_MMA(1, 1, At, B1); PG8_BAR; PG8_SCHED;
        }
        if constexpr (FP8) asm volatile("s_nop 15\n\ts_nop 15" ::: "memory");
        if constexpr (ALIGN_EPI) { if (wr == 0) PG8_BAR; }
        { int fr_ = fr, fq_ = fq; asm volatile("" : "+v"(fr_), "+v"(fq_)); E(acc, cur, wr, wc, fr_, fq_, lds); }
        if (!has_next) break;
#pragma unroll
        for (int a = 0; a < 2; ++a)
#pragma unroll
            for (int b = 0; b < 2; ++b)
#pragma unroll
                for (int m = 0; m < 4; ++m)
#pragma unroll
                    for (int n = 0; n < 2; ++n) acc[a][b][m][n] = (f32x4){0.f, 0.f, 0.f, 0.f};
        cur = nxt; ++ui;
        if constexpr (GATHER) {
#pragma unroll
            for (int _h = 0; _h < 2; ++_h)
#pragma unroll
                for (int _i = 0; _i < 2; ++_i) vC[_h][_i] = vP[_h][_i]; }
        if constexpr (ALIGN_EPI) { if (wr == 1) PG8_BAR; }
    }
    PG8_WAIT_V(0);
    if constexpr (!ALIGN_EPI) { if (wr == 0) PG8_BAR; }
    PG8_BAR;
#undef PG8_SA
#undef PG8_SB
#undef PG8_STAGE
#undef PG8_STAGE_A
#undef PG8_STAGE_A2
#undef PG8_ROWS
#undef PG8_LDA
#undef PG8_LDB
#undef PG8_MMA
#undef PG8_WAIT_V
#undef PG8_WAIT_L
#undef PG8_BAR
#undef PG8_SCHED
}
struct DenseOrder {
    int nM, nN, nwg, G, c; const char* A; const char* B; size_t tA, tB;
    __device__ void init(int nM_, int nN_, int G_, int c_, const void* A_, int lda, const void* B_, int ldb) { nM = nM_; nN = nN_; nwg = nM * nN; G = G_; c = c_; A = (const char*)A_; B = (const char*)B_; tA = (size_t)BM * lda * 2; tB = (size_t)BM * ldb * 2; }
    __device__ __forceinline__ bool tile(int i, int& pm, int& pn) const {
        const long L = (long)i * G + c; if (L >= nwg) return false;
        int wgid = (int)L; { const int q = nwg / NXCD, r = nwg % NXCD, xcd = wgid % NXCD, off = wgid / NXCD; wgid = (xcd < r ? xcd * (q + 1) : r * (q + 1) + (xcd - r) * q) + off; }
        const int nig = WGM * nN, gid = wgid / nig, fm = gid * WGM, gsz = (nM - fm) < WGM ? (nM - fm) : WGM;
        pm = fm + ((wgid % nig) % gsz); pn = (wgid % nig) / gsz; return true;
    }
    __device__ __forceinline__ bool next(int i, Unit& u) const { int pm, pn; if (!tile(i, pm, pn)) return false; u.pm = pm; u.pn = pn; u.a0 = A + pm * tA; u.b0 = B + pn * tB; u.a1 = u.a0; u.b1 = u.b0; return true; }
};
struct MoeOrder : DenseOrder {
    const LAS int* tile_e; bool gather;
    __device__ __forceinline__ bool next(int i, Unit& u) const { int pm, pn; if (!tile(i, pm, pn)) return false; const int e = tile_e[pm];
        u.pm = pm; u.pn = pn; u.a0 = gather ? A : A + pm * tA; u.b0 = B + ((size_t)e * nN + pn) * tB; u.a1 = u.a0; u.b1 = u.b0; return true; }
};
template <int KIND> struct BatchOrder {
    int G, c; const char* ws;
    __device__ __forceinline__ bool next(int i, Unit& u) const {
        const int unit = i * G + c; if (unit >= NUNIT) return false;
        int t0, h; unit_dec(unit, t0, h); const size_t rowoff = ((size_t)t0 * DM + h * 256) * 2, uoff = (size_t)unit * 131072;
        u.pm = unit; u.pn = 0;
        if (KIND == 0) { u.a0 = ws + O_VT + uoff; u.b0 = ws + O_KWT + uoff; u.a1 = u.a0; u.b1 = u.b0; }
        else if (KIND == 1) { u.a0 = ws + O_Q + rowoff; u.b0 = ws + O_K + rowoff; u.a1 = u.a0; u.b1 = u.b0; }
        else { u.a0 = ws + O_SP + rowoff; u.a1 = ws + O_Q + rowoff; u.b0 = ws + O_VT + uoff; u.b1 = ws + O_CT + uoff; }
        return true;
    }
};
__device__ __forceinline__ f32x4 sig4(const f32x4 v) { f32x4 r; r[0] = sigm(v[0]); r[1] = sigm(v[1]); r[2] = sigm(v[2]); r[3] = sigm(v[3]); return r; }
__device__ __forceinline__ f32x4 lo4(const u32x4 w) { return (f32x4){bflo(w.x), bfhi(w.x), bflo(w.y), bfhi(w.y)}; }
__device__ __forceinline__ f32x4 hi4(const u32x4 w) { return (f32x4){bflo(w.z), bfhi(w.z), bflo(w.w), bfhi(w.w)}; }
typedef f32x4 Acc[2][2][4][2];
struct EpiIn {
    static constexpr bool PERM = true; unsigned char* ws;
    __device__ __forceinline__ void operator()(const Acc& acc, const Unit& u, int wr, int wc, int fr, int fq, LAS unsigned char*) const {
        const int row0 = u.pm * BM + wr * 64 + fr;
        if (u.pn < 8) {
            bf16* O = (bf16*)(ws + O_U1) + u.pn * 128 + wc * 32 + 8 * fq;
#pragma unroll
            for (int ai = 0; ai < 2; ++ai)
#pragma unroll
                for (int m = 0; m < 4; ++m) { const f32x4 v0 = acc[ai][0][m][0] * sig4(acc[ai][1][m][0]), v1 = acc[ai][0][m][1] * sig4(acc[ai][1][m][1]);
                    *(u32x4*)(O + (size_t)(row0 + ai * HALF + m * 16) * DM) = pack8(v0, v1); }
        } else {
            const int t = (u.pn - 8) >> 2; const size_t so = t == 0 ? O_XM : t == 1 ? O_SO : t == 2 ? O_SZA : O_SZB;
            bf16* O = (bf16*)(ws + so) + ((u.pn - 8) & 3) * 256 + wc * 32 + 8 * fq;
#pragma unroll
            for (int ai = 0; ai < 2; ++ai)
#pragma unroll
                for (int m = 0; m < 4; ++m)
#pragma unroll
                    for (int bj = 0; bj < 2; ++bj) { f32x4 v0 = acc[ai][bj][m][0], v1 = acc[ai][bj][m][1]; if (t > 0) { v0 = sig4(v0); v1 = sig4(v1); }
                        *(u32x4*)(O + (size_t)(row0 + ai * HALF + m * 16) * DM + bj * HALF) = pack8(v0, v1); }
        }
    }
};
struct EpiPw {
    static constexpr bool PERM = true; unsigned char* ws; const float* bias;
    __device__ __forceinline__ void operator()(const Acc& acc, const Unit& u, int wr, int wc, int fr, int fq, LAS unsigned char*) const {
        const int row0 = u.pm * BM + wr * 64 + fr, col0 = u.pn * BM + wc * 32 + 8 * fq;
        f32x4 bb[2][2];
#pragma unroll
        for (int bj = 0; bj < 2; ++bj) { bb[bj][0] = *(const f32x4*)(bias + col0 + bj * HALF); bb[bj][1] = *(const f32x4*)(bias + col0 + bj * HALF + 4); }
#pragma unroll
        for (int ai = 0; ai < 2; ++ai) {
            u32x4 z[4][2];
#pragma unroll
            for (int m = 0; m < 4; ++m)
#pragma unroll
                for (int bj = 0; bj < 2; ++bj) z[m][bj] = *(const u32x4*)((const bf16*)(ws + O_SZA) + (size_t)(row0 + ai * HALF + m * 16) * DM + col0 + bj * HALF);
            asm volatile("" ::: "memory");
#pragma unroll
            for (int m = 0; m < 4; ++m)
#pragma unroll
                for (int bj = 0; bj < 2; ++bj) { const size_t o = (size_t)(row0 + ai * HALF + m * 16) * DM + col0 + bj * HALF;
                    *(u32x4*)((bf16*)(ws + O_YAG) + o) = pack8(lo4(z[m][bj]) * (acc[ai][bj][m][0] + bb[bj][0]), hi4(z[m][bj]) * (acc[ai][bj][m][1] + bb[bj][1])); }
            asm volatile("" ::: "memory");
        }
    }
};
struct EpiMo {
    static constexpr bool PERM = true; unsigned char* ws;
    __device__ __forceinline__ void operator()(const Acc& acc, const Unit& u, int wr, int wc, int fr, int fq, LAS unsigned char*) const {
        const int row0 = u.pm * BM + wr * 64 + fr, col0 = u.pn * BM + wc * 32 + 8 * fq;
#pragma unroll
        for (int am = 0; am < 4; ++am) {
            const int ai = am >> 1;
            u32x4 z[2][2], y[2][2];
#pragma unroll
            for (int mm = 0; mm < 2; ++mm)
#pragma unroll
                for (int bj = 0; bj < 2; ++bj) { const size_t o = (size_t)(row0 + ai * HALF + ((am & 1) * 2 + mm) * 16) * DM + col0 + bj * HALF;
                    z[mm][bj] = *(const u32x4*)((const bf16*)(ws + O_SZB) + o); y[mm][bj] = *(const u32x4*)((const bf16*)(ws + O_YAG) + o); }
            asm volatile("" ::: "memory");
#pragma unroll
            for (int mm = 0; mm < 2; ++mm)
#pragma unroll
                for (int bj = 0; bj < 2; ++bj) { const int m = (am & 1) * 2 + mm; const size_t o = (size_t)(row0 + ai * HALF + m * 16) * DM + col0 + bj * HALF;
                    *(u32x4*)((bf16*)(ws + O_MERGED) + o) = pack8(lo4(y[mm][bj]) + lo4(z[mm][bj]) * acc[ai][bj][m][0], hi4(y[mm][bj]) + hi4(z[mm][bj]) * acc[ai][bj][m][1]); }
            asm volatile("" ::: "memory");
        }
    }
};
struct EpiOut {
    static constexpr bool PERM = false; unsigned char* ws; const float* x;
    __device__ __forceinline__ void operator()(const Acc& acc, const Unit& u, int wr, int wc, int fr, int fq, LAS unsigned char*) const {
        const int row0 = u.pm * BM + wr * 64 + fr, col0 = u.pn * BM + wc * 32 + 4 * fq, b = (u.pm * BM) / SEQ;
        const float* gt = (const float*)(ws + WS_MOD) + b * DIN + 2048; float* X1 = (float*)(ws + O_X1); float* ssq = (float*)(ws + WS_SSQ);
        f32x4 gv[2][2];
#pragma unroll
        for (int bj = 0; bj < 2; ++bj)
#pragma unroll
            for (int n = 0; n < 2; ++n) gv[bj][n] = *(const f32x4*)(gt + col0 + bj * HALF + n * 16);
#pragma unroll
        for (int am = 0; am < 4; ++am) {
            const int ai = am >> 1;
            f32x4 xr[2][2][2]; float sq[2] = {0.f, 0.f};
#pragma unroll
            for (int mm = 0; mm < 2; ++mm)
#pragma unroll
                for (int bj = 0; bj < 2; ++bj)
#pragma unroll
                    for (int n = 0; n < 2; ++n) xr[mm][bj][n] = *(const f32x4*)(x + (size_t)(row0 + ai * HALF + ((am & 1) * 2 + mm) * 16) * DM + col0 + bj * HALF + n * 16);
            asm volatile("" ::: "memory");
#pragma unroll
            for (int mm = 0; mm < 2; ++mm)
#pragma unroll
                for (int bj = 0; bj < 2; ++bj)
#pragma unroll
                    for (int n = 0; n < 2; ++n) { const int m = (am & 1) * 2 + mm; const f32x4 v = xr[mm][bj][n] + gv[bj][n] * acc[ai][bj][m][n];
                        *(f32x4*)(X1 + (size_t)(row0 + ai * HALF + m * 16) * DM + col0 + bj * HALF + n * 16) = v; sq[mm] += (v[0] * v[0] + v[1] * v[1]) + (v[2] * v[2] + v[3] * v[3]); }
#pragma unroll
            for (int mm = 0; mm < 2; ++mm) { float q = sq[mm]; q += __shfl_xor(q, 16); q += __shfl_xor(q, 32);
                if (fq == 0) ssq[(size_t)(row0 + ai * HALF + ((am & 1) * 2 + mm) * 16) * 16 + u.pn * 4 + wc] = q; }
            asm volatile("" ::: "memory");
        }
    }
};
struct EpiU {
    static constexpr bool PERM = true; unsigned char* ws;
    __device__ __forceinline__ void operator()(const Acc& acc, const Unit& u, int wr, int wc, int fr, int fq, LAS unsigned char*) const {
        bf16* O = (bf16*)(ws + O_UT) + (size_t)u.pm * 65536 + (wr * 64 + fr) * 256 + wc * 32 + 8 * fq;
#pragma unroll
        for (int ai = 0; ai < 2; ++ai)
#pragma unroll
            for (int m = 0; m < 4; ++m)
#pragma unroll
                for (int bj = 0; bj < 2; ++bj) *(u32x4*)(O + (ai * HALF + m * 16) * 256 + bj * HALF) = pack8(acc[ai][bj][m][0], acc[ai][bj][m][1]);
    }
};
struct EpiS {
    static constexpr bool PERM = true; unsigned char* ws;
    __device__ __forceinline__ void operator()(const Acc& acc, const Unit& u, int wr, int wc, int fr, int fq, LAS unsigned char*) const {
        int t0, h; unit_dec(u.pm, t0, h);
        const int r0 = wr * 64 + fr, c0 = wc * 32 + 8 * fq;
        const float* cw = (const float*)(ws + WS_CW) + u.pm * 256 + c0; float* denp = (float*)(ws + WS_DENP) + (size_t)u.pm * 1024;
        bf16* O = (bf16*)(ws + O_SP) + (size_t)t0 * DM + h * 256 + c0;
        f32x4 w[2][2];
#pragma unroll
        for (int bj = 0; bj < 2; ++bj)
#pragma unroll
            for (int n = 0; n < 2; ++n) w[bj][n] = *(const f32x4*)(cw + bj * HALF + 4 * n);
#pragma unroll
        for (int ai = 0; ai < 2; ++ai)
#pragma unroll
            for (int m = 0; m < 4; ++m) { const int r = r0 + ai * HALF + m * 16; float rs = 0.f;
#pragma unroll
                for (int bj = 0; bj < 2; ++bj) { f32x4 v[2];
#pragma unroll
                    for (int n = 0; n < 2; ++n) { v[n] = acc[ai][bj][m][n] * w[bj][n]; const int c = c0 + bj * HALF + 4 * n;
#pragma unroll
                        for (int j = 0; j < 4; ++j) { if (c + j > r) v[n][j] = 0.f; rs += v[n][j]; } }
                    *(u32x4*)(O + (size_t)r * DM + bj * HALF) = pack8(v[0], v[1]); }
                rs += __shfl_xor(rs, 16); rs += __shfl_xor(rs, 32);
                if (fq == 0) denp[r * 4 + wc] = rs;
                asm volatile("" ::: "memory"); }
    }
};
struct EpiO {
    static constexpr bool PERM = true; unsigned char* ws; const float* hng; const float* skip;
    __device__ __forceinline__ void operator()(Acc& acc, const Unit& u, int wr, int wc, int fr, int fq, LAS unsigned char* lds) const {
        int t0, h; unit_dec(u.pm, t0, h);
        LAS float* inv = (LAS float*)(lds + 131072);
        LAS float* PS = inv + 256;
        LAS float* nsl = PS + 2048;
        const int tid = otid();
        const int r0 = wr * 64 + fr, c0 = wc * 32 + 8 * fq;
        if (tid < 256) {
            const f32x4 dp = *(const f32x4*)((const float*)(ws + WS_DENP) + (size_t)u.pm * 1024 + tid * 4); const float fl = ((const float*)(ws + WS_FLOOR))[u.pm * 256 + tid];
            const float den = nsl[((u.pm - (int)blockIdx.x) / (int)gridDim.x) * 256 + tid] + (dp[0] + dp[1]) + (dp[2] + dp[3]);
            inv[tid] = __builtin_amdgcn_rcpf(fmaxf(fabsf(den), fl)); }
        u32x4 gin[4][2];
        asm volatile("s_waitcnt lgkmcnt(0)" ::: "memory"); __builtin_amdgcn_s_barrier(); asm volatile("" ::: "memory");
#pragma unroll
        for (int ai = 0; ai < 2; ++ai) {
#pragma unroll
            for (int m = 0; m < 4; ++m)
#pragma unroll
                for (int bj = 0; bj < 2; ++bj) gin[m][bj] = *(const u32x4*)((const bf16*)(ws + O_SO) + (size_t)(t0 + r0 + ai * HALF + m * 16) * DM + h * 256 + c0 + bj * HALF);
            asm volatile("" ::: "memory");
#pragma unroll
            for (int m = 0; m < 4; ++m) { const int r = r0 + ai * HALF + m * 16; const float iv = inv[r]; float s = 0.f, q = 0.f;
#pragma unroll
                for (int bj = 0; bj < 2; ++bj) { const u32x4 so = gin[m][bj];
                    const f32x4 v0 = acc[ai][bj][m][0] * iv * lo4(so), v1 = acc[ai][bj][m][1] * iv * hi4(so); acc[ai][bj][m][0] = v0; acc[ai][bj][m][1] = v1;
                    s += (v0[0] + v0[1]) + (v0[2] + v0[3]) + (v1[0] + v1[1]) + (v1[2] + v1[3]);
                    q += (v0[0] * v0[0] + v0[1] * v0[1]) + (v0[2] * v0[2] + v0[3] * v0[3]) + (v1[0] * v1[0] + v1[1] * v1[1]) + (v1[2] * v1[2] + v1[3] * v1[3]); }
                s += __shfl_xor(s, 16); s += __shfl_xor(s, 32); q += __shfl_xor(q, 16); q += __shfl_xor(q, 32);
                if (fq == 0) { PS[(r * 4 + wc) * 2] = s; PS[(r * 4 + wc) * 2 + 1] = q; } }
            asm volatile("" ::: "memory");
        }
        asm volatile("s_waitcnt lgkmcnt(0)" ::: "memory"); __builtin_amdgcn_s_barrier(); asm volatile("" ::: "memory");
#pragma unroll
        for (int ai = 0; ai < 2; ++ai) {
#pragma unroll
            for (int m = 0; m < 4; ++m)
#pragma unroll
                for (int bj = 0; bj < 2; ++bj) gin[m][bj] = *(const u32x4*)((const bf16*)(ws + O_XC) + (size_t)(t0 + r0 + ai * HALF + m * 16) * DM + h * 256 + c0 + bj * HALF);
            asm volatile("" ::: "memory");
#pragma unroll
            for (int m = 0; m < 4; ++m) { const int r = r0 + ai * HALF + m * 16;
                const f32x4 p0 = *(const LAS f32x4*)(PS + r * 8), p1 = *(const LAS f32x4*)(PS + r * 8 + 4);
                const float mu = ((p0[0] + p0[2]) + (p1[0] + p1[2])) * (1.f / 256.f), ex2 = ((p0[1] + p0[3]) + (p1[1] + p1[3])) * (1.f / 256.f), rs = rsqrtf(fmaxf(ex2 - mu * mu, 0.f) + EPS);
#pragma unroll
                for (int bj = 0; bj < 2; ++bj) { const size_t o = (size_t)(t0 + r) * DM + h * 256 + c0 + bj * HALF; const u32x4 xc = gin[m][bj];
                    const float* gp = hng + h * 256 + c0 + bj * HALF; const float* sp_ = skip + h * 256 + c0 + bj * HALF;
                    const f32x4 v0 = (acc[ai][bj][m][0] - mu) * rs * *(const f32x4*)gp + *(const f32x4*)sp_ * lo4(xc), v1 = (acc[ai][bj][m][1] - mu) * rs * *(const f32x4*)(gp + 4) + *(const f32x4*)(sp_ + 4) * hi4(xc);
                    *(u32x4*)((bf16*)(ws + O_MOIN) + o) = pack8(v0, v1); } }
            asm volatile("" ::: "memory");
        }
        asm volatile("s_waitcnt lgkmcnt(0)" ::: "memory"); __builtin_amdgcn_s_barrier(); asm volatile("" ::: "memory");
    }
};
struct EpiGu {
    static constexpr bool PERM = true; unsigned char* ws; const float* bgu;
    __device__ __forceinline__ void operator()(const Acc& acc, const Unit& u, int wr, int wc, int fr, int fq, LAS unsigned char* lds_) const {
        const int e = ((const LAS int*)(lds_ + 148480))[u.pm]; const int ch0 = u.pn * 128 + wc * 32 + 8 * fq;
        const float* bb = bgu + e * 2048 + ch0;
        const f32x4 bg0 = *(const f32x4*)(bb), bg1 = *(const f32x4*)(bb + 4), bu0 = *(const f32x4*)(bb + 1024), bu1 = *(const f32x4*)(bb + 1028);
        unsigned char* O = ws + O_ACT + (size_t)(u.pm * BM + wr * 64 + fr) * KP8 + ch0;
        constexpr float ds = 1.f / (S_HM * S_W);
#pragma unroll
        for (int ai = 0; ai < 2; ++ai)
#pragma unroll
            for (int m = 0; m < 4; ++m) { f32x4 v[2];
#pragma unroll
                for (int n = 0; n < 2; ++n) { const f32x4 gt = acc[ai][0][m][n] * ds + (n ? bg1 : bg0), up = acc[ai][1][m][n] * ds + (n ? bu1 : bu0);
#pragma unroll
                    for (int j = 0; j < 4; ++j) { const float gg = fminf(gt[j], 7.f), uu = __builtin_amdgcn_fmed3f(up[j], -7.f, 7.f);
                        const float sg = __builtin_amdgcn_rcpf(1.f + __builtin_amdgcn_exp2f(gg * (-1.702f * 1.4426950408889634f)));
                        v[n][j] = (uu * S_ACT + S_ACT) * (gg * sg); } }
                u32x2 w8; w8.x = pk4_fp8_nc(v[0][0], v[0][1], v[0][2], v[0][3]); w8.y = pk4_fp8_nc(v[1][0], v[1][1], v[1][2], v[1][3]);
                *(u32x2*)(O + (size_t)(ai * HALF + m * 16) * KP8) = w8; }
    }
};
struct EpiDn {
    static constexpr bool PERM = true; unsigned char* ws; const float* bdn;
    __device__ __forceinline__ void operator()(const Acc& acc, const Unit& u, int wr, int wc, int fr, int fq, LAS unsigned char* lds_) const {
        const int e = ((const LAS int*)(lds_ + 148480))[u.pm]; const int col0 = u.pn * BM + wc * 32 + 8 * fq, row0 = u.pm * BM + wr * 64 + fr;
        const float* roww = (const float*)(ws + WS_ROWSLOT); bf16* Y = (bf16*)(ws + O_Y);
        float w[2][4];
#pragma unroll
        for (int ai = 0; ai < 2; ++ai)
#pragma unroll
            for (int m = 0; m < 4; ++m) w[ai][m] = roww[row0 + ai * HALF + m * 16];
        f32x4 b[2][2];
#pragma unroll
        for (int bj = 0; bj < 2; ++bj)
#pragma unroll
            for (int n = 0; n < 2; ++n) b[bj][n] = *(const f32x4*)(bdn + e * DM + col0 + bj * HALF + 4 * n);
        asm volatile("" ::: "memory");
#pragma unroll
        for (int ai = 0; ai < 2; ++ai)
#pragma unroll
            for (int m = 0; m < 4; ++m)
#pragma unroll
                for (int bj = 0; bj < 2; ++bj) *(u32x4*)(Y + (size_t)(row0 + ai * HALF + m * 16) * DM + col0 + bj * HALF) = pack8((acc[ai][bj][m][0] * (1.f / (S_ACT * S_W)) + b[bj][0]) * w[ai][m], (acc[ai][bj][m][1] * (1.f / (S_ACT * S_W)) + b[bj][1]) * w[ai][m]);
    }
};
}


__device__ __forceinline__ void ph_g_in(const P& p, LAS unsigned char* lds) {
    pg8::Gemm g{DM, DM, 16, 16, nullptr}; pg8::DenseOrder S; S.init(T / 256, DIN / 256, gridDim.x, blockIdx.x, p.ws + O_HA, DM, p.ws + WS_WIN, DM);
    pg8::EpiIn E{p.ws}; pg8::gemm_phase<pg8::EpiIn, pg8::DenseOrder, true>(lds, g, S, E);
}
__device__ __forceinline__ void ph_g_pw(const P& p, LAS unsigned char* lds) {
    pg8::Gemm g{DM, DM, 16, 16, nullptr}; pg8::DenseOrder S; S.init(T / 256, 4, gridDim.x, blockIdx.x, p.ws + O_YAPRE, DM, p.ws + WS_WPW, DM);
    pg8::EpiPw E{p.ws, p.in[I_BPW]}; pg8::gemm_phase<pg8::EpiPw, pg8::DenseOrder, true>(lds, g, S, E);
}
__device__ __forceinline__ void ph_g_mo(const P& p, LAS unsigned char* lds) {
    pg8::Gemm g{DM, DM, 16, 16, nullptr}; pg8::DenseOrder S; S.init(T / 256, 4, gridDim.x, blockIdx.x, p.ws + O_MOIN, DM, p.ws + WS_WMO, DM);
    pg8::EpiMo E{p.ws}; pg8::gemm_phase<pg8::EpiMo, pg8::DenseOrder, true>(lds, g, S, E);
}
__device__ __forceinline__ void ph_g_out(const P& p, LAS unsigned char* lds) {
    pg8::Gemm g{DM, DM, 16, 16, nullptr}; pg8::DenseOrder S; S.init(T / 256, 4, gridDim.x, blockIdx.x, p.ws + O_MERGED, DM, p.ws + WS_WOUT, DM);
    pg8::EpiOut E{p.ws, p.in[I_X]}; pg8::gemm_phase<pg8::EpiOut, pg8::DenseOrder, true>(lds, g, S, E);
}
__device__ __forceinline__ void ph_g_u(const P& p, LAS unsigned char* lds) {
    pg8::Gemm g{256, 256, 4, 4, nullptr}; pg8::BatchOrder<0> S{(int)gridDim.x, (int)blockIdx.x, (const char*)p.ws};
    pg8::EpiU E{p.ws}; pg8::gemm_phase<pg8::EpiU, pg8::BatchOrder<0>, true>(lds, g, S, E);
}
__device__ __forceinline__ void ph_g_s(const P& p, LAS unsigned char* lds) {
    pg8::Gemm g{DM, DM, 4, 4, nullptr}; pg8::BatchOrder<1> S{(int)gridDim.x, (int)blockIdx.x, (const char*)p.ws};
    pg8::EpiS E{p.ws}; pg8::gemm_phase<pg8::EpiS, pg8::BatchOrder<1>, true>(lds, g, S, E);
}
__device__ __forceinline__ void g_o_qn(const P& p, LAS unsigned char* lds) {
    const int tid = otid(), lane = tid & 63, wave = tid >> 6;
    LAS float* qn = (LAS float*)(lds + 131072) + 256 + 2048;
    int ui = 0;
    for (int unit = blockIdx.x; unit < NUNIT; unit += gridDim.x, ++ui) {
        int t0, h; unit_dec(unit, t0, h);
        const f32x4 n4 = ((const f32x4*)(wsp<float>(p, WS_NS) + unit * 256))[lane];
        const bf16* q = wsp<bf16>(p, O_Q) + (size_t)(t0 + wave * 32) * DM + h * 256 + 4 * lane;
        float v[32];
#pragma unroll
        for (int r = 0; r < 32; ++r) { const u32x2 w2 = *(const u32x2*)(q + (size_t)r * DM); v[r] = (bflo(w2.x) * n4.x + bfhi(w2.x) * n4.y) + (bflo(w2.y) * n4.z + bfhi(w2.y) * n4.w); }
        float a16[16], a8[8], a4[4], a2[2], a1;
        { const bool hi = lane & 32;
#pragma unroll
          for (int i = 0; i < 16; ++i) { const float keep = hi ? v[2 * i + 1] : v[2 * i], send = hi ? v[2 * i] : v[2 * i + 1]; a16[i] = keep + __shfl_xor(send, 32); } }
        { const bool hi = lane & 16;
#pragma unroll
          for (int i = 0; i < 8; ++i) { const float keep = hi ? a16[2 * i + 1] : a16[2 * i], send = hi ? a16[2 * i] : a16[2 * i + 1]; a8[i] = keep + __shfl_xor(send, 16); } }
        { const bool hi = lane & 8;
#pragma unroll
          for (int i = 0; i < 4; ++i) { const float keep = hi ? a8[2 * i + 1] : a8[2 * i], send = hi ? a8[2 * i] : a8[2 * i + 1]; a4[i] = keep + __shfl_xor(send, 8); } }
        { const bool hi = lane & 4;
#pragma unroll
          for (int i = 0; i < 2; ++i) { const float keep = hi ? a4[2 * i + 1] : a4[2 * i], send = hi ? a4[2 * i] : a4[2 * i + 1]; a2[i] = keep + __shfl_xor(send, 4); } }
        { const bool hi = lane & 2; const float keep = hi ? a2[1] : a2[0], send = hi ? a2[0] : a2[1]; a1 = keep + __shfl_xor(send, 2); }
        a1 += __shfl_xor(a1, 1);
        if ((lane & 1) == 0) { const int r = ((lane >> 1) & 1) * 16 + ((lane >> 2) & 1) * 8 + ((lane >> 3) & 1) * 4 + ((lane >> 4) & 1) * 2 + ((lane >> 5) & 1); qn[ui * 256 + wave * 32 + r] = a1; }
    }
    asm volatile("s_waitcnt lgkmcnt(0)" ::: "memory"); __syncthreads();
}
__device__ __forceinline__ void ph_g_o(const P& p, LAS unsigned char* lds) {
    g_o_qn(p, lds);
    pg8::Gemm g{DM, 256, 8, 4, nullptr}; pg8::BatchOrder<2> S{(int)gridDim.x, (int)blockIdx.x, (const char*)p.ws};
    pg8::EpiO E{p.ws, p.in[I_HNG], p.in[I_SKIP]}; pg8::gemm_phase<pg8::EpiO, pg8::BatchOrder<2>, true, true>(lds, g, S, E);
}
__device__ __forceinline__ int moe_table(const P& p, LAS unsigned char* lds) {
    LAS int* te = (LAS int*)(lds + 148480); const int* g = wsp<int>(p, WS_TILEE);
    for (int i = otid(); i <= MAXTILES; i += 512) te[i] = g[i];
    asm volatile("s_waitcnt vmcnt(0) lgkmcnt(0)" ::: "memory"); __syncthreads();
    return __builtin_amdgcn_readfirstlane(te[MAXTILES]);
}
__device__ __forceinline__ void ph_g_gu(const P& p, LAS unsigned char* lds) {
    const int nt_ = moe_table(p, lds);
    pg8::Gemm g{512, KP8 / 2, 8, 8, wsp<int>(p, WS_ROWTOK)}; pg8::MoeOrder S; S.init(nt_, 8, gridDim.x, blockIdx.x, p.ws + O_HM, 512, p.ws + WS_WGU, KP8 / 2); S.tile_e = (const LAS int*)(lds + 148480); S.gather = true;
    pg8::EpiGu E{p.ws, p.in[I_BGU]}; pg8::gemm_phase<pg8::EpiGu, pg8::MoeOrder, true, false, true, true>(lds, g, S, E);
}
__device__ __forceinline__ void ph_g_dn(const P& p, LAS unsigned char* lds) {
    const int nt_ = moe_table(p, lds);
    pg8::Gemm g{KP8 / 2, KP8 / 2, 8, 8, nullptr}; pg8::MoeOrder S; S.init(nt_, 4, gridDim.x, blockIdx.x, p.ws + O_ACT, KP8 / 2, p.ws + WS_WDN, KP8 / 2); S.tile_e = (const LAS int*)(lds + 148480); S.gather = false;
    pg8::EpiDn E{p.ws, p.in[I_BDN]}; pg8::gemm_phase<pg8::EpiDn, pg8::MoeOrder, true, false, false, true>(lds, g, S, E);
}

#define XB_TMO      128
#define XB_XCNT(j)  (256  + 64 * (j))
#define XB_XSUB(j)  (1280 + 64 * (j))
#define XB_XGEN(j)  (2304 + 64 * (j))
#define XB_TOP      3328
#define XB_TOPGEN   3392
#define XCD_BAR_WORDS 3456
#define XB_SPIN_CAP (1u << 18)
__device__ __forceinline__ unsigned xb_ld(unsigned* p)              { return __hip_atomic_load(p, __ATOMIC_RELAXED, __HIP_MEMORY_SCOPE_AGENT); }
__device__ __forceinline__ unsigned xb_add(unsigned* p, unsigned v) { return __hip_atomic_fetch_add(p, v, __ATOMIC_RELAXED, __HIP_MEMORY_SCOPE_AGENT); }
__device__ __forceinline__ unsigned xb_xcc_id() { return (unsigned)__builtin_amdgcn_s_getreg((3 << 11) | 20) & 0xFu; }
#define XB_SPIN(cond, bar) do { unsigned _sp = 0; while (cond) { __builtin_amdgcn_s_sleep(1); \
    if ((++_sp & 255u) == 0u) { if (xb_ld(&(bar)[XB_TMO])) break; if (_sp > XB_SPIN_CAP) { atomicAdd(&(bar)[XB_TMO], 1u); break; } } } } while (0)
struct XcdBarrier { unsigned* bar; unsigned x; volatile LAS unsigned* st; };
__device__ __forceinline__ XcdBarrier xcd_barrier_post(unsigned* bar, volatile LAS unsigned* st) {
    XcdBarrier b; b.bar = bar; b.x = xb_xcc_id(); b.st = st;
    if (threadIdx.x == 0) (void)xb_add(&bar[XB_XCNT(b.x)], 1u);
    return b;
}
__device__ __forceinline__ void xcd_barrier_complete(unsigned* bar, unsigned x, unsigned& nloc, unsigned& nx) {
    const unsigned G = gridDim.x * gridDim.y * gridDim.z;
    unsigned sum, cnt, mine, sp = 0u;
    for (;;) {
        sum = 0u; cnt = 0u; mine = 0u;
#pragma unroll
        for (unsigned j = 0; j < 16; ++j) { const unsigned c = xb_ld(&bar[XB_XCNT(j)]); sum += c; cnt += (c > 0u) ? 1u : 0u; mine = (j == x) ? c : mine; }
        if (sum == G) break;
        __builtin_amdgcn_s_sleep(1);
        if ((++sp & 255u) == 0u) { if (xb_ld(&bar[XB_TMO])) break; if (sp > XB_SPIN_CAP) { atomicAdd(&bar[XB_TMO], 1u); break; } }
    }
    nloc = mine > 0u ? mine : 1u; nx = cnt > 0u ? cnt : 1u;
}
__device__ __forceinline__ void xcd_barrier(const XcdBarrier& b) {
    asm volatile("s_waitcnt vmcnt(0)" ::: "memory");
    __syncthreads();
    if (threadIdx.x == 0) {
        unsigned* bar = b.bar;
        __builtin_amdgcn_s_waitcnt(0);
        unsigned nloc = b.st[0], nx = b.st[1];
        if (nloc == 0u) { xcd_barrier_complete(bar, b.x, nloc, nx); b.st[0] = nloc; b.st[1] = nx; }
        const unsigned old = xb_add(&bar[XB_XSUB(b.x)], 1u);
        const unsigned gen = old / nloc;
        if (old + 1u == (gen + 1u) * nloc) {
            __builtin_amdgcn_fence(__ATOMIC_RELEASE, "agent");
            asm volatile("s_waitcnt vmcnt(0)" ::: "memory");
            const unsigned og = xb_add(&bar[XB_TOP], 1u);
            const unsigned tg = og / nx;
            if (og + 1u == (tg + 1u) * nx) xb_add(&bar[XB_TOPGEN], 1u);
            else XB_SPIN(xb_ld(&bar[XB_TOPGEN]) == tg, bar);
            __builtin_amdgcn_fence(__ATOMIC_ACQUIRE, "agent");
            xb_add(&bar[XB_XGEN(b.x)], 1u);
            asm volatile("s_waitcnt vmcnt(0)" ::: "memory");
        } else {
            XB_SPIN(xb_ld(&bar[XB_XGEN(b.x)]) == gen, bar);
            __builtin_amdgcn_fence(__ATOMIC_ACQUIRE, "agent");
            asm volatile("s_waitcnt vmcnt(0)" ::: "memory");
        }
    }
    __syncthreads();
}

constexpr int LDS_BYTES = 155648, MISC_OFF = LDS_BYTES - 64;
constexpr int NPHASE = 13;
#ifndef DUP
#define DUP 0
#endif
#ifndef SPINMASK
#define SPINMASK 0
#endif
#define RUN(id, call) do { call; if ((DUP >> (id)) & 1) { __syncthreads(); call; } } while (0)
__global__ void __launch_bounds__(512, 2) mega(P p, int lo, int hi) {
    extern __shared__ __attribute__((aligned(16))) unsigned char lds_raw[];
    float* lds = (float*)lds_raw; LAS unsigned char* l3 = (LAS unsigned char*)lds_raw;
    volatile LAS unsigned* misc = (volatile LAS unsigned*)(l3 + MISC_OFF);
    if (threadIdx.x < 16) misc[threadIdx.x] = 0u;
    __syncthreads();
    XcdBarrier bar; bar.bar = wsp<unsigned>(p, WS_CTL); bar.x = 0; bar.st = misc;
    if (hi - lo > 1) bar = xcd_barrier_post(wsp<unsigned>(p, WS_CTL), misc);
    for (int ph = lo; ph < hi; ++ph) {
        const unsigned long long t0_ = SPINMASK ? __builtin_amdgcn_s_memrealtime() : 0ull;
        switch (ph) {
            case 0: ph_mod(p, lds); RUN(1, ph_wconv(p, lds)); mod_wait(p); RUN(2, ph_norm1(p)); break;
            case 1: RUN(3, ph_g_in(p, l3)); break;
            case 2: ph_wprime(p, lds); RUN(4, ph_conv(p, lds)); RUN(5, ph_m1(p, lds)); break;
            case 3: RUN(6, ph_m2(p, lds));
                    asm volatile("s_waitcnt vmcnt(0)" ::: "memory"); __syncthreads();
                    RUN(8, ph_g_u(p, l3)); RUN(7, ph_g_pw(p, l3)); break;
            case 4: RUN(10, ph_scan(p)); break;
            case 5: RUN(9, ph_g_s(p, l3));
                    asm volatile("s_waitcnt vmcnt(0)" ::: "memory"); __syncthreads();
                    RUN(11, ph_g_o(p, l3)); break;
            case 6: RUN(12, ph_g_mo(p, l3)); break;
            case 7: RUN(13, ph_g_out(p, l3)); break;
            case 8: RUN(14, ph_router(p, lds)); break;
            case 9: RUN(15, ph_scatter(p, lds)); break;
            case 10: RUN(16, ph_g_gu(p, l3)); break;
            case 11: RUN(17, ph_g_dn(p, l3)); break;
            case 12: RUN(18, ph_final(p)); break;
        }
        if (ph + 1 < hi || (SPINMASK >> ph) & 1) xcd_barrier(bar);
        if ((SPINMASK >> ph) & 1) { const unsigned long long t1_ = __builtin_amdgcn_s_memrealtime(), d_ = t1_ - t0_; while (__builtin_amdgcn_s_memrealtime() - t1_ < d_) __builtin_amdgcn_s_sleep(8); }
    }
}

#ifndef N_LAUNCHES
#define N_LAUNCHES 1
#endif
extern "C" void kernel_launch(void* const* d_in, const int* in_sizes, int n_in, void* d_out, int out_size, void* d_ws, size_t ws_size, hipStream_t stream) {
    static int grid = 0;
    if (grid == 0) {
        if (n_in != 31 || ws_size < WS_NEED || out_size != T * DM) { fprintf(stderr, "kernel_launch: unexpected shapes: n_in %d ws %zu out %d\n", n_in, ws_size, out_size); grid = -1; return; }
        int dev = 0, cus = 0, per_cu = 0;
        if (hipGetDevice(&dev) != hipSuccess || hipDeviceGetAttribute(&cus, hipDeviceAttributeMultiprocessorCount, dev) != hipSuccess) { fprintf(stderr, "kernel_launch: device query failed\n"); grid = -1; return; }
        if (hipFuncSetAttribute((const void*)mega, hipFuncAttributeMaxDynamicSharedMemorySize, LDS_BYTES) != hipSuccess) { fprintf(stderr, "kernel_launch: hipFuncSetAttribute failed\n"); grid = -1; return; }
        if (hipOccupancyMaxActiveBlocksPerMultiprocessor(&per_cu, (const void*)mega, 512, LDS_BYTES) != hipSuccess || per_cu < 1) { fprintf(stderr, "kernel_launch: occupancy query says %d blocks per CU\n", per_cu); (void)hipGetLastError(); grid = -1; return; }
        grid = cus;
    }
    if (grid < 0) return;
    P p{};
    for (int i = 0; i < 31; ++i) p.in[i] = (const float*)d_in[i];
    p.out = (float*)d_out; p.ws = (unsigned char*)d_ws;
    (void)hipMemsetAsync((char*)d_ws + WS_CTL, 0, 65536, stream);
    if (N_LAUNCHES == 1) hipLaunchKernelGGL(mega, dim3(grid), dim3(512), LDS_BYTES, stream, p, 0, NPHASE);
    else for (int ph = 0; ph < NPHASE; ++ph) hipLaunchKernelGGL(mega, dim3(grid), dim3(512), LDS_BYTES, stream, p, ph, ph + 1);
}
```

```cpp
#include <hip/hip_runtime.h>
#include <cstdio>
#include <cstdint>

constexpr int DM = 1024, NB_ = 4, SEQ = 8192, T = NB_ * SEQ, NE = 32, TOPK = 4, DIN = 6144;
constexpr int CH = 256;
constexpr int NCH = SEQ / CH;
constexpr int NUNIT = NB_ * 4 * NCH;
constexpr int MAXTILES = 544;
constexpr float EPS = 1e-6f;

typedef unsigned short bf16;
typedef float f32x4 __attribute__((ext_vector_type(4)));
typedef unsigned u32x4 __attribute__((ext_vector_type(4)));
typedef unsigned u32x2 __attribute__((ext_vector_type(2)));

constexpr size_t MB = 1u << 20;
constexpr size_t WS_WGU = 768 * MB, WS_WDN = 844 * MB;
constexpr size_t SLAB0 = 192 * MB, SLABSZ = 64 * MB;
#define SLAB(i) (SLAB0 + (size_t)(i) * SLABSZ)
constexpr size_t WS_WIN = 960 * MB, WS_WPW = 972 * MB, WS_WMO = 974 * MB, WS_WOUT = 976 * MB;
constexpr size_t WS_CTL = 978 * MB, WS_MOD = 979 * MB, WS_IG = 980 * MB, WS_LOGF = 980 * MB + 512 * 1024;
constexpr size_t WS_CW = 981 * MB, WS_FLOOR = 981 * MB + 512 * 1024, WS_UNITS = 982 * MB, WS_NLOC = 983 * MB, WS_NS = 984 * MB;
constexpr size_t WS_DENP = 985 * MB, WS_DEN = 987 * MB, WS_TOPI = 988 * MB, WS_TOPW = 989 * MB, WS_CNT = 990 * MB, WS_ROWSLOT = 991 * MB, WS_TILEE = 992 * MB;
constexpr size_t WS_ROWTOK = 997 * MB;
constexpr size_t WS_SSQ = WS_DENP;
constexpr size_t WS_MODCNT = WS_CTL + 40960;
constexpr size_t WS_WPR = 998 * MB;
constexpr size_t WS_GP = 993 * MB;
constexpr size_t WS_NEED = 1024 * MB;
constexpr size_t O_HA = SLAB(11), O_YAPRE = SLAB(0), O_MOIN = 64 * MB;
constexpr size_t O_UT = SLAB(11);
constexpr size_t O_SP = 128 * MB;
constexpr size_t O_U1 = SLAB(1), O_KWT = SLAB(1), O_CT = SLAB(1);
constexpr size_t O_XM = SLAB(2), O_VT = SLAB(8);
constexpr size_t O_SO = SLAB(3);
constexpr size_t O_SZA = SLAB(4);
constexpr size_t O_SZB = SLAB(5);
constexpr size_t O_Q = SLAB(6), O_K = SLAB(7), O_V = SLAB(8), O_XC = 0, O_MERGED = SLAB(11);
constexpr size_t O_HG = SLAB(7);
constexpr size_t O_X1 = SLAB(0);
constexpr size_t O_HM = SLAB(2);
constexpr size_t O_XS = SLAB(3), O_Y = SLAB(3);
constexpr size_t O_ACT = SLAB(6);

struct P { const float* in[31]; float* out; unsigned char* ws; };
enum { I_X = 0, I_C, I_WADA, I_BADA, I_GMIX, I_WIN, I_WDW, I_BDW, I_LNG, I_LNB, I_WPW, I_BPW, I_WSC, I_BSC, I_WQ, I_WK, I_WV, I_WIF, I_BIF, I_HNG, I_SKIP,
       I_WMO, I_WOUT, I_GMOE, I_WR, I_BR, I_WGU, I_BGU, I_WDN, I_BDN, I_GFIN };

#define LAS __attribute__((address_space(3)))
__device__ __forceinline__ unsigned f2bf(float f) { unsigned u = __float_as_uint(f); return (u + 0x7fffu + ((u >> 16) & 1u)) >> 16; }
__device__ __forceinline__ float bf2f(unsigned h) { return __uint_as_float(h << 16); }
__device__ __forceinline__ unsigned pk2(float lo, float hi) { unsigned r; asm volatile("v_cvt_pk_bf16_f32 %0, %1, %2" : "=v"(r) : "v"(lo), "v"(hi)); return r; }
__device__ __forceinline__ float bflo(unsigned w) { return __uint_as_float(w << 16); }
__device__ __forceinline__ float bfhi(unsigned w) { return __uint_as_float(w & 0xffff0000u); }
__device__ __forceinline__ unsigned pk4_fp8(float a, float b, float c, float d) {
    a = fminf(fmaxf(a, -448.f), 448.f); b = fminf(fmaxf(b, -448.f), 448.f); c = fminf(fmaxf(c, -448.f), 448.f); d = fminf(fmaxf(d, -448.f), 448.f);
    int w = 0; w = __builtin_amdgcn_cvt_pk_fp8_f32(a, b, w, false); w = __builtin_amdgcn_cvt_pk_fp8_f32(c, d, w, true); return (unsigned)w; }
__device__ __forceinline__ unsigned pk4_fp8_nc(float a, float b, float c, float d) { int w = 0; w = __builtin_amdgcn_cvt_pk_fp8_f32(a, b, w, false); w = __builtin_amdgcn_cvt_pk_fp8_f32(c, d, w, true); return (unsigned)w; }
typedef float f32x2_ __attribute__((ext_vector_type(2)));
constexpr int KP8 = 1152;
constexpr float S_HM = 32.f, S_W = 1024.f, S_ACT = 4.f, S_Y = 32.f;
__device__ __forceinline__ float sigm(float x) { return __builtin_amdgcn_rcpf(1.f + __expf(-x)); }
__device__ __forceinline__ float silu(float x) { return x * __builtin_amdgcn_rcpf(1.f + __expf(-x)); }
__device__ __forceinline__ float wave_sum(float v) {
#pragma unroll
    for (int o = 1; o < 64; o <<= 1) v += __shfl_xor(v, o);
    return v;
}
__device__ __forceinline__ float wave_max(float v) {
#pragma unroll
    for (int o = 1; o < 64; o <<= 1) v = fmaxf(v, __shfl_xor(v, o));
    return v;
}
__device__ __forceinline__ int ld_agent(const int* p) { return __hip_atomic_load(p, __ATOMIC_RELAXED, __HIP_MEMORY_SCOPE_AGENT); }
__device__ __forceinline__ int otid() { int t = threadIdx.x; asm volatile("" : "+v"(t)); return t; }
template <class Tp> __device__ __forceinline__ Tp* wsp(const P& p, size_t off) { return (Tp*)(p.ws + off); }

__device__ void ph_mod(const P& p, float* lds) {
    const int tid = otid();
    const float* c = p.in[I_C]; const float* w = p.in[I_WADA]; const float* ba = p.in[I_BADA];
    float* mod = wsp<float>(p, WS_MOD);
    float* sc_ = lds + 2048;
    for (int i = tid; i < NB_ * DM; i += 512) sc_[i] = silu(c[i]);
    __syncthreads();
    for (int cb = blockIdx.x; cb < DIN / 24; cb += gridDim.x) {
        if (tid < 384) {
            const int col = cb * 24 + (tid % 24), ks = tid / 24;
            float a0 = 0.f, a1 = 0.f, a2 = 0.f, a3 = 0.f;
#pragma unroll 8
            for (int k = ks * 64; k < ks * 64 + 64; ++k) {
                const float wv = w[(size_t)k * DIN + col];
                a0 += sc_[k] * wv; a1 += sc_[DM + k] * wv; a2 += sc_[2 * DM + k] * wv; a3 += sc_[3 * DM + k] * wv;
            }
            float* r = lds + (ks * 24 + (tid % 24)) * 4; r[0] = a0; r[1] = a1; r[2] = a2; r[3] = a3;
        }
        __syncthreads();
        if (tid < 96) {
            const int cl = tid % 24, b = tid / 24; float s = 0.f;
            for (int ks = 0; ks < 16; ++ks) s += lds[(ks * 24 + cl) * 4 + b];
            mod[b * DIN + cb * 24 + cl] = s + ba[cb * 24 + cl];
        }
        __syncthreads();
    }
    int done = 0; for (int cb = blockIdx.x; cb < DIN / 24; cb += gridDim.x) ++done;
    asm volatile("s_waitcnt vmcnt(0)" ::: "memory"); __syncthreads();
    if (tid == 0) { __builtin_amdgcn_fence(__ATOMIC_RELEASE, "agent"); asm volatile("s_waitcnt vmcnt(0)" ::: "memory");
        __hip_atomic_fetch_add(wsp<int>(p, WS_MODCNT), done, __ATOMIC_RELAXED, __HIP_MEMORY_SCOPE_AGENT); }
}
__device__ void mod_wait(const P& p) {
    if (otid() == 0) { const int* c = wsp<int>(p, WS_MODCNT); unsigned spins = 0;
        while (ld_agent(c) < DIN / 24 && ++spins < (1u << 22)) __builtin_amdgcn_s_sleep(2);
        __builtin_amdgcn_fence(__ATOMIC_ACQUIRE, "agent"); asm volatile("s_waitcnt vmcnt(0)" ::: "memory"); }
    __syncthreads();
}
__device__ __forceinline__ int glu_row(int n, int half) { const int ch = n % half, isg = n / half; return (ch >> 7) * 256 + isg * 128 + (ch & 127); }
__device__ __forceinline__ void transpose_item(const float* W, int K, int N, bf16* WT, int drow0, float* scr, int kb, int nb, int lane) {
    const int k0 = 64 * kb, n0 = 32 * nb;
    { float v[32];
#pragma unroll
      for (int i = 0; i < 32; ++i) v[i] = __builtin_nontemporal_load(&W[(size_t)(k0 + 2 * i + (lane >> 5)) * N + n0 + (lane & 31)]);
      asm volatile("" ::: "memory");
#pragma unroll
      for (int i = 0; i < 32; ++i) scr[(2 * i + (lane >> 5)) * 33 + (lane & 31)] = v[i]; }
    __builtin_amdgcn_s_waitcnt(0xc07f); asm volatile("" ::: "memory");
    const int c = lane & 7;
#pragma unroll
    for (int j = 0; j < 4; ++j) { const int n = (lane >> 3) + 8 * j; const float* s = scr + (8 * c) * 33 + n;
        u32x4 o; o.x = pk2(s[0 * 33], s[1 * 33]); o.y = pk2(s[2 * 33], s[3 * 33]); o.z = pk2(s[4 * 33], s[5 * 33]); o.w = pk2(s[6 * 33], s[7 * 33]);
        *(u32x4*)(WT + (size_t)(drow0 + n) * K + k0 + 8 * c) = o; }
    __builtin_amdgcn_s_waitcnt(0xc07f); asm volatile("" ::: "memory");
}
__device__ __forceinline__ void transpose_item8(const float* W, int pitch, int N, unsigned char* WT, int drow0, float* scr, int kb, int nb, int lane) {
    const int k0 = 128 * kb, n0 = 32 * nb;
#pragma unroll
    for (int hb = 0; hb < 2; ++hb) {
        float v[32];
#pragma unroll
        for (int i = 0; i < 32; ++i) v[i] = __builtin_nontemporal_load(&W[(size_t)(k0 + 2 * (hb * 32 + i) + (lane >> 5)) * N + n0 + (lane & 31)]);
        asm volatile("" ::: "memory");
#pragma unroll
        for (int i = 0; i < 32; ++i) scr[(2 * (hb * 32 + i) + (lane >> 5)) * 33 + (lane & 31)] = v[i];
    }
    __builtin_amdgcn_s_waitcnt(0xc07f); asm volatile("" ::: "memory");
    const int c = lane & 7;
#pragma unroll
    for (int j = 0; j < 4; ++j) { const int n = (lane >> 3) + 8 * j; const float* q = scr + (16 * c) * 33 + n;
        u32x4 o; o.x = pk4_fp8(q[0] * S_W, q[33] * S_W, q[66] * S_W, q[99] * S_W); o.y = pk4_fp8(q[132] * S_W, q[165] * S_W, q[198] * S_W, q[231] * S_W);
        o.z = pk4_fp8(q[264] * S_W, q[297] * S_W, q[330] * S_W, q[363] * S_W); o.w = pk4_fp8(q[396] * S_W, q[429] * S_W, q[462] * S_W, q[495] * S_W);
        *(u32x4*)(WT + (size_t)(drow0 + n) * pitch + k0 + 16 * c) = o; }
    __builtin_amdgcn_s_waitcnt(0xc07f); asm volatile("" ::: "memory");
}
__device__ void ph_wconv(const P& p, float* lds) {
    const int tid = otid(), lane = tid & 63, wave = tid >> 6;
    float* scr = lds + wave * (128 * 33);
    const int gw = blockIdx.x * 8 + wave, NGW = gridDim.x * 8;
    constexpr int I_IN = 16 * 192, I_SQ = 16 * 32, I_GU = 8 * 64, I_DN = 8 * 32;
    constexpr int NITEMS = I_IN + 3 * I_SQ + NE * I_GU + NE * I_DN;
    for (int it = gw; it < NITEMS; it += NGW) {
        int r = it;
        if (r < I_IN) { const int kb = r / 192, nb = r % 192, n0 = nb * 32; const int d = n0 < 2048 ? glu_row(n0, 1024) : n0 >= 4096 ? 4096 + glu_row(n0 - 4096, 1024) : n0;
            transpose_item(p.in[I_WIN], DM, DIN, wsp<bf16>(p, WS_WIN), d, scr, kb, nb, lane); continue; } r -= I_IN;
        if (r < I_SQ) { transpose_item(p.in[I_WPW], DM, DM, wsp<bf16>(p, WS_WPW), (r % 32) * 32, scr, r / 32, r % 32, lane); continue; } r -= I_SQ;
        if (r < I_SQ) { transpose_item(p.in[I_WMO], DM, DM, wsp<bf16>(p, WS_WMO), (r % 32) * 32, scr, r / 32, r % 32, lane); continue; } r -= I_SQ;
        if (r < I_SQ) { transpose_item(p.in[I_WOUT], DM, DM, wsp<bf16>(p, WS_WOUT), (r % 32) * 32, scr, r / 32, r % 32, lane); continue; } r -= I_SQ;
        if (r < NE * I_GU) { const int e = r / I_GU, q = r % I_GU, kb = q / 64, nb = q % 64;
            transpose_item8(p.in[I_WGU] + (size_t)e * DM * 2048, KP8, 2048, wsp<unsigned char>(p, WS_WGU) + (size_t)e * 2048 * KP8, glu_row(nb * 32, 1024), scr, kb, nb, lane); continue; } r -= NE * I_GU;
        { const int e = r / I_DN, q = r % I_DN, kb = q / 32, nb = q % 32;
            transpose_item8(p.in[I_WDN] + (size_t)e * DM * DM, KP8, DM, wsp<unsigned char>(p, WS_WDN) + (size_t)e * DM * KP8, nb * 32, scr, kb, nb, lane); }
    }
}
__device__ __forceinline__ void adanorm_row(const float* xrow, const float* g, const float* sc, const float* sh, bf16* orow, int lane) {
    f32x4 v[4]; float s = 0.f;
#pragma unroll
    for (int j = 0; j < 4; ++j) { v[j] = ((const f32x4*)xrow)[lane + 64 * j]; s += (v[j].x * v[j].x + v[j].y * v[j].y) + (v[j].z * v[j].z + v[j].w * v[j].w); }
    const float r = rsqrtf(wave_sum(s) * (1.f / DM) + EPS);
#pragma unroll
    for (int j = 0; j < 4; ++j) { const f32x4 gg = ((const f32x4*)g)[lane + 64 * j], ss = ((const f32x4*)sc)[lane + 64 * j], hh = ((const f32x4*)sh)[lane + 64 * j];
        const f32x4 o = v[j] * r * gg * (1.f + ss) + hh;
        u32x2 w; w.x = pk2(o.x, o.y); w.y = pk2(o.z, o.w); ((u32x2*)orow)[lane + 64 * j] = w; }
}
__device__ void ph_norm1(const P& p) {
    const int tid = otid(), lane = tid & 63, gw = blockIdx.x * 8 + (tid >> 6), NGW = gridDim.x * 8;
    const float* mod = wsp<float>(p, WS_MOD); bf16* HA = wsp<bf16>(p, O_HA); const float* X = p.in[I_X];
    const int per = (T + NGW - 1) / NGW;
    for (int m0 = gw * per; m0 < T && m0 < (gw + 1) * per; ) {
        const int b = m0 / SEQ; int m1 = (gw + 1) * per; if (m1 > T) m1 = T; if (m1 > (b + 1) * SEQ) m1 = (b + 1) * SEQ;
        f32x4 gs[4], hh[4];
#pragma unroll
        for (int j = 0; j < 4; ++j) { gs[j] = ((const f32x4*)p.in[I_GMIX])[lane + 64 * j] * (1.f + ((const f32x4*)(mod + b * DIN + 1024))[lane + 64 * j]); hh[j] = ((const f32x4*)(mod + b * DIN))[lane + 64 * j]; }
        int m = m0;
        for (; m + 4 <= m1; m += 4) {
            f32x4 v[4][4]; float ss[4];
#pragma unroll
            for (int r = 0; r < 4; ++r)
#pragma unroll
                for (int j = 0; j < 4; ++j) v[r][j] = ((const f32x4*)(X + (size_t)(m + r) * DM))[lane + 64 * j];
#pragma unroll
            for (int r = 0; r < 4; ++r) { float q = 0.f;
#pragma unroll
                for (int j = 0; j < 4; ++j) q += (v[r][j].x * v[r][j].x + v[r][j].y * v[r][j].y) + (v[r][j].z * v[r][j].z + v[r][j].w * v[r][j].w);
                ss[r] = rsqrtf(wave_sum(q) * (1.f / DM) + EPS); }
#pragma unroll
            for (int r = 0; r < 4; ++r)
#pragma unroll
                for (int j = 0; j < 4; ++j) { const f32x4 o = v[r][j] * ss[r] * gs[j] + hh[j]; u32x2 w; w.x = pk2(o.x, o.y); w.y = pk2(o.z, o.w); ((u32x2*)(HA + (size_t)(m + r) * DM))[lane + 64 * j] = w; }
        }
        for (; m < m1; ++m) adanorm_row(X + (size_t)m * DM, p.in[I_GMIX], mod + b * DIN + 1024, mod + b * DIN, HA + (size_t)m * DM, lane);
        m0 = m1;
    }
}
__device__ void ph_conv(const P& p, float* lds) {
    const int tid = otid(), lane = tid & 63, wave = tid >> 6, c2 = tid * 2;
    const bf16* U1 = wsp<bf16>(p, O_U1); bf16* YA = wsp<bf16>(p, O_YAPRE);
    bf16* tin = (bf16*)(lds + 256);
    bf16* tout = tin + 2 * 8192;
    const float* wd = p.in[I_WDW];
    float w0[31], w1[31];
#pragma unroll
    for (int j = 0; j < 31; ++j) { w0[j] = wd[j * DM + c2]; w1[j] = wd[j * DM + c2 + 1]; }
    const float b0 = p.in[I_BDW][c2], b1 = p.in[I_BDW][c2 + 1];
    const float g0 = p.in[I_LNG][c2], g1 = p.in[I_LNG][c2 + 1], lb0 = p.in[I_LNB][c2], lb1 = p.in[I_LNB][c2 + 1];
    const int crow = tid >> 7, ccol = (tid & 127) * 8;
    for (int blk = blockIdx.x; blk < T / 128; blk += gridDim.x) {
        const int tb = blk * 128, sb = tb % SEQ;
        unsigned win[38];
#pragma unroll
        for (int j = 0; j < 30; ++j) win[j] = (sb - 30 + j >= 0) ? *(const unsigned*)(U1 + (size_t)(tb - 30 + j) * DM + c2) : 0u;
        u32x4 r0 = *(const u32x4*)(U1 + (size_t)(tb + crow) * DM + ccol), r1 = *(const u32x4*)(U1 + (size_t)(tb + crow + 4) * DM + ccol);
        for (int grp = 0; grp < 16; ++grp) {
            const int t0 = tb + grp * 8;
            bf16* ti = tin + (grp & 1) * 8192;
            *(u32x4*)(ti + crow * 1024 + ccol) = r0; *(u32x4*)(ti + (crow + 4) * 1024 + ccol) = r1;
            if (grp < 15) { r0 = *(const u32x4*)(U1 + (size_t)(t0 + 8 + crow) * DM + ccol); r1 = *(const u32x4*)(U1 + (size_t)(t0 + 12 + crow) * DM + ccol); }
            __syncthreads();
            if (grp > 0) { const bf16* to = tout + ((grp - 1) & 1) * 8192;
                *(u32x4*)(YA + (size_t)(t0 - 8 + crow) * DM + ccol) = *(const u32x4*)(to + crow * 1024 + ccol);
                *(u32x4*)(YA + (size_t)(t0 - 4 + crow) * DM + ccol) = *(const u32x4*)(to + (crow + 4) * 1024 + ccol); }
#pragma unroll
            for (int j = 0; j < 8; ++j) win[30 + j] = *(const unsigned*)(ti + j * 1024 + c2);
            float a0[8], a1[8];
#pragma unroll
            for (int i = 0; i < 8; ++i) { a0[i] = b0; a1[i] = b1; }
#pragma unroll
            for (int j = 0; j < 38; ++j) { const float u0 = bflo(win[j]), u1 = bfhi(win[j]);
#pragma unroll
                for (int i = 0; i < 8; ++i) { const int tap = j - i; if (tap >= 0 && tap <= 30) { a0[i] += u0 * w0[tap]; a1[i] += u1 * w1[tap]; } } }
#pragma unroll
            for (int j = 0; j < 30; ++j) win[j] = win[j + 8];
            float st[16];
#pragma unroll
            for (int i = 0; i < 8; ++i) { st[2 * i] = a0[i] + a1[i]; st[2 * i + 1] = a0[i] * a0[i] + a1[i] * a1[i]; }
            float s8[8], s4[4], s2[2], s1;
            { const bool hi = lane & 32;
#pragma unroll
              for (int i = 0; i < 8; ++i) { const float keep = hi ? st[2 * i + 1] : st[2 * i], send = hi ? st[2 * i] : st[2 * i + 1]; s8[i] = keep + __shfl_xor(send, 32); } }
            { const bool hi = lane & 16;
#pragma unroll
              for (int i = 0; i < 4; ++i) { const float keep = hi ? s8[2 * i + 1] : s8[2 * i], send = hi ? s8[2 * i] : s8[2 * i + 1]; s4[i] = keep + __shfl_xor(send, 16); } }
            { const bool hi = lane & 8;
#pragma unroll
              for (int i = 0; i < 2; ++i) { const float keep = hi ? s4[2 * i + 1] : s4[2 * i], send = hi ? s4[2 * i] : s4[2 * i + 1]; s2[i] = keep + __shfl_xor(send, 8); } }
            { const bool hi = lane & 4; const float keep = hi ? s2[1] : s2[0], send = hi ? s2[0] : s2[1]; s1 = keep + __shfl_xor(send, 4); }
            s1 += __shfl_xor(s1, 2); s1 += __shfl_xor(s1, 1);
            float* red = lds + (grp & 1) * 128;
            if ((lane & 3) == 0) { const int idx = ((lane >> 2) & 1) * 8 + ((lane >> 3) & 1) * 4 + ((lane >> 4) & 1) * 2 + ((lane >> 5) & 1); red[idx * 8 + wave] = s1; }
            __syncthreads();
            float* fin = lds + 16640 + (grp & 1) * 16;
            if (tid < 8) { const f32x4 s0 = *(const f32x4*)(red + tid * 16), s1 = *(const f32x4*)(red + tid * 16 + 4), q0 = *(const f32x4*)(red + tid * 16 + 8), q1 = *(const f32x4*)(red + tid * 16 + 12);
                const float s = ((s0.x + s0.y) + (s0.z + s0.w)) + ((s1.x + s1.y) + (s1.z + s1.w)), q = ((q0.x + q0.y) + (q0.z + q0.w)) + ((q1.x + q1.y) + (q1.z + q1.w));
                const float mu = s * (1.f / DM), var = fmaxf(q * (1.f / DM) - mu * mu, 0.f); fin[tid * 2] = mu; fin[tid * 2 + 1] = rsqrtf(var + EPS); }
            __syncthreads();
            bf16* to = tout + (grp & 1) * 8192;
            const f32x4 f0 = *(const f32x4*)fin, f1 = *(const f32x4*)(fin + 4), f2 = *(const f32x4*)(fin + 8), f3 = *(const f32x4*)(fin + 12);
            const float mus[8] = {f0.x, f0.z, f1.x, f1.z, f2.x, f2.z, f3.x, f3.z}, rss[8] = {f0.y, f0.w, f1.y, f1.w, f2.y, f2.w, f3.y, f3.w};
#pragma unroll
            for (int i = 0; i < 8; ++i) {
                const float mu = mus[i], rs = rss[i];
                const float y0 = (a0[i] - mu) * rs * g0 + lb0, y1 = (a1[i] - mu) * rs * g1 + lb1;
                *(unsigned*)(to + i * 1024 + c2) = pk2(silu(y0), silu(y1));
            }
        }
        __syncthreads();
        { const bf16* to = tout + 8192;
            *(u32x4*)(YA + (size_t)(tb + 120 + crow) * DM + ccol) = *(const u32x4*)(to + crow * 1024 + ccol);
            *(u32x4*)(YA + (size_t)(tb + 124 + crow) * DM + ccol) = *(const u32x4*)(to + (crow + 4) * 1024 + ccol); }
        __syncthreads();
    }
}
typedef short bf16x8v __attribute__((ext_vector_type(8)));
__device__ __forceinline__ unsigned cvtpk(float lo, float hi) { unsigned r; asm volatile("v_cvt_pk_bf16_f32 %0, %1, %2" : "=v"(r) : "v"(lo), "v"(hi)); return r; }
__device__ __forceinline__ bf16x8v pack_frag(const float* v) { u32x4 w; w.x = cvtpk(v[0], v[1]); w.y = cvtpk(v[2], v[3]); w.z = cvtpk(v[4], v[5]); w.w = cvtpk(v[6], v[7]); return __builtin_bit_cast(bf16x8v, w); }
__device__ void ph_m1(const P& p, float* lds) {
    const int tid = otid(), lane = tid & 63, wave = tid >> 6, tok = lane & 15, kg = lane >> 4;
    const bf16* XM = wsp<bf16>(p, O_XM);
    bf16* K = wsp<bf16>(p, O_K); bf16* XC = wsp<bf16>(p, O_XC);
    float* GP = wsp<float>(p, WS_GP);
    for (int item = blockIdx.x; item < 256; item += gridDim.x) {
        const int cb = item & 3, range = item >> 2, c8 = cb * 256 + wave * 32 + kg * 8;
        float wsc[4][8], bsc[8];
#pragma unroll
        for (int j = 0; j < 4; ++j) { const f32x4 a = *(const f32x4*)(p.in[I_WSC] + j * DM + c8), b = *(const f32x4*)(p.in[I_WSC] + j * DM + c8 + 4);
            wsc[j][0] = a.x; wsc[j][1] = a.y; wsc[j][2] = a.z; wsc[j][3] = a.w; wsc[j][4] = b.x; wsc[j][5] = b.y; wsc[j][6] = b.z; wsc[j][7] = b.w; }
        { const f32x4 a = *(const f32x4*)(p.in[I_BSC] + c8), b = *(const f32x4*)(p.in[I_BSC] + c8 + 4); bsc[0] = a.x; bsc[1] = a.y; bsc[2] = a.z; bsc[3] = a.w; bsc[4] = b.x; bsc[5] = b.y; bsc[6] = b.z; bsc[7] = b.w; }
        bf16x8v wq[2], wk[2], wv[2], w2[2], bq, bk, bv;
        {
            float lq[2][8], lk[2][8], lv[2][8], g0[8], g1[8], g2_[8]; f32x4 rk[2][4], rq[2];
#pragma unroll
            for (int m = 0; m < 2; ++m) { const int co = 8 * (tok >> 2) + 4 * m + (tok & 3); const int blk = (cb * 256 + wave * 32) / 4 + (co >> 2);
#pragma unroll
                for (int j = 0; j < 8; ++j) { const int idx = blk * 16 + (j & 3) * 4 + (co & 3); lq[m][j] = p.in[I_WQ][idx]; lk[m][j] = p.in[I_WK][idx]; lv[m][j] = p.in[I_WV][idx]; }
#pragma unroll
                for (int jj = 0; jj < 4; ++jj) rk[m][jj] = *(const f32x4*)(p.in[I_WK] + blk * 16 + jj * 4);
                rq[m] = *(const f32x4*)(p.in[I_WQ] + blk * 16 + (co & 3) * 4); }
#pragma unroll
            for (int j = 0; j < 8; ++j) { const int gi = tok & 7; g0[j] = p.in[I_WIF][(size_t)(c8 + j) * 8 + gi]; g1[j] = p.in[I_WIF][(size_t)(DM + c8 + j) * 8 + gi]; g2_[j] = p.in[I_WIF][(size_t)(2 * DM + c8 + j) * 8 + gi]; }
            asm volatile("" ::: "memory");
#pragma unroll
            for (int m = 0; m < 2; ++m) { float tq[8], tk[8], tv[8], t2[8]; const int co = 8 * (tok >> 2) + 4 * m + (tok & 3);
#pragma unroll
                for (int j = 0; j < 8; ++j) { const int ci = kg * 8 + j; const bool on = (ci >> 2) == (co >> 2); const f32x4 a = rk[m][j & 3], b = rq[m];
                    tq[j] = on ? lq[m][j] : 0.f; tk[j] = on ? lk[m][j] : 0.f; tv[j] = on ? lv[m][j] : 0.f;
                    t2[j] = on ? (a[0] * b[0] + a[1] * b[1]) + (a[2] * b[2] + a[3] * b[3]) : 0.f; }
                wq[m] = pack_frag(tq); wk[m] = pack_frag(tk); wv[m] = pack_frag(tv); w2[m] = pack_frag(t2); }
            { float t0[8], t1[8], t2[8]; const bool on = tok < 8;
#pragma unroll
              for (int j = 0; j < 8; ++j) { t0[j] = on ? g0[j] : 0.f; t1[j] = on ? g1[j] : 0.f; t2[j] = on ? g2_[j] : 0.f; }
              bq = pack_frag(t0); bk = pack_frag(t1); bv = pack_frag(t2); }
        }
        u32x4 nx[4];
#pragma unroll
        for (int j = 0; j < 4; ++j) { const int t_ = range * 512 + tok, s_ = t_ % SEQ; nx[j] = (u32x4){0u, 0u, 0u, 0u}; if (s_ - 3 + j >= 0) nx[j] = *(const u32x4*)(XM + (size_t)(t_ - 3 + j) * DM + c8); }
        for (int tt = 0; tt < 32; ++tt) {
            const int t = range * 512 + tt * 16 + tok;
            float xm[4][8]; const u32x4 rawv = nx[3];
#pragma unroll
            for (int j = 0; j < 4; ++j) { const u32x4 u = nx[j];
                xm[j][0] = bflo(u.x); xm[j][1] = bfhi(u.x); xm[j][2] = bflo(u.y); xm[j][3] = bfhi(u.y); xm[j][4] = bflo(u.z); xm[j][5] = bfhi(u.z); xm[j][6] = bflo(u.w); xm[j][7] = bfhi(u.w); }
            if (tt < 31) {
#pragma unroll
                for (int j = 0; j < 4; ++j) nx[j] = *(const u32x4*)(XM + (size_t)(t + 16 - 3 + j) * DM + c8); }
            float xc[8], q[8], k[8], v[8], k2[8];
#pragma unroll
            for (int c = 0; c < 8; ++c) { float a = bsc[c];
#pragma unroll
                for (int j = 0; j < 4; ++j) a += xm[j][c] * wsc[j][c];
                xc[c] = silu(a); }
            const bf16x8v fx_ = pack_frag(xc), fraw = __builtin_bit_cast(bf16x8v, rawv);
            { const f32x4 z4 = {0.f, 0.f, 0.f, 0.f};
              f32x4 q0 = __builtin_amdgcn_mfma_f32_16x16x32_bf16(wq[0], fx_, z4, 0, 0, 0), q1 = __builtin_amdgcn_mfma_f32_16x16x32_bf16(wq[1], fx_, z4, 0, 0, 0);
              f32x4 k0 = __builtin_amdgcn_mfma_f32_16x16x32_bf16(wk[0], fx_, z4, 0, 0, 0), k1 = __builtin_amdgcn_mfma_f32_16x16x32_bf16(wk[1], fx_, z4, 0, 0, 0);
              f32x4 v0 = __builtin_amdgcn_mfma_f32_16x16x32_bf16(wv[0], fraw, z4, 0, 0, 0), v1 = __builtin_amdgcn_mfma_f32_16x16x32_bf16(wv[1], fraw, z4, 0, 0, 0);
              f32x4 s0 = __builtin_amdgcn_mfma_f32_16x16x32_bf16(w2[0], fx_, z4, 0, 0, 0), s1 = __builtin_amdgcn_mfma_f32_16x16x32_bf16(w2[1], fx_, z4, 0, 0, 0);
              asm volatile("s_nop 15" : "+v"(q0), "+v"(q1), "+v"(k0), "+v"(k1), "+v"(v0), "+v"(v1), "+v"(s0), "+v"(s1));
#pragma unroll
              for (int o = 0; o < 4; ++o) { q[o] = q0[o]; q[4 + o] = q1[o]; k[o] = k0[o]; k[4 + o] = k1[o]; v[o] = v0[o]; v[4 + o] = v1[o]; k2[o] = s0[o]; k2[4 + o] = s1[o]; } }
            const bf16x8v fq_ = pack_frag(q), fk_ = pack_frag(k), fv_ = pack_frag(v), fk2_ = pack_frag(k2);
            f32x4 acc = {0.f, 0.f, 0.f, 0.f};
            acc = __builtin_amdgcn_mfma_f32_16x16x32_bf16(fq_, bq, acc, 0, 0, 0);
            acc = __builtin_amdgcn_mfma_f32_16x16x32_bf16(fk_, bk, acc, 0, 0, 0);
            acc = __builtin_amdgcn_mfma_f32_16x16x32_bf16(fv_, bv, acc, 0, 0, 0);
            float* red = lds + (tt & 3) * 1024 + wave * 128;
            if (tok < 8) {
#pragma unroll
                for (int r = 0; r < 4; ++r) red[(kg * 4 + r) * 8 + tok] = acc[r]; }
            *(bf16x8v*)(K + (size_t)t * DM + c8) = fk2_; *(bf16x8v*)(XC + (size_t)t * DM + c8) = fx_;
            if (tt & 1) {
                __syncthreads();
                if (tid < 256) { const int tl = tt - 1 + (tid >> 7), e = tid & 127; const float* rr = lds + (tl & 3) * 1024 + e; float sum = 0.f;
#pragma unroll
                    for (int w = 0; w < 8; ++w) sum += rr[w * 128];
                    GP[(size_t)cb * T * 8 + (size_t)(range * 512 + tl * 16) * 8 + e] = sum; }
            }
        }
        __syncthreads();
    }
}
constexpr int TP = 258;
__device__ void ph_m2(const P& p, float* ldsf) {
    const int tid = otid(), lane = tid & 63, wave = tid >> 6;
    bf16* tile = (bf16*)ldsf;
    float* wts = ldsf + 33024;
    float* red = ldsf + 33024 + 256;
    const bf16* Kb = wsp<bf16>(p, O_K); const bf16* Vb = wsp<bf16>(p, O_XM);
    bf16* KWT = wsp<bf16>(p, O_KWT); bf16* VT = wsp<bf16>(p, O_VT);
    const float* GP = wsp<float>(p, WS_GP); const float* bif = p.in[I_BIF];
    float* CW = wsp<float>(p, WS_CW); float* FL = wsp<float>(p, WS_FLOOR); float* UN = wsp<float>(p, WS_UNITS); float* NLOC = wsp<float>(p, WS_NLOC);
    for (int unit = blockIdx.x; unit < NUNIT; unit += gridDim.x) {
        const int b = unit >> 7, h = (unit >> 5) & 3, c = unit & 31, tok0 = b * SEQ + c * CH;
        float bc = 0.f, a = 0.f, igv = 0.f;
        if (tid < 256) {
            float gi_ = bif[h], gf_ = bif[4 + h];
#pragma unroll
            for (int cb = 0; cb < 4; ++cb) { const float* g8 = GP + (size_t)cb * T * 8 + (size_t)(tok0 + tid) * 8; gi_ += g8[h]; gf_ += g8[4 + h]; }
            igv = gi_;
            float lf = fminf(gf_, 0.f) - log1pf(__expf(-fabsf(gf_)));
#pragma unroll
            for (int o = 1; o < 64; o <<= 1) { const float n = __shfl_up(lf, o); if (lane >= o) lf += n; }
            if (lane == 63) red[wave] = lf;
            bc = lf;
        }
        __syncthreads();
        if (tid < 256) {
            for (int w = 0; w < wave; ++w) bc += red[w];
            a = igv - bc;
            const float m = wave_max(a);
            if (lane == 0) red[8 + wave] = m;
        }
        __syncthreads();
        if (tid < 256) {
            const float amax = fmaxf(fmaxf(red[8], red[9]), fmaxf(red[10], red[11]));
            const float w = __expf(a - amax) * 0.0625f;
            wts[tid] = w; CW[unit * 256 + tid] = w; FL[unit * 256 + tid] = __expf(-bc - amax);
            if (tid == 255) { UN[unit * 2] = amax; UN[unit * 2 + 1] = bc; }
        }
        float wvb[2][16];
#pragma unroll
        for (int g = 0; g < 2; ++g)
#pragma unroll
            for (int i = 0; i < 16; ++i) wvb[g][i] = p.in[I_WV][(h * 64 + (tid & 31) * 2 + g) * 16 + i];
        for (int which = 0; which < 2; ++which) {
            const bf16* src = which ? Vb : Kb; bf16* dst = (which ? VT : KWT) + (size_t)unit * 65536;
            __syncthreads();
            if (which == 1 && tid < 256) NLOC[unit * 256 + tid] = red[16 + tid] + red[16 + 256 + tid];
            u32x4 ld[16];
#pragma unroll
            for (int i = 0; i < 16; ++i) { const int ch = tid + i * 512, row = ch >> 5, cc = ch & 31; ld[i] = *(const u32x4*)(src + (size_t)(tok0 + row) * DM + h * 256 + cc * 8); }
#pragma unroll
            for (int i = 0; i < 16; ++i) { const int ch = tid + i * 512, row = ch >> 5, cc = ch & 31;
                u32x4 v = ld[i];
                if (which) { const float x[8] = {bflo(v.x), bfhi(v.x), bflo(v.y), bfhi(v.y), bflo(v.z), bfhi(v.z), bflo(v.w), bfhi(v.w)}; float o[8];
#pragma unroll
                    for (int g = 0; g < 2; ++g)
#pragma unroll
                        for (int oo = 0; oo < 4; ++oo) { float a = 0.f;
#pragma unroll
                            for (int ii = 0; ii < 4; ++ii) a += x[g * 4 + ii] * wvb[g][ii * 4 + oo];
                            o[g * 4 + oo] = a; }
                    v.x = pk2(o[0], o[1]); v.y = pk2(o[2], o[3]); v.z = pk2(o[4], o[5]); v.w = pk2(o[6], o[7]); }
                unsigned* d = (unsigned*)(tile + row * TP + cc * 8); d[0] = v.x; d[1] = v.y; d[2] = v.z; d[3] = v.w; }
            __syncthreads();
            if (which == 0) { const int dd = tid & 255, hs = tid >> 8; float s0 = 0.f, s1 = 0.f;
#pragma unroll 8
                for (int r = hs * 128; r < hs * 128 + 128; r += 2) { s0 += bf2f(tile[r * TP + dd]) * wts[r]; s1 += bf2f(tile[(r + 1) * TP + dd]) * wts[r + 1]; }
                red[16 + hs * 256 + dd] = s0 + s1; }
            for (int i = 0; i < 8; ++i) {
                const int blk = wave + i * 8;
                const int d = (blk >> 2) * 16 + 2 * (lane >> 3), sc = (blk & 3) * 8 + (lane & 7);
                float e0[8], e1[8];
#pragma unroll
                for (int j = 0; j < 8; ++j) { const unsigned w2 = *(const unsigned*)(tile + (sc * 8 + j) * TP + d); e0[j] = bflo(w2); e1[j] = bfhi(w2); }
                if (which == 0) { const f32x4 wa = *(const f32x4*)(wts + sc * 8), wb = *(const f32x4*)(wts + sc * 8 + 4); const float ww[8] = {wa.x, wa.y, wa.z, wa.w, wb.x, wb.y, wb.z, wb.w};
#pragma unroll
                    for (int j = 0; j < 8; ++j) { e0[j] *= ww[j]; e1[j] *= ww[j]; } }
                u32x4 o; o.x = pk2(e0[0], e0[1]); o.y = pk2(e0[2], e0[3]); o.z = pk2(e0[4], e0[5]); o.w = pk2(e0[6], e0[7]);
                *(u32x4*)(dst + (size_t)d * 256 + sc * 8) = o;
                o.x = pk2(e1[0], e1[1]); o.y = pk2(e1[2], e1[3]); o.z = pk2(e1[4], e1[5]); o.w = pk2(e1[6], e1[7]);
                *(u32x4*)(dst + (size_t)(d + 1) * 256 + sc * 8) = o;
            }
        }
        __syncthreads();
    }
}
__device__ void ph_scan(const P& p) {
    const bf16* UT = wsp<bf16>(p, O_UT); bf16* CT = wsp<bf16>(p, O_CT);
    const float* UN = wsp<float>(p, WS_UNITS); const float* NLOC = wsp<float>(p, WS_NLOC); float* NS = wsp<float>(p, WS_NS);
    const int tid = otid(), nth = gridDim.x * blockDim.x;
    for (int e8 = blockIdx.x * blockDim.x + tid; e8 < 16 * 8192; e8 += nth) {
        const int bh = e8 >> 13, idx = e8 & 8191; const size_t off = (size_t)idx * 8;
        const int ne = ((e8 >> 9) & 15) * 16 + tid; const bool hasn = tid < 16;
        float C[8]; float m = 0.f, n = 0.f;
#pragma unroll
        for (int j = 0; j < 8; ++j) C[j] = 0.f;
        for (int c0 = 0; c0 < NCH; c0 += 8) {
            u32x4 uu[8]; float am[8], bl[8], nl[8];
#pragma unroll
            for (int q = 0; q < 8; ++q) { const int unit = bh * 32 + c0 + q; uu[q] = *(const u32x4*)(UT + (size_t)unit * 65536 + off); am[q] = UN[unit * 2]; bl[q] = UN[unit * 2 + 1]; nl[q] = hasn ? NLOC[unit * 256 + ne] : 0.f; }
#pragma unroll
            for (int q = 0; q < 8; ++q) {
                const int unit = bh * 32 + c0 + q; const float amax = am[q], blast = bl[q]; const u32x4 u = uu[q];
                const float f1 = __expf(m - amax);
                u32x4 o; o.x = pk2(C[0] * f1, C[1] * f1); o.y = pk2(C[2] * f1, C[3] * f1); o.z = pk2(C[4] * f1, C[5] * f1); o.w = pk2(C[6] * f1, C[7] * f1);
                *(u32x4*)(CT + (size_t)unit * 65536 + off) = o;
                if (hasn) NS[unit * 256 + ne] = n * f1;
                const float mnew = blast + fmaxf(m, amax), d1 = __expf(blast + m - mnew), d2 = __expf(blast + amax - mnew);
                C[0] = d1 * C[0] + d2 * bflo(u.x); C[1] = d1 * C[1] + d2 * bfhi(u.x); C[2] = d1 * C[2] + d2 * bflo(u.y); C[3] = d1 * C[3] + d2 * bfhi(u.y);
                C[4] = d1 * C[4] + d2 * bflo(u.z); C[5] = d1 * C[5] + d2 * bfhi(u.z); C[6] = d1 * C[6] + d2 * bflo(u.w); C[7] = d1 * C[7] + d2 * bfhi(u.w);
                n = d1 * n + d2 * nl[q];
                m = mnew;
            }
        }
    }
}
constexpr int RP = 1032;
__device__ void ph_wprime(const P& p, float* lds) {
    const int tid = otid();
    const float* mod = wsp<float>(p, WS_MOD); const float* wr = p.in[I_WR]; const float* gm = p.in[I_GMOE];
    bf16* img = wsp<bf16>(p, WS_WPR); float* cstg = (float*)(img + 4 * 2 * 32 * RP);
    for (int it = blockIdx.x; it < 128; it += gridDim.x) {
        const int b = it >> 5, e = it & 31; const float* sc = mod + b * DIN + 4096; const float* sh = mod + b * DIN + 3072;
        float a = 0.f;
#pragma unroll
        for (int q = 0; q < 2; ++q) { const int k = tid + q * 512; const float w = wr[k * 32 + e]; const float v = w * gm[k] * (1.f + sc[k]); const unsigned h = f2bf(v);
            img[((size_t)(b * 2 + 0) * 32 + e) * RP + k] = (bf16)h; img[((size_t)(b * 2 + 1) * 32 + e) * RP + k] = (bf16)f2bf(v - bf2f(h)); a += sh[k] * w; }
        a = wave_sum(a);
        if ((tid & 63) == 0) lds[tid >> 6] = a;
        __syncthreads();
        if (tid == 0) { float t = p.in[I_BR][e];
#pragma unroll
            for (int w = 0; w < 8; ++w) t += lds[w];
            cstg[b * 32 + e] = t; }
        __syncthreads();
    }
}
__device__ void ph_router(const P& p, float* lds) {
    const int tid = otid(), lane = tid & 63, wave = tid >> 6, tok = lane & 15, kg = lane >> 4;
    bf16* Wh = (bf16*)lds; bf16* Wl = Wh + 32 * RP;
    float* lg = lds + 33024 + wave * 512;
    float* cst = lds + 33024 + 4096;
    int* cnt = (int*)(cst + 32);
    float* rinv = cst + 64 + wave * 16;
    float* red = cst + 64 + 128;
    const bf16* X1 = wsp<bf16>(p, O_X1); const float* mod = wsp<float>(p, WS_MOD); unsigned char* HM = wsp<unsigned char>(p, O_HM);
    int* TOPI = wsp<int>(p, WS_TOPI); float* TOPW = wsp<float>(p, WS_TOPW); int* CNT = wsp<int>(p, WS_CNT);
    const float* wr = p.in[I_WR]; const float* gm = p.in[I_GMOE];
    for (int blk = blockIdx.x; blk < T / 128; blk += gridDim.x) {
        const int b = (blk * 128) / SEQ; const float* sc = mod + b * DIN + 4096; const float* sh = mod + b * DIN + 3072;
        { const u32x4* src = (const u32x4*)(wsp<bf16>(p, WS_WPR) + (size_t)b * 2 * 32 * RP); u32x4* dst = (u32x4*)Wh;
            u32x4 im[16], imt = {0u, 0u, 0u, 0u};
#pragma unroll
            for (int i = 0; i < 16; ++i) im[i] = src[tid + i * 512];
            if (tid < 64) imt = src[tid + 8192];
            asm volatile("" ::: "memory");
#pragma unroll
            for (int i = 0; i < 16; ++i) dst[tid + i * 512] = im[i];
            if (tid < 64) dst[tid + 8192] = imt;
            if (tid < 32) { cst[tid] = ((const float*)(wsp<bf16>(p, WS_WPR) + 4 * 2 * 32 * RP))[b * 32 + tid]; cnt[tid] = 0; }
            float* GH = lds + 33024;
#pragma unroll
            for (int q = 0; q < 2; ++q) { const int k = tid + q * 512; GH[k] = gm[k] * (1.f + sc[k]); GH[1024 + k] = sh[k] * S_HM; } }
        __syncthreads();
        const int tb = blk * 128 + wave * 16;
        {
            const bf16* xr = X1 + (size_t)(tb + tok) * DM + kg * 8;
            u32x4 xv[32];
#pragma unroll
            for (int ks = 0; ks < 32; ++ks) xv[ks] = *(const u32x4*)(xr + ks * 32);
            float rr;
            { const f32x4* sp = (const f32x4*)(wsp<float>(p, WS_SSQ) + (size_t)(tb + tok) * 16); const f32x4 a = sp[0], b4 = sp[1], c4 = sp[2], d4 = sp[3];
              asm volatile("" ::: "memory");
              const float ss = ((a.x + a.y) + (a.z + a.w)) + ((b4.x + b4.y) + (b4.z + b4.w)) + ((c4.x + c4.y) + (c4.z + c4.w)) + ((d4.x + d4.y) + (d4.z + d4.w));
              rr = rsqrtf(ss * (1.f / DM) + EPS); }
            if (kg == 0) rinv[tok] = rr;
            const float rs = rr * S_HM;
            unsigned char* ho = HM + (size_t)(tb + tok) * DM + kg * 8;
            f32x4 acc0 = {0.f, 0.f, 0.f, 0.f}, acc1 = {0.f, 0.f, 0.f, 0.f};
            const bf16* wh0 = Wh + tok * RP + kg * 8; const bf16* wl0 = Wl + tok * RP + kg * 8;
#pragma unroll
            for (int ks = 0; ks < 32; ++ks) {
                const u32x4 xw = xv[ks];
                const f32x4 x0 = (f32x4){bflo(xw.x), bfhi(xw.x), bflo(xw.y), bfhi(xw.y)}, x1 = (f32x4){bflo(xw.z), bfhi(xw.z), bflo(xw.w), bfhi(xw.w)};
                { const int k0 = ks * 32 + kg * 8;
                  const float* GH = lds + 33024 + k0;
                  const f32x4 h0 = x0 * rs * *(const f32x4*)GH + *(const f32x4*)(GH + 1024), h1 = x1 * rs * *(const f32x4*)(GH + 4) + *(const f32x4*)(GH + 1028);
                  u32x2 w8; w8.x = pk4_fp8(h0.x, h0.y, h0.z, h0.w); w8.y = pk4_fp8(h1.x, h1.y, h1.z, h1.w); *(u32x2*)(ho + ks * 32) = w8; }
                const bf16x8v ah = __builtin_bit_cast(bf16x8v, xw);
                const bf16x8v bh0 = *(const bf16x8v*)(wh0 + ks * 32), bl0 = *(const bf16x8v*)(wl0 + ks * 32);
                const bf16x8v bh1 = *(const bf16x8v*)(wh0 + 16 * RP + ks * 32), bl1 = *(const bf16x8v*)(wl0 + 16 * RP + ks * 32);
                acc0 = __builtin_amdgcn_mfma_f32_16x16x32_bf16(ah, bh0, acc0, 0, 0, 0); acc1 = __builtin_amdgcn_mfma_f32_16x16x32_bf16(ah, bh1, acc1, 0, 0, 0);
                acc0 = __builtin_amdgcn_mfma_f32_16x16x32_bf16(ah, bl0, acc0, 0, 0, 0); acc1 = __builtin_amdgcn_mfma_f32_16x16x32_bf16(ah, bl1, acc1, 0, 0, 0);
            }
            __syncthreads();
#pragma unroll
            for (int r = 0; r < 4; ++r) { lg[(kg * 4 + r) * 32 + tok] = acc0[r]; lg[(kg * 4 + r) * 32 + 16 + tok] = acc1[r]; }
        }
        __builtin_amdgcn_s_waitcnt(0xc07f); asm volatile("" ::: "memory");
        if (lane < 16) {
            const float rr = rinv[lane]; float v[32];
#pragma unroll
            for (int e4 = 0; e4 < 8; ++e4) { const f32x4 t4 = *(const f32x4*)(lg + lane * 32 + e4 * 4), c4 = *(const f32x4*)(cst + e4 * 4);
                v[e4 * 4] = rr * t4.x + c4.x; v[e4 * 4 + 1] = rr * t4.y + c4.y; v[e4 * 4 + 2] = rr * t4.z + c4.z; v[e4 * 4 + 3] = rr * t4.w + c4.w; }
            float tv[4]; int ti[4];
#pragma unroll
            for (int k = 0; k < 4; ++k) { float m = v[0]; int idx = 0;
#pragma unroll
                for (int e = 1; e < 32; ++e) { if (v[e] > m) { m = v[e]; idx = e; } }
                tv[k] = m; ti[k] = idx;
#pragma unroll
                for (int e = 0; e < 32; ++e) if (e == idx) v[e] = -INFINITY; }
            const float e1 = __expf(tv[1] - tv[0]), e2 = __expf(tv[2] - tv[0]), e3 = __expf(tv[3] - tv[0]), inv = 1.f / (1.f + e1 + e2 + e3);
            const int t = tb + lane;
            *(int4*)(TOPI + t * 4) = make_int4(ti[0], ti[1], ti[2], ti[3]);
            *(f32x4*)(TOPW + t * 4) = (f32x4){inv, e1 * inv, e2 * inv, e3 * inv};
            atomicAdd(&cnt[ti[0]], 1); atomicAdd(&cnt[ti[1]], 1); atomicAdd(&cnt[ti[2]], 1); atomicAdd(&cnt[ti[3]], 1);
        }
        __syncthreads();
        if (tid < 32) CNT[blk * 32 + tid] = cnt[tid];
        __syncthreads();
    }
}
__device__ void ph_scatter(const P& p, float* lds) {
    const int tid = otid(), lane = tid & 63, wave = tid >> 6;
    int* tot = (int*)lds; int* pre = tot + 32; int* startp = tot + 64; int* wc = tot + 128;
    const int* CNT = wsp<int>(p, WS_CNT); const int* TOPI = wsp<int>(p, WS_TOPI);
    float* ROWW = wsp<float>(p, WS_ROWSLOT); int* TILEE = wsp<int>(p, WS_TILEE);
    int* ROWTOK = wsp<int>(p, WS_ROWTOK); int* POS = wsp<int>(p, WS_DEN); const float* TOPW = wsp<float>(p, WS_TOPW);
    for (int blk = blockIdx.x; blk < T / 128; blk += gridDim.x) {
        { const int e = tid & 31, g = tid >> 5; int a = 0, b = 0, cv[16];
#pragma unroll
            for (int q = 0; q < 16; ++q) cv[q] = CNT[(g + 16 * q) * 32 + e];
            asm volatile("" ::: "memory");
#pragma unroll
            for (int q = 0; q < 16; ++q) { const int j = g + 16 * q; a += cv[q]; if (j < blk) b += cv[q]; }
            wc[g * 32 + e] = a; wc[512 + g * 32 + e] = b; }
        __syncthreads();
        if (tid < 32) { int a = 0, b = 0;
#pragma unroll
            for (int g = 0; g < 16; ++g) { a += wc[g * 32 + tid]; b += wc[512 + g * 32 + tid]; }
            tot[tid] = a; pre[tid] = b; }
        __syncthreads();
        if (tid == 0) { int s = 0; for (int e = 0; e < 32; ++e) { startp[e] = s; s += (tot[e] + 255) & ~255; } startp[32] = s; }
        __syncthreads();
        if (blk < 32) {
            const int e = blk, s0 = startp[e], s1 = startp[e + 1];
            if (blk == 0 && tid == 0) TILEE[MAXTILES] = startp[32] >> 8;
            for (int tl = (s0 >> 8) + tid; tl < (s1 >> 8); tl += 512) TILEE[tl] = e;
            for (int r = s0 + tot[e] + tid; r < s1; r += 512) { ROWW[r] = 0.f; ROWTOK[r] = 0; }
        }
        const int slot = blk * 512 + tid, e = TOPI[slot]; const float wgt = TOPW[slot];
        int lrank = 0;
        for (int ee = 0; ee < 32; ++ee) { const unsigned long long m = __ballot(e == ee);
            if (e == ee) lrank = __popcll(m & ((1ull << lane) - 1ull));
            if (lane == 0) wc[wave * 32 + ee] = __popcll(m); }
        __syncthreads();
        int base = startp[e] + pre[e] + lrank;
        for (int w = 0; w < wave; ++w) base += wc[w * 32 + e];
        __syncthreads();
        ROWW[base] = wgt; ROWTOK[base] = slot >> 2; POS[slot] = base;
        __syncthreads();
    }
}
__device__ void ph_final(const P& p) {
    const int tid = otid(), lane = tid & 63, gw = blockIdx.x * 8 + (tid >> 6), NGW = gridDim.x * 8;
    const bf16* X1 = wsp<bf16>(p, O_X1); const unsigned char* Y = wsp<unsigned char>(p, O_Y); const float* mod = wsp<float>(p, WS_MOD);
    const int4* POS = (const int4*)wsp<int>(p, WS_DEN);
    f32x4 gfin[4];
#pragma unroll
    for (int q = 0; q < 4; ++q) gfin[q] = ((const f32x4*)p.in[I_GFIN])[4 * lane + q];
    int t = gw; int bcur = -1; f32x4 g2[4] = {};
    if (t >= T) return;
    int tt[2] = {t, t + NGW < T ? t + NGW : t};
    int4 p4[2]; u32x4 y[2][4], xw[2][2];
#pragma unroll
    for (int r = 0; r < 2; ++r) p4[r] = POS[tt[r]];
#pragma unroll
    for (int r = 0; r < 2; ++r) { const int pos[4] = {p4[r].x, p4[r].y, p4[r].z, p4[r].w};
#pragma unroll
        for (int k = 0; k < 4; ++k) y[r][k] = *(const u32x4*)(Y + (size_t)pos[k] * DM + 16 * lane);
        xw[r][0] = ((const u32x4*)(X1 + (size_t)tt[r] * DM))[2 * lane]; xw[r][1] = ((const u32x4*)(X1 + (size_t)tt[r] * DM))[2 * lane + 1]; }
    for (; t < T; t += 2 * NGW) {
        const bool two = t + NGW < T;
        const int tn = t + 2 * NGW; const bool more = tn < T;
        int tn2[2] = {more ? tn : t, (more && tn + NGW < T) ? tn + NGW : (more ? tn : t)};
        int4 p4n[2]; u32x4 yn[2][4], xn[2][2];
#pragma unroll
        for (int r = 0; r < 2; ++r) p4n[r] = POS[tn2[r]];
#pragma unroll
        for (int r = 0; r < 2; ++r) { const int pos[4] = {p4n[r].x, p4n[r].y, p4n[r].z, p4n[r].w};
#pragma unroll
            for (int k = 0; k < 4; ++k) yn[r][k] = *(const u32x4*)(Y + (size_t)pos[k] * DM + 16 * lane);
            xn[r][0] = ((const u32x4*)(X1 + (size_t)tn2[r] * DM))[2 * lane]; xn[r][1] = ((const u32x4*)(X1 + (size_t)tn2[r] * DM))[2 * lane + 1]; }
        asm volatile("" ::: "memory");
#pragma unroll
        for (int r = 0; r < 2; ++r) {
            { const int bb_ = __builtin_amdgcn_readfirstlane(tt[r] / SEQ);
              if (bb_ != bcur) { const float* gt2 = mod + bb_ * DIN + 5120 + 16 * lane;
#pragma unroll
                  for (int q = 0; q < 4; ++q) g2[q] = ((const f32x4*)gt2)[q] * (1.f / S_Y);
                  bcur = bb_; } }
            float a[16];
#pragma unroll
            for (int q = 0; q < 16; ++q) a[q] = 0.f;
#pragma unroll
            for (int k = 0; k < 4; ++k)
#pragma unroll
                for (int q = 0; q < 4; ++q) { const int w = (int)y[r][k][q]; const f32x2_ lo = __builtin_amdgcn_cvt_pk_f32_fp8(w, false), hi = __builtin_amdgcn_cvt_pk_f32_fp8(w, true);
                    a[4 * q] += lo[0]; a[4 * q + 1] += lo[1]; a[4 * q + 2] += hi[0]; a[4 * q + 3] += hi[1]; }
            f32x4 v[4]; float s = 0.f;
#pragma unroll
            for (int q = 0; q < 4; ++q) { const u32x4 xq = xw[r][q >> 1]; const unsigned w0 = (q & 1) ? xq.z : xq.x, w1 = (q & 1) ? xq.w : xq.y;
                const f32x4 g = g2[q];
                v[q] = (f32x4){bflo(w0), bfhi(w0), bflo(w1), bfhi(w1)} + g * (f32x4){a[4 * q], a[4 * q + 1], a[4 * q + 2], a[4 * q + 3]};
                s += (v[q].x * v[q].x + v[q].y * v[q].y) + (v[q].z * v[q].z + v[q].w * v[q].w); }
            const float rn = rsqrtf(wave_sum(s) * (1.f / DM) + EPS);
            if (r == 0 || two) {
#pragma unroll
                for (int q = 0; q < 4; ++q) ((f32x4*)(p.out + (size_t)tt[r] * DM))[4 * lane + q] = v[q] * rn * gfin[q]; }
        }
#pragma unroll
        for (int r = 0; r < 2; ++r) { tt[r] = tn2[r]; xw[r][0] = xn[r][0]; xw[r][1] = xn[r][1];
#pragma unroll
            for (int k = 0; k < 4; ++k) y[r][k] = yn[r][k]; }
    }
}
__device__ __forceinline__ void unit_dec(int unit, int& tok0, int& h) { const int b = unit >> 7; h = (unit >> 5) & 3; tok0 = b * SEQ + (unit & 31) * CH; }

namespace pg8 {
typedef short bf16x8 __attribute__((ext_vector_type(8)));
constexpr int BM = 256, BK = 64, HALF = 128, HTB = HALF * BK * 2, STAGE_BYTES = 8 * HTB, NXCD = 8, WGM = 8;
__host__ __device__ __forceinline__ int lds_byte(int r, int c) { const int st = (r >> 4) * 2 + (c >> 5), rr = r & 15, cc = c & 31, ob = rr * 64 + cc * 2; return st * 1024 + (ob ^ (((ob >> 9) & 1) << 5)); }
__host__ __device__ __forceinline__ void stage_rc(int b, int& R, int& C) { const int st = b / 1024, sb = b % 1024, swz = sb ^ (((sb >> 9) & 1) << 5); R = (st >> 1) * 16 + swz / 64; C = (st & 1) * 32 + (swz % 64) / 2; }
__host__ __device__ __forceinline__ int perm32(int rho) { const int n = rho >> 4, i = rho & 15; return 8 * (i >> 2) + 4 * n + (i & 3); }
struct Unit { const char* a0; const char* a1; const char* b0; const char* b1; int pm, pn; };
struct Gemm { int lda, ldb, nt, nth; const int* rowtok; };
__device__ __forceinline__ unsigned cvt_pk_bf16(float lo, float hi) { unsigned r; asm volatile("v_cvt_pk_bf16_f32 %0, %1, %2" : "=v"(r) : "v"(lo), "v"(hi)); return r; }
__device__ __forceinline__ u32x4 pack8(const f32x4 v0, const f32x4 v1) { u32x4 w; w.x = cvt_pk_bf16(v0[0], v0[1]); w.y = cvt_pk_bf16(v0[2], v0[3]); w.z = cvt_pk_bf16(v1[0], v1[1]); w.w = cvt_pk_bf16(v1[2], v1[3]); return w; }

typedef int v4i_t __attribute__((ext_vector_type(4))); typedef int v8i_t __attribute__((ext_vector_type(8)));
__device__ __forceinline__ v8i_t cat8(const bf16x8 a, const bf16x8 b) { return __builtin_shufflevector(__builtin_bit_cast(v4i_t, a), __builtin_bit_cast(v4i_t, b), 0, 1, 2, 3, 4, 5, 6, 7); }
template <class Epi, class Sched, bool ALIGN_EPI, bool SPLITK = false, bool GATHER = false, bool FP8 = false>
__device__ __forceinline__ void gemm_phase(LAS unsigned char* lds, const Gemm g, const Sched& S, const Epi& E) {
    const int tid = otid(), wid = __builtin_amdgcn_readfirstlane(tid >> 6), lane = tid & 63, wr = wid >> 2, wc = wid & 3, fr = lane & 15, fq = lane >> 4;
    const int nt = g.nt, nth = g.nth;
    unsigned voffA[2], voffB[2];
#pragma unroll
    for (int i = 0; i < 2; ++i) { int R, C; stage_rc(tid * 16 + i * 8192, R, C); const int Rb = Epi::PERM ? ((R & ~31) + perm32(R & 31)) : R;
        voffA[i] = (unsigned)(R * g.lda + C) * 2u; voffB[i] = (unsigned)(Rb * g.ldb + C) * 2u; }
    LAS int* rt = (LAS int*)(lds + 131072); unsigned vC[2][2], vP[2][2];
    if constexpr (GATHER) { Unit uu; int rv[17];
#pragma unroll
        for (int i = 0; i < 17; ++i) { rv[i] = 0; if (S.next(i, uu)) rv[i] = (tid < 256) ? g.rowtok[uu.pm * 256 + tid] : 0; }
#pragma unroll
        for (int i = 0; i < 17; ++i) if (tid < 256) rt[i * 256 + tid] = rv[i];
        asm volatile("s_waitcnt vmcnt(0) lgkmcnt(0)" ::: "memory"); __builtin_amdgcn_s_barrier(); asm volatile("" ::: "memory"); }
#define PG8_ROWS(dst, iu) do { const int _t = otid(); _Pragma("unroll") for (int _i = 0; _i < 2; ++_i) { int _R, _C; stage_rc(_t * 16 + _i * 8192, _R, _C); _Pragma("unroll") for (int _h = 0; _h < 2; ++_h) dst[_h][_i] = (unsigned)rt[(iu) * 256 + _h * 128 + _R] * (unsigned)(g.lda * 2) + (unsigned)_C * 2u; } } while (0)
#define PG8_STAGE_A(bufoff, gbase, h, V) do { if constexpr (GATHER) { PG8_STAGE(bufoff, gbase, V[h]); } else { PG8_STAGE(bufoff, (gbase) + (h) * hstepA, voffA); } } while (0)
#define PG8_STAGE_A2(bufoff, gbase, h) do { if constexpr (GATHER) { if (last) { PG8_STAGE(bufoff, gbase, vP[h]); } else { PG8_STAGE(bufoff, gbase, vC[h]); } } else { PG8_STAGE(bufoff, (gbase) + (h) * hstepA, voffA); } } while (0)
    const size_t kstep = (size_t)(BK * 2);
    const size_t hstepA = (size_t)HALF * g.lda * 2, hstepB = (size_t)HALF * g.ldb * 2;
    const unsigned ldsw = (unsigned)wid * 1024u;
    const int aoff = lds_byte(wr * 64 + fr, fq * 8), boff = lds_byte(wc * 32 + fr, fq * 8);
    const int one8 = 0x7f7f7f7f;
    constexpr int F2 = 1024;
#define PG8_SA(b, h) (((b) * 2 + (h)) * HTB)
#define PG8_SB(b, h) ((4 + (b) * 2 + (h)) * HTB)
#define PG8_STAGE(bufoff, gbase, voff) do { _Pragma("unroll") for (int _i = 0; _i < 2; ++_i) \
        __builtin_amdgcn_global_load_lds((const unsigned*)((const char*)(gbase) + (voff)[_i]), (LAS unsigned*)(lds + (bufoff) + ldsw + _i * 8192), 16, 0, 0); } while (0)
#define PG8_LDA(dst, b, h) do { _Pragma("unroll") for (int m = 0; m < 4; ++m) { dst[m][0] = *(const LAS bf16x8*)(lds + PG8_SA(b, h) + aoff + m * 2048); dst[m][1] = *(const LAS bf16x8*)(lds + PG8_SA(b, h) + aoff + F2 + m * 2048); } } while (0)
#define PG8_LDB(dst, b, h) do { _Pragma("unroll") for (int n = 0; n < 2; ++n) { dst[n][0] = *(const LAS bf16x8*)(lds + PG8_SB(b, h) + boff + n * 2048); dst[n][1] = *(const LAS bf16x8*)(lds + PG8_SB(b, h) + boff + F2 + n * 2048); } } while (0)
#define PG8_MMA(ai, bj, At, Bt) do { __builtin_amdgcn_s_setprio(1); _Pragma("unroll") for (int m = 0; m < 4; ++m) _Pragma("unroll") for (int n = 0; n < 2; ++n) { \
        if constexpr (FP8) { const v8i_t b8_ = cat8(Bt[n][0], Bt[n][1]), a8_ = cat8(At[m][0], At[m][1]); asm volatile("v_mfma_scale_f32_16x16x128_f8f6f4 %0, %1, %2, %0, %3, %3 op_sel_hi:[0,0,0]" : "+v"(acc[ai][bj][m][n]) : "v"(b8_), "v"(a8_), "v"(one8)); } \
        else { _Pragma("unroll") for (int k = 0; k < 2; ++k) acc[ai][bj][m][n] = __builtin_amdgcn_mfma_f32_16x16x32_bf16(Bt[n][k], At[m][k], acc[ai][bj][m][n], 0, 0, 0); } } __builtin_amdgcn_s_setprio(0); } while (0)
#define PG8_WAIT_V(n) asm volatile("s_waitcnt vmcnt(" #n ")" ::: "memory")
#define PG8_WAIT_L(n) asm volatile("s_waitcnt lgkmcnt(" #n ")" ::: "memory")
#define PG8_BAR __builtin_amdgcn_s_barrier()
#define PG8_SCHED __builtin_amdgcn_sched_barrier(0)
    Unit cur, nxt; int ui = 0;
    if (!S.next(0, cur)) return;
    f32x4 acc[2][2][4][2];
#pragma unroll
    for (int a = 0; a < 2; ++a)
#pragma unroll
        for (int b = 0; b < 2; ++b)
#pragma unroll
            for (int m = 0; m < 4; ++m)
#pragma unroll
                for (int n = 0; n < 2; ++n) acc[a][b][m][n] = (f32x4){0.f, 0.f, 0.f, 0.f};
    bf16x8 At[4][2], B0[2][2], B1[2][2];
    {
        const char* cA = cur.a0; const char* cB = cur.b0;
        if constexpr (GATHER) { PG8_ROWS(vC, 0); }
        PG8_STAGE(PG8_SB(0, 0), cB, voffB); PG8_STAGE(PG8_SB(0, 1), cB + hstepB, voffB); PG8_STAGE_A(PG8_SA(0, 0), cA, 0, vC); PG8_STAGE_A(PG8_SA(0, 1), cA, 1, vC);
        if (wr == 1) PG8_BAR;
        PG8_WAIT_V(2); PG8_BAR;
        PG8_STAGE(PG8_SB(1, 0), cB + kstep, voffB); PG8_STAGE_A(PG8_SA(1, 0), cA + kstep, 0, vC); PG8_STAGE(PG8_SB(1, 1), cB + hstepB + kstep, voffB);
        PG8_WAIT_V(6); PG8_BAR;
    }
    for (;;) {
        const bool has_next = S.next(ui + 1, nxt);
        const char* nA = has_next ? nxt.a0 : cur.a0; const char* nB = has_next ? nxt.b0 : cur.b0;
        if constexpr (GATHER) { PG8_ROWS(vP, has_next ? ui + 1 : ui); }
#pragma unroll 1
        for (int t = 0; t < nt; t += 2) {
            const bool last = (t == nt - 2);
            const char *a1, *a2, *b2;
            if constexpr (SPLITK) {
                a1 = (t + 1 < nth) ? cur.a0 + (size_t)(t + 1) * kstep : cur.a1 + (size_t)(t + 1 - nth) * kstep;
                a2 = last ? nA : ((t + 2 < nth) ? cur.a0 + (size_t)(t + 2) * kstep : cur.a1 + (size_t)(t + 2 - nth) * kstep);
                b2 = last ? nB : ((t + 2 < nth) ? cur.b0 + (size_t)(t + 2) * kstep : cur.b1 + (size_t)(t + 2 - nth) * kstep);
            } else {
                a1 = cur.a0 + (size_t)(t + 1) * kstep; a2 = last ? nA : cur.a0 + (size_t)(t + 2) * kstep; b2 = last ? nB : cur.b0 + (size_t)(t + 2) * kstep;
            }
            const char* a3 = a2 + kstep; const char* b3 = b2 + kstep;
            PG8_LDB(B0, 0, 0); PG8_LDB(B1, 0, 1); PG8_SCHED; PG8_LDA(At, 0, 0); PG8_STAGE_A(PG8_SA(1, 1), a1, 1, vC);
            if constexpr (GATHER) { if (last) { _Pragma("unroll") for (int _h = 0; _h < 2; ++_h) _Pragma("unroll") for (int _i = 0; _i < 2; ++_i) vC[_h][_i] = vP[_h][_i]; } }
            PG8_WAIT_V(8); PG8_WAIT_L(0); PG8_BAR; PG8_MMA(0, 0, At, B0); PG8_MMA(0, 1, At, B1); PG8_BAR; PG8_SCHED;
            PG8_LDA(At, 0, 1); PG8_STAGE(PG8_SB(0, 0), b2, voffB); PG8_STAGE(PG8_SB(0, 1), b2 + hstepB, voffB); PG8_STAGE_A(PG8_SA(0, 0), a2, 0, vC);
            PG8_WAIT_V(8); PG8_WAIT_L(0); PG8_BAR; PG8_MMA(1, 0, At, B0); PG8_MMA(1, 1, At, B1); PG8_BAR; PG8_SCHED;
            PG8_LDB(B0, 1, 0); PG8_LDB(B1, 1, 1); PG8_SCHED; PG8_LDA(At, 1, 0); PG8_STAGE_A(PG8_SA(0, 1), a2, 1, vC);
            PG8_WAIT_V(8); PG8_WAIT_L(0); PG8_BAR; PG8_MMA(0, 0, At, B0); PG8_MMA(0, 1, At, B1); PG8_BAR; PG8_SCHED;
            PG8_LDA(At, 1, 1); PG8_STAGE(PG8_SB(1, 0), b3, voffB); PG8_STAGE(PG8_SB(1, 1), b3 + hstepB, voffB); PG8_STAGE_A(PG8_SA(1, 0), a3, 0, vC);
            PG8_WAIT_V(8); PG8_WAIT_L(0); PG8_BAR; PG8_MMA(1, 0, At, B0); PG8_MMA(1, 1, At, B1); PG8_BAR; PG8_SCHED;
            if constexpr (Epi::MID) { if (t + 2 == nth) { int fr_ = fr, fq_ = fq; asm volatile("" : "+v"(fr_), "+v"(fq_)); E.mid(acc, cur, wr, wc, fr_, fq_); } }
        }
        if constexpr (FP8) asm volatile("s_nop 15\n\ts_nop 15" ::: "memory");
        if constexpr (ALIGN_EPI) { if (wr == 0) PG8_BAR; }
        { int fr_ = fr, fq_ = fq; asm volatile("" : "+v"(fr_), "+v"(fq_)); E(acc, cur, wr, wc, fr_, fq_, lds); }
        if (!has_next) break;
#pragma unroll
        for (int a = 0; a < 2; ++a)
#pragma unroll
            for (int b = 0; b < 2; ++b)
#pragma unroll
                for (int m = 0; m < 4; ++m)
#pragma unroll
                    for (int n = 0; n < 2; ++n) acc[a][b][m][n] = (f32x4){0.f, 0.f, 0.f, 0.f};
        cur = nxt; ++ui;
        if constexpr (GATHER) {
#pragma unroll
            for (int _h = 0; _h < 2; ++_h)
#pragma unroll
                for (int _i = 0; _i < 2; ++_i) vC[_h][_i] = vP[_h][_i]; }
        if constexpr (ALIGN_EPI) { if (wr == 1) PG8_BAR; }
    }
    PG8_WAIT_V(0);
    if constexpr (!ALIGN_EPI) { if (wr == 0) PG8_BAR; }
    PG8_BAR;
#undef PG8_SA
#undef PG8_SB
#undef PG8_STAGE
#undef PG8_STAGE_A
#undef PG8_STAGE_A2
#undef PG8_ROWS
#undef PG8_LDA
#undef PG8_LDB
#undef PG8_MMA
#undef PG8_WAIT_V
#undef PG8_WAIT_L
#undef PG8_BAR
#undef PG8_SCHED
}
struct DenseOrder {
    int nM, nN, nwg, G, c; const char* A; const char* B; const char* A1; const char* B1; size_t tA, tB; bool revm = false;
    __device__ void init(int nM_, int nN_, int G_, int c_, const void* A_, int lda, const void* B_, int ldb) { nM = nM_; nN = nN_; nwg = nM * nN; G = G_; c = c_; A = (const char*)A_; B = (const char*)B_; A1 = A; B1 = B; tA = (size_t)BM * lda * 2; tB = (size_t)BM * ldb * 2; }
    __device__ __forceinline__ bool tile(int i, int& pm, int& pn) const {
        const long L = (long)i * G + c; if (L >= nwg) return false;
        int wgid = (int)L; { const int q = nwg / NXCD, r = nwg % NXCD, xcd = wgid % NXCD, off = wgid / NXCD; wgid = (xcd < r ? xcd * (q + 1) : r * (q + 1) + (xcd - r) * q) + off; }
        const int nig = WGM * nN, gid = wgid / nig, fm = gid * WGM, gsz = (nM - fm) < WGM ? (nM - fm) : WGM;
        pm = fm + ((wgid % nig) % gsz); pn = (wgid % nig) / gsz; return true;
    }
    __device__ __forceinline__ bool next(int i, Unit& u) const { int pm, pn; if (!tile(i, pm, pn)) return false; if (revm) pm = nM - 1 - pm; u.pm = pm; u.pn = pn; u.a0 = A + pm * tA; u.b0 = B + pn * tB; u.a1 = A1 + pm * tA; u.b1 = B1 + pn * tB; return true; }
};
struct MoeOrder : DenseOrder {
    const LAS int* tile_e; bool gather, rev;
    __device__ __forceinline__ bool next(int i, Unit& u) const { int pm, pn; if (!tile(i, pm, pn)) return false; if (rev) pm = nM - 1 - pm; const int e = tile_e[pm];
        u.pm = pm; u.pn = pn; u.a0 = gather ? A : A + pm * tA; u.b0 = B + ((size_t)e * nN + pn) * tB; u.a1 = u.a0; u.b1 = u.b0; return true; }
};
template <int KIND> struct BatchOrder {
    int G, c; const char* ws;
    __device__ __forceinline__ bool next(int i, Unit& u) const {
        const int lin = i * G + c; if (lin >= NUNIT) return false;
        const int unit = KIND == 0 ? lin : NUNIT - 1 - lin;
        int t0, h; unit_dec(unit, t0, h); const size_t rowoff = ((size_t)t0 * DM + h * 256) * 2, uoff = (size_t)unit * 131072;
        u.pm = unit; u.pn = 0;
        if (KIND == 0) { u.a0 = ws + O_VT + uoff; u.b0 = ws + O_KWT + uoff; u.a1 = u.a0; u.b1 = u.b0; }
        else if (KIND == 1) { u.a0 = ws + O_XC + rowoff; u.b0 = ws + O_K + rowoff; u.a1 = u.a0; u.b1 = u.b0; }
        else { u.a0 = ws + O_SP + rowoff; u.a1 = ws + O_XC + rowoff; u.b0 = ws + O_VT + uoff; u.b1 = ws + O_CT + uoff; }
        return true;
    }
};
__device__ __forceinline__ f32x4 sig4(const f32x4 v) { f32x4 r; r[0] = sigm(v[0]); r[1] = sigm(v[1]); r[2] = sigm(v[2]); r[3] = sigm(v[3]); return r; }
__device__ __forceinline__ f32x4 lo4(const u32x4 w) { return (f32x4){bflo(w.x), bfhi(w.x), bflo(w.y), bfhi(w.y)}; }
__device__ __forceinline__ f32x4 hi4(const u32x4 w) { return (f32x4){bflo(w.z), bfhi(w.z), bflo(w.w), bfhi(w.w)}; }
typedef f32x4 Acc[2][2][4][2];
struct EpiIn {
    static constexpr bool MID = false; static constexpr bool PERM = true; unsigned char* ws;
    __device__ __forceinline__ void operator()(const Acc& acc, const Unit& u, int wr, int wc, int fr, int fq, LAS unsigned char*) const {
        const int row0 = u.pm * BM + wr * 64 + fr;
        if (u.pn < 8) {
            bf16* O = (bf16*)(ws + O_U1) + u.pn * 128 + wc * 32 + 8 * fq;
#pragma unroll
            for (int ai = 0; ai < 2; ++ai)
#pragma unroll
                for (int m = 0; m < 4; ++m) { const f32x4 v0 = acc[ai][0][m][0] * sig4(acc[ai][1][m][0]), v1 = acc[ai][0][m][1] * sig4(acc[ai][1][m][1]);
                    *(u32x4*)(O + (size_t)(row0 + ai * HALF + m * 16) * DM) = pack8(v0, v1); }
        } else if (u.pn >= 16) {
            const size_t co = (size_t)(u.pn - 16) * 128 + wc * 32 + 8 * fq;
            bf16* OR = (bf16*)(ws + O_SZA) + co; bf16* OB = (bf16*)(ws + O_SZB) + co;
#pragma unroll
            for (int ai = 0; ai < 2; ++ai)
#pragma unroll
                for (int m = 0; m < 4; ++m) { f32x4 r[2], sb[2];
#pragma unroll
                    for (int n = 0; n < 2; ++n)
#pragma unroll
                        for (int q = 0; q < 4; ++q) { const float da = 1.f + __expf(-acc[ai][0][m][n][q]), db = 1.f + __expf(-fmaxf(acc[ai][1][m][n][q], -30.f));
                            sb[n][q] = __builtin_amdgcn_rcpf(db); r[n][q] = db * __builtin_amdgcn_rcpf(da); }
                    *(u32x4*)(OR + (size_t)(row0 + ai * HALF + m * 16) * DM) = pack8(r[0], r[1]);
                    *(u32x4*)(OB + (size_t)(row0 + ai * HALF + m * 16) * DM) = pack8(sb[0], sb[1]); }
        } else {
            const int t = (u.pn - 8) >> 2; const size_t so = t == 0 ? O_XM : O_SO;
            bf16* O = (bf16*)(ws + so) + ((u.pn - 8) & 3) * 256 + wc * 32 + 8 * fq;
#pragma unroll
            for (int ai = 0; ai < 2; ++ai)
#pragma unroll
                for (int m = 0; m < 4; ++m)
#pragma unroll
                    for (int bj = 0; bj < 2; ++bj) { f32x4 v0 = acc[ai][bj][m][0], v1 = acc[ai][bj][m][1]; if (t > 0) { v0 = sig4(v0); v1 = sig4(v1); }
                        *(u32x4*)(O + (size_t)(row0 + ai * HALF + m * 16) * DM + bj * HALF) = pack8(v0, v1); }
        }
    }
};
__device__ __forceinline__ f32x4 rcp4(const f32x4 v) { f32x4 r; r[0] = __builtin_amdgcn_rcpf(v[0]); r[1] = __builtin_amdgcn_rcpf(v[1]); r[2] = __builtin_amdgcn_rcpf(v[2]); r[3] = __builtin_amdgcn_rcpf(v[3]); return r; }
struct EpiPwMo {
    static constexpr bool MID = true; static constexpr bool PERM = true; unsigned char* ws; const float* bias;
    __device__ __forceinline__ void mid(Acc& acc, const Unit& u, int wr, int wc, int fr, int fq) const {
        const int row0 = u.pm * BM + wr * 64 + fr, col0 = u.pn * BM + wc * 32 + 8 * fq;
        f32x4 bb[2][2];
#pragma unroll
        for (int bj = 0; bj < 2; ++bj) { bb[bj][0] = *(const f32x4*)(bias + col0 + bj * HALF); bb[bj][1] = *(const f32x4*)(bias + col0 + bj * HALF + 4); }
#pragma unroll
        for (int ai = 0; ai < 2; ++ai) {
            u32x4 z[4][2];
#pragma unroll
            for (int m = 0; m < 4; ++m)
#pragma unroll
                for (int bj = 0; bj < 2; ++bj) z[m][bj] = *(const u32x4*)((const bf16*)(ws + O_SZA) + (size_t)(row0 + ai * HALF + m * 16) * DM + col0 + bj * HALF);
            asm volatile("" ::: "memory");
#pragma unroll
            for (int m = 0; m < 4; ++m)
#pragma unroll
                for (int bj = 0; bj < 2; ++bj) { acc[ai][bj][m][0] = (acc[ai][bj][m][0] + bb[bj][0]) * lo4(z[m][bj]); acc[ai][bj][m][1] = (acc[ai][bj][m][1] + bb[bj][1]) * hi4(z[m][bj]); }
            asm volatile("" ::: "memory");
        }
    }
    __device__ __forceinline__ void operator()(const Acc& acc, const Unit& u, int wr, int wc, int fr, int fq, LAS unsigned char*) const {
        const int row0 = u.pm * BM + wr * 64 + fr, col0 = u.pn * BM + wc * 32 + 8 * fq;
#pragma unroll
        for (int ai = 0; ai < 2; ++ai) {
            u32x4 z[4][2];
#pragma unroll
            for (int m = 0; m < 4; ++m)
#pragma unroll
                for (int bj = 0; bj < 2; ++bj) z[m][bj] = *(const u32x4*)((const bf16*)(ws + O_SZB) + (size_t)(row0 + ai * HALF + m * 16) * DM + col0 + bj * HALF);
            asm volatile("" ::: "memory");
#pragma unroll
            for (int m = 0; m < 4; ++m)
#pragma unroll
                for (int bj = 0; bj < 2; ++bj) { const size_t o = (size_t)(row0 + ai * HALF + m * 16) * DM + col0 + bj * HALF;
                    *(u32x4*)((bf16*)(ws + O_MERGED) + o) = pack8(lo4(z[m][bj]) * acc[ai][bj][m][0], hi4(z[m][bj]) * acc[ai][bj][m][1]); }
            asm volatile("" ::: "memory");
        }
    }
};
struct EpiOut {
    static constexpr bool MID = false; static constexpr bool PERM = true; unsigned char* ws; const float* x;
    __device__ __forceinline__ void operator()(const Acc& acc, const Unit& u, int wr, int wc, int fr, int fq, LAS unsigned char*) const {
        const int row0 = u.pm * BM + wr * 64 + fr, col0 = u.pn * BM + wc * 32 + 8 * fq, b = (u.pm * BM) / SEQ;
        const float* gt = (const float*)(ws + WS_MOD) + b * DIN + 2048; bf16* X1 = (bf16*)(ws + O_X1); float* ssq = (float*)(ws + WS_SSQ);
        f32x4 gv[2][2];
#pragma unroll
        for (int bj = 0; bj < 2; ++bj)
#pragma unroll
            for (int n = 0; n < 2; ++n) gv[bj][n] = *(const f32x4*)(gt + col0 + bj * HALF + n * 4);
#pragma unroll
        for (int am = 0; am < 4; ++am) {
            const int ai = am >> 1;
            f32x4 xr[2][2][2]; float sq[2] = {0.f, 0.f};
#pragma unroll
            for (int mm = 0; mm < 2; ++mm)
#pragma unroll
                for (int bj = 0; bj < 2; ++bj)
#pragma unroll
                    for (int n = 0; n < 2; ++n) xr[mm][bj][n] = *(const f32x4*)(x + (size_t)(row0 + ai * HALF + ((am & 1) * 2 + mm) * 16) * DM + col0 + bj * HALF + n * 4);
            asm volatile("" ::: "memory");
#pragma unroll
            for (int mm = 0; mm < 2; ++mm)
#pragma unroll
                for (int bj = 0; bj < 2; ++bj) { const int m = (am & 1) * 2 + mm;
                    const f32x4 v0 = xr[mm][bj][0] + gv[bj][0] * acc[ai][bj][m][0], v1 = xr[mm][bj][1] + gv[bj][1] * acc[ai][bj][m][1];
                    *(u32x4*)(X1 + (size_t)(row0 + ai * HALF + m * 16) * DM + col0 + bj * HALF) = pack8(v0, v1);
                    sq[mm] += ((v0[0] * v0[0] + v0[1] * v0[1]) + (v0[2] * v0[2] + v0[3] * v0[3])) + ((v1[0] * v1[0] + v1[1] * v1[1]) + (v1[2] * v1[2] + v1[3] * v1[3])); }
#pragma unroll
            for (int mm = 0; mm < 2; ++mm) { float q = sq[mm]; q += __shfl_xor(q, 16); q += __shfl_xor(q, 32);
                if (fq == 0) ssq[(size_t)(row0 + ai * HALF + ((am & 1) * 2 + mm) * 16) * 16 + u.pn * 4 + wc] = q; }
            asm volatile("" ::: "memory");
        }
    }
};
struct EpiU {
    static constexpr bool MID = false; static constexpr bool PERM = true; unsigned char* ws;
    __device__ __forceinline__ void operator()(const Acc& acc, const Unit& u, int wr, int wc, int fr, int fq, LAS unsigned char*) const {
        bf16* O = (bf16*)(ws + O_UT) + (size_t)u.pm * 65536 + (wr * 64 + fr) * 256 + wc * 32 + 8 * fq;
#pragma unroll
        for (int ai = 0; ai < 2; ++ai)
#pragma unroll
            for (int m = 0; m < 4; ++m)
#pragma unroll
                for (int bj = 0; bj < 2; ++bj) *(u32x4*)(O + (ai * HALF + m * 16) * 256 + bj * HALF) = pack8(acc[ai][bj][m][0], acc[ai][bj][m][1]);
    }
};
struct EpiS {
    static constexpr bool MID = false; static constexpr bool PERM = true; unsigned char* ws;
    __device__ __forceinline__ void operator()(const Acc& acc, const Unit& u, int wr, int wc, int fr, int fq, LAS unsigned char*) const {
        int t0, h; unit_dec(u.pm, t0, h);
        const int r0 = wr * 64 + fr, c0 = wc * 32 + 8 * fq;
        const float* cw = (const float*)(ws + WS_CW) + u.pm * 256 + c0; float* denp = (float*)(ws + WS_DENP) + (size_t)u.pm * 1024;
        bf16* O = (bf16*)(ws + O_SP) + (size_t)t0 * DM + h * 256 + c0;
        f32x4 w[2][2];
#pragma unroll
        for (int bj = 0; bj < 2; ++bj)
#pragma unroll
            for (int n = 0; n < 2; ++n) w[bj][n] = *(const f32x4*)(cw + bj * HALF + 4 * n);
#pragma unroll
        for (int ai = 0; ai < 2; ++ai)
#pragma unroll
            for (int m = 0; m < 4; ++m) { const int r = r0 + ai * HALF + m * 16; float rs = 0.f;
#pragma unroll
                for (int bj = 0; bj < 2; ++bj) { f32x4 v[2];
#pragma unroll
                    for (int n = 0; n < 2; ++n) { v[n] = acc[ai][bj][m][n] * w[bj][n]; const int c = c0 + bj * HALF + 4 * n;
#pragma unroll
                        for (int j = 0; j < 4; ++j) { if (c + j > r) v[n][j] = 0.f; rs += v[n][j]; } }
                    *(u32x4*)(O + (size_t)r * DM + bj * HALF) = pack8(v[0], v[1]); }
                rs += __shfl_xor(rs, 16); rs += __shfl_xor(rs, 32);
                if (fq == 0) denp[r * 4 + wc] = rs;
                asm volatile("" ::: "memory"); }
    }
};
struct EpiO {
    static constexpr bool MID = false; static constexpr bool PERM = true; unsigned char* ws; const float* hng; const float* skip;
    __device__ __forceinline__ void operator()(Acc& acc, const Unit& u, int wr, int wc, int fr, int fq, LAS unsigned char* lds) const {
        int t0, h; unit_dec(u.pm, t0, h);
        LAS float* inv = (LAS float*)(lds + 131072);
        LAS float* PS = inv + 256;
        LAS float* nsl = PS + 2048;
        const int tid = otid();
        const int r0 = wr * 64 + fr, c0 = wc * 32 + 8 * fq;
        if (tid < 256) {
            const f32x4 dp = *(const f32x4*)((const float*)(ws + WS_DENP) + (size_t)u.pm * 1024 + tid * 4); const float fl = ((const float*)(ws + WS_FLOOR))[u.pm * 256 + tid];
            const float den = nsl[(((NUNIT - 1 - u.pm) - (int)blockIdx.x) / (int)gridDim.x) * 256 + tid] + (dp[0] + dp[1]) + (dp[2] + dp[3]);
            inv[tid] = __builtin_amdgcn_rcpf(fmaxf(fabsf(den), fl)); }
        u32x4 gin[4][2];
        asm volatile("s_waitcnt lgkmcnt(0)" ::: "memory"); __builtin_amdgcn_s_barrier(); asm volatile("" ::: "memory");
#pragma unroll
        for (int ai = 0; ai < 2; ++ai) {
#pragma unroll
            for (int m = 0; m < 4; ++m)
#pragma unroll
                for (int bj = 0; bj < 2; ++bj) gin[m][bj] = *(const u32x4*)((const bf16*)(ws + O_SO) + (size_t)(t0 + r0 + ai * HALF + m * 16) * DM + h * 256 + c0 + bj * HALF);
            asm volatile("" ::: "memory");
#pragma unroll
            for (int m = 0; m < 4; ++m) { const int r = r0 + ai * HALF + m * 16; const float iv = inv[r]; float s = 0.f, q = 0.f;
#pragma unroll
                for (int bj = 0; bj < 2; ++bj) { const u32x4 so = gin[m][bj];
                    const f32x4 v0 = acc[ai][bj][m][0] * iv * lo4(so), v1 = acc[ai][bj][m][1] * iv * hi4(so); acc[ai][bj][m][0] = v0; acc[ai][bj][m][1] = v1;
                    s += (v0[0] + v0[1]) + (v0[2] + v0[3]) + (v1[0] + v1[1]) + (v1[2] + v1[3]);
                    q += (v0[0] * v0[0] + v0[1] * v0[1]) + (v0[2] * v0[2] + v0[3] * v0[3]) + (v1[0] * v1[0] + v1[1] * v1[1]) + (v1[2] * v1[2] + v1[3] * v1[3]); }
                s += __shfl_xor(s, 16); s += __shfl_xor(s, 32); q += __shfl_xor(q, 16); q += __shfl_xor(q, 32);
                if (fq == 0) { PS[(r * 4 + wc) * 2] = s; PS[(r * 4 + wc) * 2 + 1] = q; } }
            asm volatile("" ::: "memory");
        }
        asm volatile("s_waitcnt lgkmcnt(0)" ::: "memory"); __builtin_amdgcn_s_barrier(); asm volatile("" ::: "memory");
#pragma unroll
        for (int ai = 0; ai < 2; ++ai) {
#pragma unroll
            for (int m = 0; m < 4; ++m)
#pragma unroll
                for (int bj = 0; bj < 2; ++bj) gin[m][bj] = *(const u32x4*)((const bf16*)(ws + O_XC) + (size_t)(t0 + r0 + ai * HALF + m * 16) * DM + h * 256 + c0 + bj * HALF);
            asm volatile("" ::: "memory");
#pragma unroll
            for (int m = 0; m < 4; ++m) { const int r = r0 + ai * HALF + m * 16;
                const f32x4 p0 = *(const LAS f32x4*)(PS + r * 8), p1 = *(const LAS f32x4*)(PS + r * 8 + 4);
                const float mu = ((p0[0] + p0[2]) + (p1[0] + p1[2])) * (1.f / 256.f), ex2 = ((p0[1] + p0[3]) + (p1[1] + p1[3])) * (1.f / 256.f), rs = rsqrtf(fmaxf(ex2 - mu * mu, 0.f) + EPS);
#pragma unroll
                for (int bj = 0; bj < 2; ++bj) { const size_t o = (size_t)(t0 + r) * DM + h * 256 + c0 + bj * HALF; const u32x4 xc = gin[m][bj];
                    const LAS float* gp = (const LAS float*)(lds + 142336) + h * 256 + c0 + bj * HALF; const LAS float* sp_ = gp + 1024;
                    const f32x4 v0 = (acc[ai][bj][m][0] - mu) * rs * *(const LAS f32x4*)gp + *(const LAS f32x4*)sp_ * lo4(xc), v1 = (acc[ai][bj][m][1] - mu) * rs * *(const LAS f32x4*)(gp + 4) + *(const LAS f32x4*)(sp_ + 4) * hi4(xc);
                    *(u32x4*)((bf16*)(ws + O_MOIN) + o) = pack8(v0, v1); } }
            asm volatile("" ::: "memory");
        }
        asm volatile("s_waitcnt lgkmcnt(0)" ::: "memory"); __builtin_amdgcn_s_barrier(); asm volatile("" ::: "memory");
    }
};
struct EpiGu {
    static constexpr bool MID = false; static constexpr bool PERM = true; unsigned char* ws; const float* bgu;
    __device__ __forceinline__ void operator()(const Acc& acc, const Unit& u, int wr, int wc, int fr, int fq, LAS unsigned char* lds_) const {
        const int e = ((const LAS int*)(lds_ + 148480))[u.pm]; const int ch0 = u.pn * 128 + wc * 32 + 8 * fq;
        const float* bb = bgu + e * 2048 + ch0;
        const f32x4 bg0 = *(const f32x4*)(bb), bg1 = *(const f32x4*)(bb + 4), bu0 = *(const f32x4*)(bb + 1024), bu1 = *(const f32x4*)(bb + 1028);
        unsigned char* O = ws + O_ACT + (size_t)(u.pm * BM + wr * 64 + fr) * KP8 + ch0;
        constexpr float ds = 1.f / (S_HM * S_W);
#pragma unroll
        for (int ai = 0; ai < 2; ++ai)
#pragma unroll
            for (int m = 0; m < 4; ++m) { f32x4 v[2];
#pragma unroll
                for (int n = 0; n < 2; ++n) { const f32x4 gt = acc[ai][0][m][n] * ds + (n ? bg1 : bg0), up = acc[ai][1][m][n] * ds + (n ? bu1 : bu0);
#pragma unroll
                    for (int j = 0; j < 4; ++j) { const float gg = fminf(gt[j], 7.f), uu = __builtin_amdgcn_fmed3f(up[j], -7.f, 7.f);
                        const float sg = __builtin_amdgcn_rcpf(1.f + __builtin_amdgcn_exp2f(gg * (-1.702f * 1.4426950408889634f)));
                        v[n][j] = (uu * S_ACT + S_ACT) * (gg * sg); } }
                u32x2 w8; w8.x = pk4_fp8_nc(v[0][0], v[0][1], v[0][2], v[0][3]); w8.y = pk4_fp8_nc(v[1][0], v[1][1], v[1][2], v[1][3]);
                *(u32x2*)(O + (size_t)(ai * HALF + m * 16) * KP8) = w8; }
    }
};
struct EpiDn {
    static constexpr bool MID = false; static constexpr bool PERM = true; unsigned char* ws; const float* bdn;
    __device__ __forceinline__ void operator()(const Acc& acc, const Unit& u, int wr, int wc, int fr, int fq, LAS unsigned char* lds_) const {
        const int e = ((const LAS int*)(lds_ + 148480))[u.pm]; const int col0 = u.pn * BM + wc * 32 + 8 * fq, row0 = u.pm * BM + wr * 64 + fr;
        const float* roww = (const float*)(ws + WS_ROWSLOT); unsigned char* Y = ws + O_Y;
        float w[2][4];
#pragma unroll
        for (int ai = 0; ai < 2; ++ai)
#pragma unroll
            for (int m = 0; m < 4; ++m) w[ai][m] = roww[row0 + ai * HALF + m * 16];
        f32x4 b[2][2];
#pragma unroll
        for (int bj = 0; bj < 2; ++bj)
#pragma unroll
            for (int n = 0; n < 2; ++n) b[bj][n] = *(const f32x4*)(bdn + e * DM + col0 + bj * HALF + 4 * n);
        asm volatile("" ::: "memory");
#pragma unroll
        for (int ai = 0; ai < 2; ++ai)
#pragma unroll
            for (int m = 0; m < 4; ++m) w[ai][m] *= S_Y;
#pragma unroll
        for (int ai = 0; ai < 2; ++ai)
#pragma unroll
            for (int m = 0; m < 4; ++m)
#pragma unroll
                for (int bj = 0; bj < 2; ++bj) { const f32x4 v0 = (acc[ai][bj][m][0] * (1.f / (S_ACT * S_W)) + b[bj][0]) * w[ai][m], v1 = (acc[ai][bj][m][1] * (1.f / (S_ACT * S_W)) + b[bj][1]) * w[ai][m];
                    u32x2 w8; w8.x = pk4_fp8(v0[0], v0[1], v0[2], v0[3]); w8.y = pk4_fp8(v1[0], v1[1], v1[2], v1[3]);
                    *(u32x2*)(Y + (size_t)(row0 + ai * HALF + m * 16) * DM + col0 + bj * HALF) = w8; }
    }
};
}


__device__ __forceinline__ void ph_g_in(const P& p, LAS unsigned char* lds) {
    pg8::Gemm g{DM, DM, 16, 16, nullptr}; pg8::DenseOrder S; S.init(T / 256, DIN / 256, gridDim.x, blockIdx.x, p.ws + O_HA, DM, p.ws + WS_WIN, DM);
    pg8::EpiIn E{p.ws}; pg8::gemm_phase<pg8::EpiIn, pg8::DenseOrder, true>(lds, g, S, E);
}
__device__ __forceinline__ void ph_g_pwmo(const P& p, LAS unsigned char* lds) {
    pg8::Gemm g{DM, DM, 32, 16, nullptr}; pg8::DenseOrder S; S.init(T / 256, 4, gridDim.x, blockIdx.x, p.ws + O_YAPRE, DM, p.ws + WS_WPW, DM); S.A1 = (const char*)(p.ws + O_MOIN); S.B1 = (const char*)(p.ws + WS_WMO); S.revm = true;
    pg8::EpiPwMo E{p.ws, p.in[I_BPW]}; pg8::gemm_phase<pg8::EpiPwMo, pg8::DenseOrder, true, true>(lds, g, S, E);
}
__device__ __forceinline__ void ph_g_out(const P& p, LAS unsigned char* lds) {
    pg8::Gemm g{DM, DM, 16, 16, nullptr}; pg8::DenseOrder S; S.init(T / 256, 4, gridDim.x, blockIdx.x, p.ws + O_MERGED, DM, p.ws + WS_WOUT, DM);
    pg8::EpiOut E{p.ws, p.in[I_X]}; pg8::gemm_phase<pg8::EpiOut, pg8::DenseOrder, true>(lds, g, S, E);
}
__device__ __forceinline__ void ph_g_u(const P& p, LAS unsigned char* lds) {
    pg8::Gemm g{256, 256, 4, 4, nullptr}; pg8::BatchOrder<0> S{(int)gridDim.x, (int)blockIdx.x, (const char*)p.ws};
    pg8::EpiU E{p.ws}; pg8::gemm_phase<pg8::EpiU, pg8::BatchOrder<0>, true>(lds, g, S, E);
}
__device__ __forceinline__ void ph_g_s(const P& p, LAS unsigned char* lds) {
    pg8::Gemm g{DM, DM, 4, 4, nullptr}; pg8::BatchOrder<1> S{(int)gridDim.x, (int)blockIdx.x, (const char*)p.ws};
    pg8::EpiS E{p.ws}; pg8::gemm_phase<pg8::EpiS, pg8::BatchOrder<1>, true>(lds, g, S, E);
}
__device__ __forceinline__ void g_o_qn(const P& p, LAS unsigned char* lds) {
    const int tid = otid(), lane = tid & 63, wave = tid >> 6;
    LAS float* qn = (LAS float*)(lds + 131072) + 256 + 2048;
    { LAS f32x4* hs = (LAS f32x4*)(lds + 142336);
      hs[tid] = tid < 256 ? ((const f32x4*)p.in[I_HNG])[tid] : ((const f32x4*)p.in[I_SKIP])[tid - 256]; }
    int ui = 0;
    for (int lin = blockIdx.x; lin < NUNIT; lin += gridDim.x, ++ui) { const int unit = NUNIT - 1 - lin;
        int t0, h; unit_dec(unit, t0, h);
        const f32x4 n4 = ((const f32x4*)(wsp<float>(p, WS_NS) + unit * 256))[lane];
        const bf16* q = wsp<bf16>(p, O_XC) + (size_t)(t0 + wave * 32) * DM + h * 256 + 4 * lane;
        float v[32]; u32x2 qv[32];
#pragma unroll
        for (int r = 0; r < 32; ++r) qv[r] = *(const u32x2*)(q + (size_t)r * DM);
        asm volatile("" ::: "memory");
#pragma unroll
        for (int r = 0; r < 32; ++r) { const u32x2 w2 = qv[r]; v[r] = (bflo(w2.x) * n4.x + bfhi(w2.x) * n4.y) + (bflo(w2.y) * n4.z + bfhi(w2.y) * n4.w); }
        float a16[16], a8[8], a4[4], a2[2], a1;
        { const bool hi = lane & 32;
#pragma unroll
          for (int i = 0; i < 16; ++i) { const float keep = hi ? v[2 * i + 1] : v[2 * i], send = hi ? v[2 * i] : v[2 * i + 1]; a16[i] = keep + __shfl_xor(send, 32); } }
        { const bool hi = lane & 16;
#pragma unroll
          for (int i = 0; i < 8; ++i) { const float keep = hi ? a16[2 * i + 1] : a16[2 * i], send = hi ? a16[2 * i] : a16[2 * i + 1]; a8[i] = keep + __shfl_xor(send, 16); } }
        { const bool hi = lane & 8;
#pragma unroll
          for (int i = 0; i < 4; ++i) { const float keep = hi ? a8[2 * i + 1] : a8[2 * i], send = hi ? a8[2 * i] : a8[2 * i + 1]; a4[i] = keep + __shfl_xor(send, 8); } }
        { const bool hi = lane & 4;
#pragma unroll
          for (int i = 0; i < 2; ++i) { const float keep = hi ? a4[2 * i + 1] : a4[2 * i], send = hi ? a4[2 * i] : a4[2 * i + 1]; a2[i] = keep + __shfl_xor(send, 4); } }
        { const bool hi = lane & 2; const float keep = hi ? a2[1] : a2[0], send = hi ? a2[0] : a2[1]; a1 = keep + __shfl_xor(send, 2); }
        a1 += __shfl_xor(a1, 1);
        if ((lane & 1) == 0) { const int r = ((lane >> 1) & 1) * 16 + ((lane >> 2) & 1) * 8 + ((lane >> 3) & 1) * 4 + ((lane >> 4) & 1) * 2 + ((lane >> 5) & 1); qn[ui * 256 + wave * 32 + r] = a1; }
    }
    asm volatile("s_waitcnt lgkmcnt(0)" ::: "memory"); __syncthreads();
}
__device__ __forceinline__ void ph_g_o(const P& p, LAS unsigned char* lds) {
    g_o_qn(p, lds);
    pg8::Gemm g{DM, 256, 8, 4, nullptr}; pg8::BatchOrder<2> S{(int)gridDim.x, (int)blockIdx.x, (const char*)p.ws};
    pg8::EpiO E{p.ws, p.in[I_HNG], p.in[I_SKIP]}; pg8::gemm_phase<pg8::EpiO, pg8::BatchOrder<2>, true, true>(lds, g, S, E);
}
__device__ __forceinline__ int moe_table(const P& p, LAS unsigned char* lds) {
    LAS int* te = (LAS int*)(lds + 148480); const int* g = wsp<int>(p, WS_TILEE);
    for (int i = otid(); i <= MAXTILES; i += 512) te[i] = g[i];
    asm volatile("s_waitcnt vmcnt(0) lgkmcnt(0)" ::: "memory"); __syncthreads();
    return __builtin_amdgcn_readfirstlane(te[MAXTILES]);
}
__device__ __forceinline__ void ph_g_gu(const P& p, LAS unsigned char* lds) {
    const int nt_ = moe_table(p, lds);
    pg8::Gemm g{512, KP8 / 2, 8, 8, wsp<int>(p, WS_ROWTOK)}; pg8::MoeOrder S; S.init(nt_, 8, gridDim.x, blockIdx.x, p.ws + O_HM, 512, p.ws + WS_WGU, KP8 / 2); S.tile_e = (const LAS int*)(lds + 148480); S.gather = true; S.rev = false;
    pg8::EpiGu E{p.ws, p.in[I_BGU]}; pg8::gemm_phase<pg8::EpiGu, pg8::MoeOrder, true, false, true, true>(lds, g, S, E);
}
__device__ __forceinline__ void ph_g_dn(const P& p, LAS unsigned char* lds) {
    const int nt_ = moe_table(p, lds);
    pg8::Gemm g{KP8 / 2, KP8 / 2, 8, 8, nullptr}; pg8::MoeOrder S; S.init(nt_, 4, gridDim.x, blockIdx.x, p.ws + O_ACT, KP8 / 2, p.ws + WS_WDN, KP8 / 2); S.tile_e = (const LAS int*)(lds + 148480); S.gather = false; S.rev = true;
    pg8::EpiDn E{p.ws, p.in[I_BDN]}; pg8::gemm_phase<pg8::EpiDn, pg8::MoeOrder, true, false, false, true>(lds, g, S, E);
}

#define XB_TMO      128
#define XB_XCNT(j)  (256  + 64 * (j))
#define XB_XSUB(j)  (1280 + 64 * (j))
#define XB_XGEN(j)  (2304 + 64 * (j))
#define XB_TOP      3328
#define XB_TOPGEN   3392
#define XCD_BAR_WORDS 3456
#define XB_SPIN_CAP (1u << 18)
__device__ __forceinline__ unsigned xb_ld(unsigned* p)              { return __hip_atomic_load(p, __ATOMIC_RELAXED, __HIP_MEMORY_SCOPE_AGENT); }
__device__ __forceinline__ unsigned xb_add(unsigned* p, unsigned v) { return __hip_atomic_fetch_add(p, v, __ATOMIC_RELAXED, __HIP_MEMORY_SCOPE_AGENT); }
__device__ __forceinline__ unsigned xb_xcc_id() { return (unsigned)__builtin_amdgcn_s_getreg((3 << 11) | 20) & 0xFu; }
#define XB_SPIN(cond, bar) do { unsigned _sp = 0; while (cond) { __builtin_amdgcn_s_sleep(1); \
    if ((++_sp & 255u) == 0u) { if (xb_ld(&(bar)[XB_TMO])) break; if (_sp > XB_SPIN_CAP) { atomicAdd(&(bar)[XB_TMO], 1u); break; } } } } while (0)
struct XcdBarrier { unsigned* bar; unsigned x; volatile LAS unsigned* st; };
__device__ __forceinline__ XcdBarrier xcd_barrier_post(unsigned* bar, volatile LAS unsigned* st) {
    XcdBarrier b; b.bar = bar; b.x = xb_xcc_id(); b.st = st;
    if (threadIdx.x == 0) (void)xb_add(&bar[XB_XCNT(b.x)], 1u);
    return b;
}
__device__ __forceinline__ void xcd_barrier_complete(unsigned* bar, unsigned x, unsigned& nloc, unsigned& nx) {
    const unsigned G = gridDim.x * gridDim.y * gridDim.z;
    unsigned sum, cnt, mine, sp = 0u;
    for (;;) {
        sum = 0u; cnt = 0u; mine = 0u;
#pragma unroll
        for (unsigned j = 0; j < 16; ++j) { const unsigned c = xb_ld(&bar[XB_XCNT(j)]); sum += c; cnt += (c > 0u) ? 1u : 0u; mine = (j == x) ? c : mine; }
        if (sum == G) break;
        __builtin_amdgcn_s_sleep(1);
        if ((++sp & 255u) == 0u) { if (xb_ld(&bar[XB_TMO])) break; if (sp > XB_SPIN_CAP) { atomicAdd(&bar[XB_TMO], 1u); break; } }
    }
    nloc = mine > 0u ? mine : 1u; nx = cnt > 0u ? cnt : 1u;
}
__device__ __forceinline__ void xcd_barrier(const XcdBarrier& b) {
    asm volatile("s_waitcnt vmcnt(0)" ::: "memory");
    __syncthreads();
    if (threadIdx.x < 64 && b.st[0] == 0u) {
        unsigned* bar = b.bar; const unsigned lane = threadIdx.x, G = gridDim.x * gridDim.y * gridDim.z;
        unsigned c = 0u, sp = 0u;
        for (;;) {
            c = lane < 16u ? xb_ld(&bar[XB_XCNT(lane)]) : 0u;
            unsigned sum = c;
#pragma unroll
            for (int o = 1; o < 16; o <<= 1) sum += __shfl_xor(sum, o);
            sum = __builtin_amdgcn_readfirstlane(sum);
            if (sum == G) break;
            __builtin_amdgcn_s_sleep(1);
            if ((++sp & 255u) == 0u) { if (__builtin_amdgcn_readfirstlane(xb_ld(&bar[XB_TMO]))) break; if (sp > XB_SPIN_CAP) { if (lane == 0u) atomicAdd(&bar[XB_TMO], 1u); break; } }
        }
        const unsigned nx = (unsigned)__popcll(__ballot(c > 0u)), mine = (unsigned)__shfl((int)c, (int)b.x);
        if (lane == 0u) { b.st[0] = mine > 0u ? mine : 1u; b.st[1] = nx > 0u ? nx : 1u; }
    }
    if (threadIdx.x == 0) {
        unsigned* bar = b.bar;
        __builtin_amdgcn_s_waitcnt(0);
        const unsigned nloc = b.st[0], nx = b.st[1];
        const unsigned old = xb_add(&bar[XB_XSUB(b.x)], 1u);
        const unsigned gen = old / nloc;
        if (old + 1u == (gen + 1u) * nloc) {
            __builtin_amdgcn_fence(__ATOMIC_RELEASE, "agent");
            asm volatile("s_waitcnt vmcnt(0)" ::: "memory");
            const unsigned og = xb_add(&bar[XB_TOP], 1u);
            const unsigned tg = og / nx;
            if (og + 1u == (tg + 1u) * nx) xb_add(&bar[XB_TOPGEN], 1u);
            else XB_SPIN(xb_ld(&bar[XB_TOPGEN]) == tg, bar);
            __builtin_amdgcn_fence(__ATOMIC_ACQUIRE, "agent");
            xb_add(&bar[XB_XGEN(b.x)], 1u);
            asm volatile("s_waitcnt vmcnt(0)" ::: "memory");
        } else {
            XB_SPIN(xb_ld(&bar[XB_XGEN(b.x)]) == gen, bar);
            __builtin_amdgcn_fence(__ATOMIC_ACQUIRE, "agent");
            asm volatile("s_waitcnt vmcnt(0)" ::: "memory");
        }
    }
    __syncthreads();
}

constexpr int LDS_BYTES = 155648, MISC_OFF = LDS_BYTES - 64;
constexpr int NPHASE = 13;
#ifndef DUP
#define DUP 0
#endif
#ifndef SPINMASK
#define SPINMASK 0
#endif
#define RUN(id, call) do { call; if ((DUP >> (id)) & 1) { __syncthreads(); call; } } while (0)
__global__ void __launch_bounds__(512, 2) mega(P p, int lo, int hi) {
    extern __shared__ __attribute__((aligned(16))) unsigned char lds_raw[];
    float* lds = (float*)lds_raw; LAS unsigned char* l3 = (LAS unsigned char*)lds_raw;
    volatile LAS unsigned* misc = (volatile LAS unsigned*)(l3 + MISC_OFF);
    if (threadIdx.x < 16) misc[threadIdx.x] = 0u;
    __syncthreads();
    XcdBarrier bar; bar.bar = wsp<unsigned>(p, WS_CTL); bar.x = 0; bar.st = misc;
    if (hi - lo > 1) bar = xcd_barrier_post(wsp<unsigned>(p, WS_CTL), misc);
    for (int ph = lo; ph < hi; ++ph) {
        const unsigned long long t0_ = SPINMASK ? __builtin_amdgcn_s_memrealtime() : 0ull;
        switch (ph) {
            case 0: ph_mod(p, lds); RUN(1, ph_wconv(p, lds)); mod_wait(p); RUN(2, ph_norm1(p)); break;
            case 1: RUN(3, ph_g_in(p, l3)); break;
            case 2: ph_wprime(p, lds); RUN(4, ph_conv(p, lds)); RUN(5, ph_m1(p, lds)); break;
            case 3: RUN(6, ph_m2(p, lds));
                    asm volatile("s_waitcnt vmcnt(0)" ::: "memory"); __syncthreads();
                    RUN(8, ph_g_u(p, l3)); break;
            case 4: RUN(10, ph_scan(p)); break;
            case 5: RUN(9, ph_g_s(p, l3));
                    asm volatile("s_waitcnt vmcnt(0)" ::: "memory"); __syncthreads();
                    RUN(11, ph_g_o(p, l3)); break;
            case 6: RUN(12, ph_g_pwmo(p, l3)); break;
            case 7: RUN(13, ph_g_out(p, l3)); break;
            case 8: RUN(14, ph_router(p, lds)); break;
            case 9: RUN(15, ph_scatter(p, lds)); break;
            case 10: RUN(16, ph_g_gu(p, l3)); break;
            case 11: RUN(17, ph_g_dn(p, l3)); break;
            case 12: RUN(18, ph_final(p)); break;
        }
        if (ph + 1 < hi || (SPINMASK >> ph) & 1) xcd_barrier(bar);
        if ((SPINMASK >> ph) & 1) { const unsigned long long t1_ = __builtin_amdgcn_s_memrealtime(), d_ = t1_ - t0_; while (__builtin_amdgcn_s_memrealtime() - t1_ < d_) __builtin_amdgcn_s_sleep(8); }
    }
}

#ifndef N_LAUNCHES
#define N_LAUNCHES 1
#endif
extern "C" void kernel_launch(void* const* d_in, const int* in_sizes, int n_in, void* d_out, int out_size, void* d_ws, size_t ws_size, hipStream_t stream) {
    static int grid = 0;
    if (grid == 0) {
        if (n_in != 31 || ws_size < WS_NEED || out_size != T * DM) { fprintf(stderr, "kernel_launch: unexpected shapes: n_in %d ws %zu out %d\n", n_in, ws_size, out_size); grid = -1; return; }
        int dev = 0, cus = 0, per_cu = 0;
        if (hipGetDevice(&dev) != hipSuccess || hipDeviceGetAttribute(&cus, hipDeviceAttributeMultiprocessorCount, dev) != hipSuccess) { fprintf(stderr, "kernel_launch: device query failed\n"); grid = -1; return; }
        if (hipFuncSetAttribute((const void*)mega, hipFuncAttributeMaxDynamicSharedMemorySize, LDS_BYTES) != hipSuccess) { fprintf(stderr, "kernel_launch: hipFuncSetAttribute failed\n"); grid = -1; return; }
        if (hipOccupancyMaxActiveBlocksPerMultiprocessor(&per_cu, (const void*)mega, 512, LDS_BYTES) != hipSuccess || per_cu < 1) { fprintf(stderr, "kernel_launch: occupancy query says %d blocks per CU\n", per_cu); (void)hipGetLastError(); grid = -1; return; }
        grid = cus;
    }
    if (grid < 0) return;
    P p{};
    for (int i = 0; i < 31; ++i) p.in[i] = (const float*)d_in[i];
    p.out = (float*)d_out; p.ws = (unsigned char*)d_ws + ((ws_size - WS_NEED) & ~(size_t)(MB - 1));
    (void)hipMemsetAsync((char*)p.ws + WS_CTL, 0, 65536, stream);
    if (N_LAUNCHES == 1) hipLaunchKernelGGL(mega, dim3(grid), dim3(512), LDS_BYTES, stream, p, 0, NPHASE);
    else for (int ph = 0; ph < NPHASE; ++ph) hipLaunchKernelGGL(mega, dim3(grid), dim3(512), LDS_BYTES, stream, p, ph, ph + 1);
}
```
